# Optimizing an MI355X kernel written in HIP

```python
import jax, jax.numpy as jnp
from jax import lax
import numpy as np

D_MODEL = 1024
BATCH = 32
SEQ = 256
DEPTH = 2
DEC_BATCH = 2
DEC_SEQ = 1024
PAST_LEN = 256

GRID_W = 64
HEAD_DIM = 64
A_HEADS = 4
A_KV_HEADS = 2
B_HEADS = 6
B_KV_HEADS = 2
C_HEADS = 6
A_DIM = A_HEADS * HEAD_DIM
B_DIM = B_HEADS * HEAD_DIM
C_DIM = C_HEADS * HEAD_DIM
MIX_DIM = A_DIM + B_DIM + C_DIM
WINDOW = 128
Q_BLK = 128
W_RANK = 64
A_RANK = 64
G_RANK = 128
FF_DIM = -(-8 * D_MODEL // (3 * 256)) * 256
ROPE_THETA = 10000.0
ROPE_PAIRS_AXIS = HEAD_DIM // 4
NORM_EPS = 1e-6
GN_EPS = 64e-5
NEG_INF = -1e30
IN_SPLITS = (A_DIM, A_KV_HEADS * HEAD_DIM, A_KV_HEADS * HEAD_DIM,
             B_DIM, B_KV_HEADS * HEAD_DIM, B_KV_HEADS * HEAD_DIM,
             C_DIM, C_DIM, C_DIM, W_RANK, A_RANK, G_RANK)
IN_COLS = sum(IN_SPLITS)

kernel_name = 'hybrid_diffusion_prefix_trunk_step'


def rms_norm(x, g):
    xf = x.astype(jnp.float32)
    y = xf * lax.rsqrt(jnp.mean(xf * xf, axis=-1, keepdims=True) + NORM_EPS)
    return y.astype(x.dtype) * g


def rope_2d(x):
    T = x.shape[1]
    rows = T // GRID_W
    f32 = jnp.float32
    row = jnp.repeat(jnp.arange(rows), GRID_W).astype(f32)
    col = (jnp.arange(T) % GRID_W).astype(f32)
    freqs = ROPE_THETA ** (-jnp.arange(ROPE_PAIRS_AXIS, dtype=f32) / ROPE_PAIRS_AXIS)
    ang = jnp.concatenate([row[:, None] * freqs, col[:, None] * freqs], axis=-1)[None, :, None, :]
    cos, sin = jnp.cos(ang), jnp.sin(ang)
    xf = x.astype(f32)
    half = HEAD_DIM // 2
    x1, x2 = xf[..., :half], xf[..., half:]
    return jnp.concatenate([x1 * cos - x2 * sin, x1 * sin + x2 * cos], axis=-1).astype(x.dtype)


def dense_attn(q, k, v, sink=None):
    B, T, Hq, D = q.shape
    Hkv = k.shape[2]
    G = Hq // Hkv
    nb = T // Q_BLK
    scale = D ** -0.5
    qb = jnp.moveaxis(q.reshape(B, nb, Q_BLK, Hkv, G, D), 1, 0)

    def one_block(qi):
        s = jnp.einsum('bqhgd,bshd->bhgqs', qi, k).astype(jnp.float32) * scale
        if sink is None:
            p = jax.nn.softmax(s, axis=-1)
        else:
            sl = jnp.broadcast_to(sink.astype(jnp.float32).reshape(Hkv, G)[None, :, :, None, None],
                                  s.shape[:-1] + (1,))
            p = jax.nn.softmax(jnp.concatenate([s, sl], axis=-1), axis=-1)[..., :-1]
        return jnp.einsum('bhgqs,bshd->bqhgd', p.astype(v.dtype), v)

    o = lax.map(one_block, qb)
    return jnp.moveaxis(o, 0, 1).reshape(B, T, Hq, D)


def window_attn(q, k, v, k_ctx, v_ctx, sink):
    B, T, Hq, D = q.shape
    Hkv = k.shape[2]
    G = Hq // Hkv
    nb = T // Q_BLK
    scale = D ** -0.5
    qb = q.reshape(B, nb, Q_BLK, Hkv, G, D)

    def band(t):
        tp = jnp.pad(t, ((0, 0), (Q_BLK, Q_BLK), (0, 0), (0, 0))).reshape(B, nb + 2, Q_BLK, Hkv, D)
        return jnp.concatenate([tp[:, :-2], tp[:, 1:-1], tp[:, 2:]], axis=2)

    kb, vb = band(k), band(v)
    blk = jnp.arange(nb)[:, None] * Q_BLK
    qpos = blk + jnp.arange(Q_BLK)[None, :]
    kpos = blk - Q_BLK + jnp.arange(3 * Q_BLK)[None, :]
    mask = ((jnp.abs(kpos[:, None, :] - qpos[:, :, None]) <= WINDOW)
            & (kpos[:, None, :] >= 0) & (kpos[:, None, :] < T))
    s_loc = jnp.einsum('bnqhgd,bnkhd->bnhgqk', qb, kb).astype(jnp.float32) * scale
    s_loc = jnp.where(mask[None, :, None, None], s_loc, NEG_INF)
    s_ctx = jnp.einsum('bnqhgd,bshd->bnhgqs', qb, k_ctx).astype(jnp.float32) * scale
    s_sink = jnp.broadcast_to(sink.astype(jnp.float32).reshape(Hkv, G)[None, None, :, :, None, None],
                              s_loc.shape[:-1] + (1,))
    p = jax.nn.softmax(jnp.concatenate([s_loc, s_ctx, s_sink], axis=-1), axis=-1)
    n_loc = 3 * Q_BLK
    n_ctx = k_ctx.shape[1]
    p_loc = p[..., :n_loc].astype(v.dtype)
    p_ctx = p[..., n_loc:n_loc + n_ctx].astype(v.dtype)
    o = (jnp.einsum('bnhgqk,bnkhd->bnqhgd', p_loc, vb)
         + jnp.einsum('bnhgqs,bshd->bnqhgd', p_ctx, v_ctx))
    return o.reshape(B, T, Hq, D)


def wkv_step(S, inp):
    r, w, k, v, a, b = inp
    sa = jnp.einsum('bhvk,bhk->bhv', S, a)
    S = S * w[:, :, None, :] + sa[..., None] * b[:, :, None, :] + v[..., None] * k[:, :, None, :]
    y = jnp.einsum('bhvk,bhk->bhv', S, r)
    return S, y


def rwkv_mix(r, k, v, xw, xa, xg, P, l, init_state):
    dtype = r.dtype
    f32 = jnp.float32
    B, T, _ = r.shape
    r, k, v, xw, xa, xg = (t.astype(f32) for t in (r, k, v, xw, xa, xg))

    def heads(t):
        return t.reshape(B, T, C_HEADS, HEAD_DIM)

    g = jax.nn.sigmoid(xg) @ P['c_g_up'][l].astype(f32)
    tw = jnp.tanh(xw)
    kk = heads(k * P['c_k_k'][l].astype(f32))
    kk = kk * lax.rsqrt(jnp.sum(kk * kk, axis=-1, keepdims=True) + 1e-12)
    rh, vh = heads(r), heads(v)
    r_k = P['c_r_k'][l].astype(f32)
    y_sum = jnp.zeros_like(rh)
    bonus = jnp.zeros_like(rh)
    finals = []
    for d in range(2):
        wlog = -jax.nn.softplus(-(P['c_w0'][l, d].astype(f32) + tw @ P['c_w_up'][l, d].astype(f32))) - 0.5
        decay = jnp.exp(-jnp.exp(wlog))
        a = jax.nn.sigmoid(P['c_a0'][l, d].astype(f32) + xa @ P['c_a_up'][l, d].astype(f32))
        kt = heads(k * (1.0 + (a - 1.0) * P['c_k_a'][l].astype(f32)))
        ah = heads(a)
        xs = tuple(jnp.moveaxis(t, 1, 0) for t in (rh, heads(decay), kt, vh, -kk, kk * ah))
        S_fin, y = lax.scan(wkv_step, init_state[:, d].astype(f32), xs, reverse=(d == 1))
        y_sum = y_sum + jnp.moveaxis(y, 0, 1)
        bonus = bonus + jnp.sum(rh * kt * r_k, axis=-1, keepdims=True) * vh
        finals.append(S_fin)
    mu = jnp.mean(y_sum, axis=-1, keepdims=True)
    var = jnp.mean(jnp.square(y_sum - mu), axis=-1, keepdims=True)
    yn = ((y_sum - mu) * lax.rsqrt(var + GN_EPS)).reshape(B, T, C_DIM)
    o = (yn * P['c_ln_w'][l].astype(f32) + P['c_ln_b'][l].astype(f32) + bonus.reshape(B, T, C_DIM)) * g
    return o.astype(dtype), jnp.stack(finals, axis=1)


def mixer(h, P, l, ctx_cache):
    B, T, _ = h.shape
    z = h @ P['w_in'][l]
    split_points = np.cumsum(IN_SPLITS)[:-1].tolist()
    aq, ak, av, bq, bk, bv, cr, ck, cv, cw, ca, cg = jnp.split(z, split_points, axis=-1)
    aq = aq.reshape(B, T, A_HEADS, HEAD_DIM)
    ak = ak.reshape(B, T, A_KV_HEADS, HEAD_DIM)
    av = av.reshape(B, T, A_KV_HEADS, HEAD_DIM)
    bq = rms_norm(bq.reshape(B, T, B_HEADS, HEAD_DIM), P['b_q_norm'][l])
    bk = rms_norm(bk.reshape(B, T, B_KV_HEADS, HEAD_DIM), P['b_k_norm'][l])
    bv = bv.reshape(B, T, B_KV_HEADS, HEAD_DIM)
    if ctx_cache is None:
        oa = dense_attn(aq, ak, av, P['a_sink'][l])
        ob = dense_attn(bq, bk, bv)
        init = jnp.zeros((B, 2, C_HEADS, HEAD_DIM, HEAD_DIM), jnp.float32)
        oc, st = rwkv_mix(cr, ck, cv, cw, ca, cg, P, l, init)
        cache = (ak, av, bk, bv, st)
    else:
        ka_c, va_c, kb_c, vb_c, st_c = ctx_cache
        oa = window_attn(rope_2d(aq), rope_2d(ak), av, ka_c, va_c, P['a_sink'][l])
        ob = dense_attn(rope_2d(bq),
                        jnp.concatenate([kb_c, rope_2d(bk)], axis=1),
                        jnp.concatenate([vb_c, bv], axis=1))
        oc, _ = rwkv_mix(cr, ck, cv, cw, ca, cg, P, l, st_c)
        cache = None
    o = jnp.concatenate([oa.reshape(B, T, A_DIM), ob.reshape(B, T, B_DIM), oc], axis=-1) @ P['w_out'][l]
    return o, cache


def trunk_layer(x, mod, P, l, ctx_cache):
    shift1, scale1, gate1, shift2, scale2, gate2 = jnp.split(mod, 6, axis=-1)
    h = rms_norm(x, P['norm_mix_pre'][l]) * (1.0 + scale1) + shift1
    o, cache = mixer(h, P, l, ctx_cache)
    x = x + gate1 * rms_norm(o, P['norm_mix_post'][l])
    h = rms_norm(x, P['norm_ffn_pre'][l]) * (1.0 + scale2) + shift2
    gu = h @ P['w_gu'][l]
    f = (jax.nn.silu(gu[..., :FF_DIM]) * gu[..., FF_DIM:]) @ P['w_down'][l]
    x = x + gate2 * rms_norm(f, P['norm_ffn_post'][l])
    return x, cache


def setup_inputs(seed: int = 0) -> dict:
    key = jax.random.key(seed)
    ks = iter(jax.random.split(key, 48))
    f32 = jnp.float32

    def nrm(shape, scale):
        return jax.random.normal(next(ks), shape, f32) * scale

    return {
        'x_prompt': nrm((BATCH, SEQ, D_MODEL), 1.0),
        'x_sample': nrm((DEC_BATCH, DEC_SEQ, D_MODEL), 1.0),
        'cache_a_k': nrm((DEC_BATCH, DEPTH, PAST_LEN, A_KV_HEADS, HEAD_DIM), 1.0),
        'cache_a_v': nrm((DEC_BATCH, DEPTH, PAST_LEN, A_KV_HEADS, HEAD_DIM), 1.0),
        'cache_b_k': nrm((DEC_BATCH, DEPTH, PAST_LEN, B_KV_HEADS, HEAD_DIM), 1.0),
        'cache_b_v': nrm((DEC_BATCH, DEPTH, PAST_LEN, B_KV_HEADS, HEAD_DIM), 1.0),
        'state_c': nrm((DEC_BATCH, DEPTH, 2, C_HEADS, HEAD_DIM, HEAD_DIM), 0.3),
        'c': nrm((DEC_BATCH, D_MODEL), 1.0),
        'c_ctx': nrm((D_MODEL,), 1.0),
        'w_mod': nrm((DEPTH, D_MODEL, 6 * D_MODEL), D_MODEL ** -0.5),
        'b_mod': nrm((DEPTH, 6 * D_MODEL), 0.02),
        'norm_mix_pre': 1.0 + nrm((DEPTH, D_MODEL), 0.05),
        'norm_mix_post': 1.0 + nrm((DEPTH, D_MODEL), 0.05),
        'norm_ffn_pre': 1.0 + nrm((DEPTH, D_MODEL), 0.05),
        'norm_ffn_post': 1.0 + nrm((DEPTH, D_MODEL), 0.05),
        'w_in': nrm((DEPTH, D_MODEL, IN_COLS), D_MODEL ** -0.5),
        'w_out': nrm((DEPTH, MIX_DIM, D_MODEL), MIX_DIM ** -0.5),
        'a_sink': nrm((DEPTH, A_HEADS), 0.5),
        'b_q_norm': 1.0 + nrm((DEPTH, HEAD_DIM), 0.05),
        'b_k_norm': 1.0 + nrm((DEPTH, HEAD_DIM), 0.05),
        'c_w0': jax.random.uniform(next(ks), (DEPTH, 2, C_DIM), f32, -5.0, 0.5),
        'c_w_up': nrm((DEPTH, 2, W_RANK, C_DIM), 0.1),
        'c_a0': nrm((DEPTH, 2, C_DIM), 0.1),
        'c_a_up': nrm((DEPTH, 2, A_RANK, C_DIM), 0.1),
        'c_g_up': nrm((DEPTH, G_RANK, C_DIM), G_RANK ** -0.5),
        'c_k_k': 0.85 + nrm((DEPTH, C_DIM), 0.05),
        'c_k_a': 1.0 + nrm((DEPTH, C_DIM), 0.05),
        'c_r_k': nrm((DEPTH, C_HEADS, HEAD_DIM), 0.1),
        'c_ln_w': 1.0 + nrm((DEPTH, C_DIM), 0.05),
        'c_ln_b': nrm((DEPTH, C_DIM), 0.02),
        'w_gu': nrm((DEPTH, D_MODEL, 2 * FF_DIM), D_MODEL ** -0.5),
        'w_down': nrm((DEPTH, FF_DIM, D_MODEL), FF_DIM ** -0.5),
    }


def reference(x_prompt, x_sample, cache_a_k, cache_a_v, cache_b_k, cache_b_v, state_c, c, c_ctx,
              w_mod, b_mod, norm_mix_pre, norm_mix_post, norm_ffn_pre, norm_ffn_post, w_in, w_out,
              a_sink, b_q_norm, b_k_norm, c_w0, c_w_up, c_a0, c_a_up, c_g_up, c_k_k, c_k_a, c_r_k,
              c_ln_w, c_ln_b, w_gu, w_down):
    P = {
        'norm_mix_pre': norm_mix_pre, 'norm_mix_post': norm_mix_post,
        'norm_ffn_pre': norm_ffn_pre, 'norm_ffn_post': norm_ffn_post,
        'w_in': w_in, 'w_out': w_out, 'a_sink': a_sink, 'b_q_norm': b_q_norm, 'b_k_norm': b_k_norm,
        'c_w0': c_w0, 'c_w_up': c_w_up, 'c_a0': c_a0, 'c_a_up': c_a_up, 'c_g_up': c_g_up,
        'c_k_k': c_k_k, 'c_k_a': c_k_a, 'c_r_k': c_r_k, 'c_ln_w': c_ln_w, 'c_ln_b': c_ln_b,
        'w_gu': w_gu, 'w_down': w_down,
    }
    xp = x_prompt
    ak_l, av_l, bk_l, bv_l, st_l = [], [], [], [], []
    for l in range(DEPTH):
        mod = (jax.nn.silu(c_ctx) @ w_mod[l] + b_mod[l])[None, None, :]
        xp, (ak, av, bk, bv, st) = trunk_layer(xp, mod, P, l, None)
        ak_l.append(ak)
        av_l.append(av)
        bk_l.append(bk)
        bv_l.append(bv)
        st_l.append(st.astype(x_prompt.dtype))
    xs = x_sample
    for l in range(DEPTH):
        mod = (jax.nn.silu(c) @ w_mod[l] + b_mod[l])[:, None, :]
        ctx = (cache_a_k[:, l], cache_a_v[:, l], cache_b_k[:, l], cache_b_v[:, l], state_c[:, l])
        xs, _ = trunk_layer(xs, mod, P, l, ctx)
    new_a_k = jnp.stack(ak_l, axis=1)
    new_a_v = jnp.stack(av_l, axis=1)
    new_b_k = jnp.stack(bk_l, axis=1)
    new_b_v = jnp.stack(bv_l, axis=1)
    new_state_c = jnp.stack(st_l, axis=1)
    return (xp, xs, new_a_k, new_a_v, new_b_k, new_b_v, new_state_c)
```

```cpp
#include <hip/hip_runtime.h>
#include <hip/hip_bf16.h>
#include <hip/hip_cooperative_groups.h>
#include <cstdio>
#include <cstdint>
namespace cg = cooperative_groups;

typedef unsigned short bf16_t;
using bf16x8 = __attribute__((ext_vector_type(8))) short;
using f32x4 = __attribute__((ext_vector_type(4))) float;

#ifndef REP_GEMM
#define REP_GEMM 1
#endif
#ifndef REP_MIX
#define REP_MIX 1
#endif
#ifndef REP_P0
#define REP_P0 1
#endif
#ifndef REP_R0
#define REP_R0 1
#endif
#ifndef REP_BAR
#define REP_BAR 0
#endif
#ifndef REP_PREP
#define REP_PREP 1
#endif
#ifndef MIX_SPLIT
#define MIX_SPLIT 0
#endif
#ifndef REP_MA
#define REP_MA 1
#endif
#ifndef REP_MB
#define REP_MB 1
#endif
#ifndef REP_MC
#define REP_MC 1
#endif
#ifndef REP_OTHER
#define REP_OTHER 1
#endif
#ifndef USE_CG_SYNC
#define USE_CG_SYNC 0
#endif
#ifndef N_LAUNCH_MODE
#define N_LAUNCH_MODE 1
#endif

constexpr int D = 1024, M_CTX = 8192, M_LAT = 2048, MTOT = 10240;
constexpr int IN_COLS = 2560, FF = 2816, GU = 5632;
constexpr int NPHASE = 20;
constexpr int SMEM_CTL = 73728;
constexpr int SMEM_BYTES = SMEM_CTL + 64;

constexpr size_t al256(size_t x) { return (x + 255) & ~(size_t)255; }
constexpr size_t WS_WT_IN = 0;
constexpr size_t WS_WT_OUT = WS_WT_IN + (size_t)2 * IN_COLS * D * 2;
constexpr size_t WS_WT_GU = WS_WT_OUT + (size_t)2 * D * D * 2;
constexpr size_t WS_WT_DN = WS_WT_GU + (size_t)2 * GU * D * 2;
constexpr size_t WS_WUPT = WS_WT_DN + (size_t)2 * D * FF * 2;
constexpr size_t WS_AUPT = WS_WUPT + (size_t)4 * 384 * 64 * 2;
constexpr size_t WS_GUPT = WS_AUPT + (size_t)4 * 384 * 64 * 2;
constexpr size_t WS_MOD = WS_GUPT + (size_t)2 * 384 * 128 * 2;
constexpr size_t WS_ROPE = WS_MOD + (size_t)2 * 3 * 6144 * 4;
constexpr size_t WS_CKA = WS_ROPE + (size_t)1024 * 32 * 2 * 4;
constexpr size_t WS_CVTA = WS_CKA + (size_t)131072 * 2;
constexpr size_t WS_CKB = WS_CVTA + (size_t)131072 * 2;
constexpr size_t WS_CVTB = WS_CKB + (size_t)131072 * 2;
constexpr size_t WS_CNT = WS_CVTB + (size_t)131072 * 2;
constexpr size_t WS_BAR = WS_CNT + 256;
constexpr size_t WS_H = WS_BAR + 16384;
constexpr size_t WS_QK = WS_H + (size_t)MTOT * D * 2;
constexpr size_t WS_VT = WS_QK + (size_t)MTOT * 896 * 2;
constexpr size_t WS_CZ = WS_VT + (size_t)4 * 64 * MTOT * 2;
constexpr size_t WS_DEC = WS_CZ + (size_t)MTOT * 1408 * 4;
constexpr size_t WS_KT = WS_DEC + (size_t)2 * MTOT * 384 * 4;
constexpr size_t WS_BB = WS_KT + (size_t)2 * MTOT * 384 * 2;
constexpr size_t WS_KK = WS_BB + (size_t)2 * MTOT * 384 * 2;
constexpr size_t WS_G = WS_KK + (size_t)MTOT * 384 * 2;
constexpr size_t WS_BON = WS_G + (size_t)MTOT * 384 * 2;
constexpr size_t WS_Y = WS_BON + (size_t)MTOT * 8 * 4;
constexpr size_t WS_END = WS_Y + (size_t)2 * MTOT * 384 * 2;
static_assert((size_t)MTOT * D * 4 <= (WS_BB - WS_DEC), "O alias");
static_assert(WS_END <= (size_t)256 * 1024 * 1024, "workspace too big");

constexpr size_t OUT_X = 0;
constexpr size_t OUT_AK = (size_t)MTOT * D;
constexpr size_t OUT_AV = OUT_AK + 2097152;
constexpr size_t OUT_BK = OUT_AV + 2097152;
constexpr size_t OUT_BV = OUT_BK + 2097152;
constexpr size_t OUT_ST = OUT_BV + 2097152;

struct Params {
  const float *x_prompt, *x_sample, *cache_a_k, *cache_a_v, *cache_b_k, *cache_b_v, *state_c, *c, *c_ctx,
      *w_mod, *b_mod, *norm_mix_pre, *norm_mix_post, *norm_ffn_pre, *norm_ffn_post, *w_in, *w_out, *a_sink,
      *b_q_norm, *b_k_norm, *c_w0, *c_w_up, *c_a0, *c_a_up, *c_g_up, *c_k_k, *c_k_a, *c_r_k, *c_ln_w, *c_ln_b,
      *w_gu, *w_down;
  float* out;
  unsigned char* ws;
  int ph_lo, ph_hi;
};

typedef __bf16 bf16x2_t __attribute__((ext_vector_type(2)));
typedef float f32x2_t __attribute__((ext_vector_type(2)));
__device__ __forceinline__ unsigned pk_bf16(float lo, float hi) {
  f32x2_t f = {lo, hi};
  bf16x2_t b = __builtin_convertvector(f, bf16x2_t);
  return __builtin_bit_cast(unsigned, b);
}
__device__ __forceinline__ bf16_t f2bf(float f) { return (bf16_t)(pk_bf16(f, 0.f) & 0xffffu); }
__device__ __forceinline__ float bf2f(bf16_t b) { return __uint_as_float(((unsigned)b) << 16); }
__device__ __forceinline__ float bflo(unsigned u) { return __uint_as_float(u << 16); }
__device__ __forceinline__ float bfhi(unsigned u) { return __uint_as_float(u & 0xffff0000u); }
__device__ __forceinline__ int opq_tid() { int x = threadIdx.x; asm volatile("" : "+v"(x)); return x; }
__device__ __forceinline__ int opq_bid() { int x = blockIdx.x; asm volatile("" : "+s"(x)); return x; }
__device__ __forceinline__ float4 cvt4(uint2 u) { return make_float4(bflo(u.x), bfhi(u.x), bflo(u.y), bfhi(u.y)); }
__device__ __forceinline__ float frcp(float x) { return __builtin_amdgcn_rcpf(x); }
__device__ __forceinline__ float sigmoidf_(float x) { return frcp(1.f + __expf(-x)); }
__device__ __forceinline__ float wave_sum(float v) {
#pragma unroll
  for (int o = 1; o < 64; o <<= 1) v += __shfl_xor(v, o);
  return v;
}
template <int CTRL>
__device__ __forceinline__ float dppf(float x) {
  return __builtin_bit_cast(float, __builtin_amdgcn_mov_dpp(__builtin_bit_cast(int, x), CTRL, 0xf, 0xf, true));
}
constexpr int DPP_XOR1 = 0xB1, DPP_XOR2 = 0x4E, DPP_ROR4 = 0x124, DPP_ROR8 = 0x128;
__device__ __forceinline__ float row16_sum(float v) {
  v += dppf<DPP_XOR1>(v);
  v += dppf<DPP_XOR2>(v);
  v += dppf<DPP_ROR4>(v);
  v += dppf<DPP_ROR8>(v);
  return v;
}
__device__ __forceinline__ f32x4 mfma16(bf16x8 a, bf16x8 b, f32x4 c) {
  return __builtin_amdgcn_mfma_f32_16x16x32_bf16(a, b, c, 0, 0, 0);
}

__device__ __forceinline__ void transpose_tile(const float* __restrict__ src, int K, int N, bf16_t* __restrict__ dst,
                                               int tile, bool perm, float* lds) {
  const int nkt = K / 64, nnt = N / 64, per = nkt * nnt;
  const int lyr = tile / per, r = tile % per, kt = r / nnt, nt = r % nnt;
  src += (size_t)lyr * K * N;
  dst += (size_t)lyr * K * N;
  const int tid = opq_tid();
#pragma unroll
  for (int i = 0; i < 16; ++i) {
    const int row = (tid >> 6) + 4 * i;
    lds[row * 65 + (tid & 63)] = src[(size_t)(kt * 64 + row) * N + nt * 64 + (tid & 63)];
  }
  __syncthreads();
#pragma unroll
  for (int it = 0; it < 2; ++it) {
    const int idx = tid + it * 256, n = idx >> 3, kc = idx & 7;
    uint4 v;
    v.x = pk_bf16(lds[(kc * 8 + 0) * 65 + n], lds[(kc * 8 + 1) * 65 + n]);
    v.y = pk_bf16(lds[(kc * 8 + 2) * 65 + n], lds[(kc * 8 + 3) * 65 + n]);
    v.z = pk_bf16(lds[(kc * 8 + 4) * 65 + n], lds[(kc * 8 + 5) * 65 + n]);
    v.w = pk_bf16(lds[(kc * 8 + 6) * 65 + n], lds[(kc * 8 + 7) * 65 + n]);
    const int col = nt * 64 + n;
    int prow = col;
    if (perm) {
      if (col < FF) prow = (col >> 5) * 64 + (col & 31);
      else { const int c2 = col - FF; prow = (c2 >> 5) * 64 + 32 + (c2 & 31); }
    }
    *(uint4*)(dst + (size_t)prow * K + kt * 64 + kc * 8) = v;
  }
  __syncthreads();
}

__device__ __forceinline__ void gemv_item(const Params& p, int item, float* lds) {
  const int l = item / 192, n0 = (item % 192) * 32;
  const int tid = opq_tid();
  float* s_c = lds;
  float* red = lds + 3072;
  for (int i = tid; i < 3072; i += 256) {
    const int ci = i >> 10, k = i & 1023;
    const float x = (ci == 0) ? p.c_ctx[k] : p.c[(ci - 1) * 1024 + k];
    s_c[i] = x * sigmoidf_(x);
  }
  __syncthreads();
  const int kg = tid >> 5, col = tid & 31;
  const float* w = p.w_mod + (size_t)l * 1024 * 6144 + (size_t)(kg * 128) * 6144 + n0 + col;
  float a0 = 0.f, a1 = 0.f, a2 = 0.f;
#pragma unroll 32
  for (int k = 0; k < 128; ++k) {
    const float wv = __builtin_nontemporal_load(w + (size_t)k * 6144);
    a0 += s_c[kg * 128 + k] * wv;
    a1 += s_c[1024 + kg * 128 + k] * wv;
    a2 += s_c[2048 + kg * 128 + k] * wv;
  }
  red[(kg * 3 + 0) * 32 + col] = a0;
  red[(kg * 3 + 1) * 32 + col] = a1;
  red[(kg * 3 + 2) * 32 + col] = a2;
  __syncthreads();
  if (tid < 96) {
    const int ci = tid >> 5, cc = tid & 31;
    float sum = p.b_mod[l * 6144 + n0 + cc];
#pragma unroll
    for (int g = 0; g < 8; ++g) sum += red[(g * 3 + ci) * 32 + cc];
    ((float*)(p.ws + WS_MOD))[(l * 3 + ci) * 6144 + n0 + cc] = sum;
  }
  __syncthreads();
}

constexpr int WL_IN = 16 * 40, WL_OUT = 16 * 16, WL_GU = 16 * 88, WL_DN = 44 * 16, WL_UP = 2 * 6, WL_G = 2 * 6;
constexpr int WL_TOTAL = WL_IN + WL_OUT + WL_GU + WL_DN + 2 * WL_UP + WL_G;
__device__ __forceinline__ void weight_item(const Params& p, int layer, int r, float* lds) {
  if (r < WL_IN) { transpose_tile(p.w_in, 1024, IN_COLS, (bf16_t*)(p.ws + WS_WT_IN), layer * WL_IN + r, false, lds); return; }
  r -= WL_IN;
  if (r < WL_OUT) { transpose_tile(p.w_out, 1024, 1024, (bf16_t*)(p.ws + WS_WT_OUT), layer * WL_OUT + r, false, lds); return; }
  r -= WL_OUT;
  if (r < WL_GU) { transpose_tile(p.w_gu, 1024, GU, (bf16_t*)(p.ws + WS_WT_GU), layer * WL_GU + r, true, lds); return; }
  r -= WL_GU;
  if (r < WL_DN) { transpose_tile(p.w_down, FF, 1024, (bf16_t*)(p.ws + WS_WT_DN), layer * WL_DN + r, false, lds); return; }
  r -= WL_DN;
  if (r < WL_UP) { transpose_tile(p.c_w_up, 64, 384, (bf16_t*)(p.ws + WS_WUPT), layer * WL_UP + r, false, lds); return; }
  r -= WL_UP;
  if (r < WL_UP) { transpose_tile(p.c_a_up, 64, 384, (bf16_t*)(p.ws + WS_AUPT), layer * WL_UP + r, false, lds); return; }
  r -= WL_UP;
  transpose_tile(p.c_g_up, 128, 384, (bf16_t*)(p.ws + WS_GUPT), layer * WL_G + r, false, lds);
}

constexpr int P0_GEMV = 384;
constexpr int P0_ROPE = 128, P0_CACHE = 256;
constexpr int P0_TOTAL = P0_GEMV + WL_TOTAL + P0_ROPE + P0_CACHE;

__device__ __forceinline__ void phase0(const Params& p, unsigned char* smem) {
  float* lds = (float*)smem;
  const int tid = opq_tid();
  const int bid = opq_bid();
  if (bid == 0 && tid < 64) ((unsigned*)(p.ws + WS_CNT))[tid] = 0u;
  for (int it = bid; it < P0_TOTAL; it += gridDim.x) {
    int r = it;
    if (r < P0_GEMV) { gemv_item(p, r, lds); continue; }
    r -= P0_GEMV;
    if (r < WL_TOTAL) { weight_item(p, 0, r, lds); continue; }
    r -= WL_TOTAL;
    if (r < P0_ROPE) {
      const int idx = r * 256 + tid, t = idx >> 5, i = idx & 31, fi = i & 15;
      const float pos = (i < 16) ? (float)(t >> 6) : (float)(t & 63);
      const float freq = exp2f(-(float)fi * (13.287712379549449f / 16.f));
      float rev = pos * freq * 0.15915494309189535f;
      rev -= floorf(rev);
      float2 cs;
      cs.x = __builtin_amdgcn_cosf(rev);
      cs.y = __builtin_amdgcn_sinf(rev);
      ((float2*)(p.ws + WS_ROPE))[idx] = cs;
      continue;
    }
    r -= P0_ROPE;
    {
#pragma unroll
      for (int j = 0; j < 8; ++j) {
        const int idx = r * 2048 + j * 256 + tid;
        const int tensor = idx >> 17, e = idx & 131071;
        const float* src = tensor == 0 ? p.cache_a_k : tensor == 1 ? p.cache_a_v : tensor == 2 ? p.cache_b_k : p.cache_b_v;
        bf16_t* dst = (bf16_t*)(p.ws + (tensor == 0 ? WS_CKA : tensor == 1 ? WS_CVTA : tensor == 2 ? WS_CKB : WS_CVTB));
        int b, l, h, t, d;
        if ((tensor & 1) == 0) { d = e & 63; t = (e >> 6) & 255; h = (e >> 14) & 1; l = (e >> 15) & 1; b = e >> 16; }
        else { t = e & 255; d = (e >> 8) & 63; h = (e >> 14) & 1; l = (e >> 15) & 1; b = e >> 16; }
        dst[e] = f2bf(src[((((size_t)b * 2 + l) * 256 + t) * 2 + h) * 64 + d]);
      }
    }
  }
}

__device__ __forceinline__ void rpass(const Params& p, int mode, int l) {
  const int tid_ = opq_tid(); const int lane = tid_ & 63, wave = tid_ >> 6;
  const float* MOD = (const float*)(p.ws + WS_MOD);
  const bf16_t* O = (const bf16_t*)(p.ws + WS_DEC);
  float* X = p.out + OUT_X;
  bf16_t* H = (bf16_t*)(p.ws + WS_H);
  for (int row = opq_bid() * 4 + wave; row < MTOT; row += gridDim.x * 4) {
    const int ci = row < M_CTX ? 0 : 1 + ((row - M_CTX) >> 10);
    const float* xs;
    if (mode == 0 || (mode == 1 && l == 0)) xs = row < M_CTX ? p.x_prompt + (size_t)row * D : p.x_sample + (size_t)(row - M_CTX) * D;
    else xs = X + (size_t)row * D;
    float4 x[4];
#pragma unroll
    for (int j = 0; j < 4; ++j) x[j] = *(const float4*)(xs + j * 256 + lane * 4);
    if (mode != 0) {
      float4 o[4];
      float ss = 0.f;
#pragma unroll
      for (int j = 0; j < 4; ++j) {
        o[j] = cvt4(*(const uint2*)(O + (size_t)row * D + j * 256 + lane * 4));
        ss += o[j].x * o[j].x + o[j].y * o[j].y + o[j].z * o[j].z + o[j].w * o[j].w;
      }
      ss = wave_sum(ss);
      const float rs = __builtin_amdgcn_rsqf(ss * (1.f / D) + 1e-6f);
      const float* gate = MOD + (l * 3 + ci) * 6144 + (mode == 1 ? 2 : 5) * 1024;
      const float* gp = (mode == 1 ? p.norm_mix_post : p.norm_ffn_post) + l * D;
#pragma unroll
      for (int j = 0; j < 4; ++j) {
        const float4 g = *(const float4*)(gate + j * 256 + lane * 4);
        const float4 w = *(const float4*)(gp + j * 256 + lane * 4);
        x[j].x += g.x * (o[j].x * rs * w.x);
        x[j].y += g.y * (o[j].y * rs * w.y);
        x[j].z += g.z * (o[j].z * rs * w.z);
        x[j].w += g.w * (o[j].w * rs * w.w);
        *(float4*)(X + (size_t)row * D + j * 256 + lane * 4) = x[j];
      }
    }
    if (mode == 2 && l == 1) continue;
    const int nl = (mode == 2) ? l + 1 : l;
    float ss2 = 0.f;
#pragma unroll
    for (int j = 0; j < 4; ++j) ss2 += x[j].x * x[j].x + x[j].y * x[j].y + x[j].z * x[j].z + x[j].w * x[j].w;
    ss2 = wave_sum(ss2);
    const float rs2 = __builtin_amdgcn_rsqf(ss2 * (1.f / D) + 1e-6f);
    const float* gpre = (mode == 1 ? p.norm_ffn_pre : p.norm_mix_pre) + nl * D;
    const float* sc = MOD + (nl * 3 + ci) * 6144 + (mode == 1 ? 4 : 1) * 1024;
    const float* sh = MOD + (nl * 3 + ci) * 6144 + (mode == 1 ? 3 : 0) * 1024;
#pragma unroll
    for (int j = 0; j < 4; ++j) {
      const float4 g = *(const float4*)(gpre + j * 256 + lane * 4);
      const float4 s = *(const float4*)(sc + j * 256 + lane * 4);
      const float4 t = *(const float4*)(sh + j * 256 + lane * 4);
      const float h0 = x[j].x * rs2 * g.x * (1.f + s.x) + t.x;
      const float h1 = x[j].y * rs2 * g.y * (1.f + s.y) + t.y;
      const float h2 = x[j].z * rs2 * g.z * (1.f + s.z) + t.z;
      const float h3 = x[j].w * rs2 * g.w * (1.f + s.w) + t.w;
      uint2 v;
      v.x = pk_bf16(h0, h1);
      v.y = pk_bf16(h2, h3);
      *(uint2*)(H + (size_t)row * D + j * 256 + lane * 4) = v;
    }
  }
}

__device__ __forceinline__ void epi_f32(const Params& p, f32x4 (&acc)[4][4], int rb, int cb, int lane) {
  const int fr = lane & 15, fq = lane >> 4;
  float* O = (float*)(p.ws + WS_DEC);
#pragma unroll
  for (int m = 0; m < 4; ++m)
#pragma unroll
    for (int n = 0; n < 4; ++n)
#pragma unroll
      for (int j = 0; j < 4; ++j) O[(size_t)(rb + m * 16 + fq * 4 + j) * D + cb + n * 16 + fr] = acc[m][n][j];
}

__device__ __forceinline__ void epi_gu(const Params& p, f32x4 (&acc)[4][4], int rb, int cb, int lane) {
  const int fr = lane & 15, fq = lane >> 4;
  bf16_t* ACT = (bf16_t*)(p.ws + WS_CZ);
  const int chunk = cb >> 6;
#pragma unroll
  for (int m = 0; m < 4; ++m)
#pragma unroll
    for (int n = 0; n < 2; ++n)
#pragma unroll
      for (int j = 0; j < 4; ++j) {
        const float g = acc[m][n][j], u = acc[m][n + 2][j];
        const float a = g * sigmoidf_(g) * u;
        ACT[(size_t)(rb + m * 16 + fq * 4 + j) * FF + chunk * 32 + n * 16 + fr] = f2bf(a);
      }
}

__device__ __forceinline__ void epi_in(const Params& p, int l, f32x4 (&acc)[4][4], int rb, int cb, int lane) {
  const int fr = lane & 15, fq = lane >> 4;
  const int cidx = cb >> 6;
  const bool lat = rb >= M_CTX;
  if (cidx >= 18) {
    float* CZ = (float*)(p.ws + WS_CZ);
    const int cc = cb - 1152;
#pragma unroll
    for (int m = 0; m < 4; ++m)
#pragma unroll
      for (int n = 0; n < 4; ++n)
#pragma unroll
        for (int j = 0; j < 4; ++j) CZ[(size_t)(rb + m * 16 + fq * 4 + j) * 1408 + cc + n * 16 + fr] = acc[m][n][j];
    return;
  }
  if (cidx >= 8 && cidx < 16) {
    const float* gw = (cidx < 14 ? p.b_q_norm : p.b_k_norm) + l * 64;
    float g[4];
#pragma unroll
    for (int n = 0; n < 4; ++n) g[n] = gw[n * 16 + fr];
#pragma unroll
    for (int m = 0; m < 4; ++m)
#pragma unroll
      for (int j = 0; j < 4; ++j) {
        float ss = 0.f;
#pragma unroll
        for (int n = 0; n < 4; ++n) ss += acc[m][n][j] * acc[m][n][j];
        ss = row16_sum(ss);
        const float rs = __builtin_amdgcn_rsqf(ss * (1.f / 64.f) + 1e-6f);
#pragma unroll
        for (int n = 0; n < 4; ++n) acc[m][n][j] *= rs * g[n];
      }
  }
  const bool isv = (cidx == 6 || cidx == 7 || cidx == 16 || cidx == 17);
  if (lat && !isv) {
    const float2* ROPE = (const float2*)(p.ws + WS_ROPE);
#pragma unroll
    for (int m = 0; m < 4; ++m)
#pragma unroll
      for (int j = 0; j < 4; ++j) {
        const int t = (rb + m * 16 + fq * 4 + j - M_CTX) & 1023;
        const float2 a0 = ROPE[t * 32 + fr], a1 = ROPE[t * 32 + 16 + fr];
        float x1 = acc[m][0][j], x2 = acc[m][2][j];
        acc[m][0][j] = x1 * a0.x - x2 * a0.y;
        acc[m][2][j] = x1 * a0.y + x2 * a0.x;
        x1 = acc[m][1][j]; x2 = acc[m][3][j];
        acc[m][1][j] = x1 * a1.x - x2 * a1.y;
        acc[m][3][j] = x1 * a1.y + x2 * a1.x;
      }
  }
  if (!isv) {
    bf16_t* QK = (bf16_t*)(p.ws + WS_QK);
    const int qc = (cidx < 6) ? cb : cb - 128;
#pragma unroll
    for (int m = 0; m < 4; ++m)
#pragma unroll
      for (int n = 0; n < 4; ++n)
#pragma unroll
        for (int j = 0; j < 4; ++j) QK[(size_t)(rb + m * 16 + fq * 4 + j) * 896 + qc + n * 16 + fr] = f2bf(acc[m][n][j]);
    if (!lat && (cidx == 4 || cidx == 5 || cidx == 14 || cidx == 15)) {
      float* dst = p.out + (cidx < 6 ? OUT_AK : OUT_BK);
      const int h = cidx & 1;
#pragma unroll
      for (int m = 0; m < 4; ++m)
#pragma unroll
        for (int n = 0; n < 4; ++n)
#pragma unroll
          for (int j = 0; j < 4; ++j) {
            const int row = rb + m * 16 + fq * 4 + j, b = row >> 8, t = row & 255;
            dst[((((size_t)b * 2 + l) * 256 + t) * 2 + h) * 64 + n * 16 + fr] = acc[m][n][j];
          }
    }
  } else {
    bf16_t* VT = (bf16_t*)(p.ws + WS_VT);
    const int vh = (cidx < 8) ? cidx - 6 : 2 + cidx - 16;
#pragma unroll
    for (int m = 0; m < 4; ++m)
#pragma unroll
      for (int n = 0; n < 4; ++n) {
        uint2 v;
        v.x = pk_bf16(acc[m][n][0], acc[m][n][1]);
        v.y = pk_bf16(acc[m][n][2], acc[m][n][3]);
        *(uint2*)(VT + ((size_t)(vh * 64 + n * 16 + fr)) * MTOT + rb + m * 16 + fq * 4) = v;
      }
    if (!lat) {
      float* dst = p.out + (cidx < 8 ? OUT_AV : OUT_BV);
      const int h = cidx & 1;
#pragma unroll
      for (int m = 0; m < 4; ++m)
#pragma unroll
        for (int n = 0; n < 4; ++n)
#pragma unroll
          for (int j = 0; j < 4; ++j) {
            const int row = rb + m * 16 + fq * 4 + j, b = row >> 8, t = row & 255;
            dst[((((size_t)b * 2 + l) * 256 + t) * 2 + h) * 64 + n * 16 + fr] = acc[m][n][j];
          }
    }
  }
}

template <int EPI>
__device__ __forceinline__ void gemm_phase(const Params& p, int l, const bf16_t* __restrict__ A, int lda,
                                           const bf16_t* __restrict__ Bt, int ldb, int N, int K, unsigned char* smem) {
  const int tid = opq_tid(), lane = tid & 63, wid = tid >> 6, wr = wid >> 1, wc = wid & 1, fr = lane & 15, fq = lane >> 4;
  const int bid = opq_bid();
  const int nN = N / 128, ntiles = (MTOT / 128) * nN;
  const int G = gridDim.x, per = G >> 3;
  const int srow = wid * 32 + (lane >> 3);
  const int sw = (fr >> 1) & 7;
  const int nk = K / 64;
  for (int base = 0; base < ntiles; base += G) {
    const int tile = base + (bid & 7) * per + (bid >> 3);
    if (tile >= ntiles) {
      if (EPI == 0 && l == 0) {
        const int nidle = base + G - ntiles;
        for (int it = tile - ntiles; it < WL_TOTAL; it += nidle) weight_item(p, 1, it, (float*)smem);
      }
      continue;
    }
    const int patch = tile >> 5, within = tile & 31, nPN = nN >> 2;
    const int mt = (patch / nPN) * 8 + (within >> 2), nt = (patch % nPN) * 4 + (within & 3);
    const int brow = mt * 128, bcol = nt * 128;
    f32x4 acc[4][4];
#pragma unroll
    for (int m = 0; m < 4; ++m)
#pragma unroll
      for (int n = 0; n < 4; ++n) acc[m][n] = (f32x4){0.f, 0.f, 0.f, 0.f};
    const bf16_t* ga = A + (size_t)(brow + srow) * lda;
    const bf16_t* gb = Bt + (size_t)(bcol + srow) * ldb;
#define GEMM_STAGE(bufi, kt_)                                                                                     \
  {                                                                                                               \
    unsigned char* sa_ = smem + (bufi) * 32768 + wid * 4096 + lane * 16;                                          \
    _Pragma("unroll") for (int i_ = 0; i_ < 4; ++i_) {                                                            \
      const int c_ = (lane & 7) ^ (((srow + i_ * 8) >> 1) & 7);                                                   \
      __builtin_amdgcn_global_load_lds((const unsigned*)(ga + (size_t)(i_ * 8) * lda + (kt_) * 64 + c_ * 8),      \
                                       (unsigned*)(sa_ + i_ * 1024), 16, 0, 0);                                   \
      __builtin_amdgcn_global_load_lds((const unsigned*)(gb + (size_t)(i_ * 8) * ldb + (kt_) * 64 + c_ * 8),      \
                                       (unsigned*)(sa_ + 16384 + i_ * 1024), 16, 0, 0);                           \
    }                                                                                                             \
  }
    __syncthreads();
    GEMM_STAGE(0, 0);
    for (int kt = 0; kt < nk; ++kt) {
      asm volatile("s_waitcnt vmcnt(0)" ::: "memory");
      __syncthreads();
      if (kt + 1 < nk) GEMM_STAGE((kt + 1) & 1, kt + 1);
      const unsigned char* sA = smem + (kt & 1) * 32768;
      const unsigned char* sB = sA + 16384;
#pragma unroll
      for (int s = 0; s < 2; ++s) {
        bf16x8 a[4], b[4];
        const int co = ((s * 4 + fq) ^ sw) << 4;
#pragma unroll
        for (int m = 0; m < 4; ++m) a[m] = *(const bf16x8*)(sA + (wr * 64 + m * 16 + fr) * 128 + co);
#pragma unroll
        for (int n = 0; n < 4; ++n) b[n] = *(const bf16x8*)(sB + (wc * 64 + n * 16 + fr) * 128 + co);
        __builtin_amdgcn_s_setprio(1);
#pragma unroll
        for (int m = 0; m < 4; ++m)
#pragma unroll
          for (int n = 0; n < 4; ++n) acc[m][n] = mfma16(a[m], b[n], acc[m][n]);
        __builtin_amdgcn_s_setprio(0);
      }
    }
    const int rb = brow + wr * 64, cb = bcol + wc * 64;
    if constexpr (EPI == 0) epi_in(p, l, acc, rb, cb, lane);
    else if constexpr (EPI == 1) epi_f32(p, acc, rb, cb, lane);
    else epi_gu(p, acc, rb, cb, lane);
  }
}

constexpr int G160_BUF = 36864;
__device__ __forceinline__ void gemm160_phase(const Params& p, const bf16_t* __restrict__ A, int lda,
                                              const bf16_t* __restrict__ Bt, int ldb, int K, unsigned char* smem) {
  const int tid = opq_tid(), lane = tid & 63, wid = tid >> 6, wr = wid >> 1, wc = wid & 1, fr = lane & 15, fq = lane >> 4;
  const int bid = opq_bid();
  constexpr int nN = 8, ntiles = 64 * nN;
  const int G = gridDim.x, per = G >> 3;
  const int sw = (fr >> 1) & 7;
  const int nk = K / 64;
  const int lrow = lane >> 3;
  bf16_t* O = (bf16_t*)(p.ws + WS_DEC);
  for (int base = 0; base < ntiles; base += G) {
    const int tile = base + (bid & 7) * per + (bid >> 3);
    if (tile >= ntiles) continue;
    const int mt = tile / nN, nt = tile % nN;
    const int brow = mt * 160, bcol = nt * 128;
    f32x4 acc[5][4];
#pragma unroll
    for (int m = 0; m < 5; ++m)
#pragma unroll
      for (int n = 0; n < 4; ++n) acc[m][n] = (f32x4){0.f, 0.f, 0.f, 0.f};
    const bf16_t* ga = A + (size_t)(brow + lrow) * lda;
    const bf16_t* gb = Bt + (size_t)(bcol + wid * 32 + lrow) * ldb;
#define GEMM160_STAGE(bufi, kt_)                                                                                  \
  {                                                                                                               \
    unsigned char* sb_ = smem + (bufi) * G160_BUF;                                                                \
    _Pragma("unroll") for (int i_ = 0; i_ < 5; ++i_) {                                                            \
      const int pc_ = wid + i_ * 4;                                                                               \
      const int c_ = (lane & 7) ^ (((pc_ * 8 + lrow) >> 1) & 7);                                                  \
      __builtin_amdgcn_global_load_lds((const unsigned*)(ga + (size_t)(pc_ * 8) * lda + (kt_) * 64 + c_ * 8),     \
                                       (unsigned*)(sb_ + pc_ * 1024 + lane * 16), 16, 0, 0);                      \
    }                                                                                                             \
    _Pragma("unroll") for (int i_ = 0; i_ < 4; ++i_) {                                                            \
      const int c_ = (lane & 7) ^ (((wid * 32 + i_ * 8 + lrow) >> 1) & 7);                                        \
      __builtin_amdgcn_global_load_lds((const unsigned*)(gb + (size_t)(i_ * 8) * ldb + (kt_) * 64 + c_ * 8),      \
                                       (unsigned*)(sb_ + 20480 + wid * 4096 + i_ * 1024 + lane * 16), 16, 0, 0);  \
    }                                                                                                             \
  }
    __syncthreads();
    GEMM160_STAGE(0, 0);
    for (int kt = 0; kt < nk; ++kt) {
      asm volatile("s_waitcnt vmcnt(0)" ::: "memory");
      __syncthreads();
      if (kt + 1 < nk) GEMM160_STAGE((kt + 1) & 1, kt + 1);
      const unsigned char* sA = smem + (kt & 1) * G160_BUF;
      const unsigned char* sB = sA + 20480;
#pragma unroll
      for (int s = 0; s < 2; ++s) {
        bf16x8 a[5], b[4];
        const int co = ((s * 4 + fq) ^ sw) << 4;
#pragma unroll
        for (int m = 0; m < 5; ++m) a[m] = *(const bf16x8*)(sA + (wr * 80 + m * 16 + fr) * 128 + co);
#pragma unroll
        for (int n = 0; n < 4; ++n) b[n] = *(const bf16x8*)(sB + (wc * 64 + n * 16 + fr) * 128 + co);
        __builtin_amdgcn_s_setprio(1);
#pragma unroll
        for (int m = 0; m < 5; ++m)
#pragma unroll
          for (int n = 0; n < 4; ++n) acc[m][n] = mfma16(a[m], b[n], acc[m][n]);
        __builtin_amdgcn_s_setprio(0);
      }
    }
#pragma unroll
    for (int m = 0; m < 5; ++m)
#pragma unroll
      for (int n = 0; n < 4; ++n)
#pragma unroll
        for (int j = 0; j < 4; ++j)
          O[(size_t)(brow + wr * 80 + m * 16 + fq * 4 + j) * D + bcol + wc * 64 + n * 16 + fr] = f2bf(acc[m][n][j]);
  }
}

template <int FN>
__device__ __forceinline__ float xform(float t) {
  if (FN == 1) { const float e = __expf(2.f * t); return 1.f - 2.f * frcp(e + 1.f); }
  if (FN == 2) return sigmoidf_(t);
  return t;
}
template <int FN>
__device__ __forceinline__ bf16x8 ld_frag_f32(const float* src) {
  const float4 u = *(const float4*)src, v = *(const float4*)(src + 4);
  union { uint4 u4; bf16x8 v8; } r;
  r.u4.x = pk_bf16(xform<FN>(u.x), xform<FN>(u.y));
  r.u4.y = pk_bf16(xform<FN>(u.z), xform<FN>(u.w));
  r.u4.z = pk_bf16(xform<FN>(v.x), xform<FN>(v.y));
  r.u4.w = pk_bf16(xform<FN>(v.z), xform<FN>(v.w));
  return r.v8;
}

__device__ __forceinline__ void prep_phase(const Params& p, int l, unsigned char* smem) {
  const int tid = opq_tid(), lane = tid & 63, wid = tid >> 6, fr = lane & 15, fq = lane >> 4;
  const float* CZ = (const float*)(p.ws + WS_CZ);
  float* DEC = (float*)(p.ws + WS_DEC);
  bf16_t* KT = (bf16_t*)(p.ws + WS_KT);
  bf16_t* BB = (bf16_t*)(p.ws + WS_BB);
  bf16_t* KK = (bf16_t*)(p.ws + WS_KK);
  bf16_t* Gb = (bf16_t*)(p.ws + WS_G);
  float* BON = (float*)(p.ws + WS_BON);
  const bf16_t* WUPT = (const bf16_t*)(p.ws + WS_WUPT);
  const bf16_t* AUPT = (const bf16_t*)(p.ws + WS_AUPT);
  const bf16_t* GUPT = (const bf16_t*)(p.ws + WS_GUPT);
  const int swz = (fr >> 1) & 7;
  for (int u = opq_bid(); u < 80 * 6; u += gridDim.x) {
    const int tile = u / 6, h = u % 6;
    __syncthreads();
    {
      uint4 tw_[4], tg_[4];
#pragma unroll
      for (int i = 0; i < 4; ++i) {
        const bf16_t* src = (i < 2 ? WUPT : AUPT) + ((unsigned)(l * 2 + (i & 1)) * 384 + h * 64) * 64;
        const int pc0 = tid, pc1 = tid + 256;
        const uint4 v0 = *(const uint4*)(src + (pc0 >> 3) * 64 + (pc0 & 7) * 8);
        const uint4 v1 = *(const uint4*)(src + (pc1 >> 3) * 64 + (pc1 & 7) * 8);
        tw_[i] = v0; tg_[i] = v1;
      }
#pragma unroll
      for (int i = 0; i < 4; ++i) {
        const int pc0 = tid, pc1 = tid + 256;
        *(uint4*)(smem + i * 8192 + (pc0 >> 3) * 128 + (((pc0 & 7) ^ (((pc0 >> 3) >> 1) & 7)) << 4)) = tw_[i];
        *(uint4*)(smem + i * 8192 + (pc1 >> 3) * 128 + (((pc1 & 7) ^ (((pc1 >> 3) >> 1) & 7)) << 4)) = tg_[i];
      }
#pragma unroll
      for (int i = 0; i < 4; ++i) {
        const int pc = tid + i * 256, col = pc >> 4, chn = pc & 15;
        const uint4 v = *(const uint4*)(GUPT + ((unsigned)l * 384 + h * 64 + col) * 128 + chn * 8);
        *(uint4*)(smem + 32768 + col * 256 + ((chn ^ (col & 15)) << 4)) = v;
      }
    }
    __syncthreads();
#pragma unroll 1
    for (int mb = 0; mb < 2; ++mb) {
      const int rb = tile * 128 + wid * 32 + mb * 16;
      const int arow = rb + fr;
      bf16x8 ftw[2], fxa[2];
#pragma unroll
      for (int ks = 0; ks < 2; ++ks) {
        ftw[ks] = ld_frag_f32<1>(CZ + (unsigned)arow * 1408 + 1152 + ks * 32 + fq * 8);
        fxa[ks] = ld_frag_f32<0>(CZ + (unsigned)arow * 1408 + 1216 + ks * 32 + fq * 8);
      }
      float kv[4][4], rv[4][4], kkn[4][4], bon[4];
      float kkw[4], kaw[4], rkw[4];
#pragma unroll
      for (int n = 0; n < 4; ++n) {
        kkw[n] = p.c_k_k[l * 384 + h * 64 + n * 16 + fr];
        kaw[n] = p.c_k_a[l * 384 + h * 64 + n * 16 + fr];
        rkw[n] = p.c_r_k[l * 384 + h * 64 + n * 16 + fr];
      }
#pragma unroll
      for (int j = 0; j < 4; ++j) {
        const int row = rb + fq * 4 + j;
        float ss = 0.f;
#pragma unroll
        for (int n = 0; n < 4; ++n) {
          kv[n][j] = CZ[(unsigned)row * 1408 + 384 + h * 64 + n * 16 + fr];
          rv[n][j] = CZ[(unsigned)row * 1408 + h * 64 + n * 16 + fr];
          kkn[n][j] = kv[n][j] * kkw[n];
          ss += kkn[n][j] * kkn[n][j];
        }
        ss = row16_sum(ss);
        const float rs = __builtin_amdgcn_rsqf(ss + 1e-12f);
#pragma unroll
        for (int n = 0; n < 4; ++n) {
          kkn[n][j] *= rs;
          KK[(unsigned)row * 384 + h * 64 + n * 16 + fr] = f2bf(kkn[n][j]);
        }
        bon[j] = 0.f;
      }
#pragma unroll 1
      for (int d = 0; d < 2; ++d) {
        f32x4 aw[4], aa[4];
#pragma unroll
        for (int n = 0; n < 4; ++n) {
          aw[n] = (f32x4){0.f, 0.f, 0.f, 0.f};
          aa[n] = (f32x4){0.f, 0.f, 0.f, 0.f};
          const int col = h * 64 + n * 16 + fr;
#pragma unroll
          for (int ks = 0; ks < 2; ++ks) {
            const bf16x8 bw = *(const bf16x8*)(smem + d * 8192 + (n * 16 + fr) * 128 + (((ks * 4 + fq) ^ swz) << 4));
            const bf16x8 ba = *(const bf16x8*)(smem + 16384 + d * 8192 + (n * 16 + fr) * 128 + (((ks * 4 + fq) ^ swz) << 4));
            aw[n] = mfma16(ftw[ks], bw, aw[n]);
            aa[n] = mfma16(fxa[ks], ba, aa[n]);
          }
        }
#pragma unroll
        for (int n = 0; n < 4; ++n) {
          const int col = h * 64 + n * 16 + fr;
          const float w0 = p.c_w0[(l * 2 + d) * 384 + col], a0 = p.c_a0[(l * 2 + d) * 384 + col];
#pragma unroll
          for (int j = 0; j < 4; ++j) {
            const int row = rb + fq * 4 + j;
            const float dec = __expf(-0.6065306597126334f * sigmoidf_(aw[n][j] + w0));
            const float a = sigmoidf_(aa[n][j] + a0);
            const float kt = kv[n][j] * (1.f + (a - 1.f) * kaw[n]);
            DEC[((unsigned)d * MTOT + row) * 384 + col] = dec;
            KT[((unsigned)d * MTOT + row) * 384 + col] = f2bf(kt);
            BB[((unsigned)d * MTOT + row) * 384 + col] = f2bf(kkn[n][j] * a);
            bon[j] += rv[n][j] * kt * rkw[n];
          }
        }
      }
#pragma unroll
      for (int j = 0; j < 4; ++j) {
        const float b = row16_sum(bon[j]);
        if (fr == 0) BON[(unsigned)(rb + fq * 4 + j) * 8 + h] = b;
      }
      f32x4 ag[4];
#pragma unroll
      for (int n = 0; n < 4; ++n) ag[n] = (f32x4){0.f, 0.f, 0.f, 0.f};
#pragma unroll
      for (int ks = 0; ks < 4; ++ks) {
        const bf16x8 fa = ld_frag_f32<2>(CZ + (unsigned)arow * 1408 + 1280 + ks * 32 + fq * 8);
#pragma unroll
        for (int n = 0; n < 4; ++n) {
          const int col = h * 64 + n * 16 + fr;
          const bf16x8 bg = *(const bf16x8*)(smem + 32768 + (n * 16 + fr) * 256 + (((ks * 4 + fq) ^ fr) << 4));
          ag[n] = mfma16(fa, bg, ag[n]);
        }
      }
#pragma unroll
      for (int n = 0; n < 4; ++n)
#pragma unroll
        for (int j = 0; j < 4; ++j) Gb[(unsigned)(rb + fq * 4 + j) * 384 + h * 64 + n * 16 + fr] = f2bf(ag[n][j]);
    }
  }
}


typedef float f32x2 __attribute__((ext_vector_type(2)));
__device__ __forceinline__ f32x2 fma2(f32x2 a, f32x2 b, f32x2 c) { return __builtin_elementwise_fma(a, b, c); }

struct ScanSrc { const float* DEC; const bf16_t* KT; const bf16_t* BB; const bf16_t* KK; const float* CZ; int row0, T, d, hoff, ls, lc; };
#define SCAN_DECL(P) float4 P##w, P##r, P##v; uint2 P##kt, P##kk, P##b;
#define SCAN_GLOAD(P, chunk)                                                         \
  {                                                                                  \
    int t_ = (chunk) * 16 + sc.ls;                                                   \
    if (sc.d) t_ = sc.T - 1 - t_;                                                    \
    const unsigned row_ = (unsigned)(sc.row0 + t_);                                  \
    P##w = *(const float4*)(sc.DEC + row_ * 384u + sc.hoff + sc.lc);                 \
    P##kt = *(const uint2*)(sc.KT + row_ * 384u + sc.hoff + sc.lc);                  \
    P##kk = *(const uint2*)(sc.KK + row_ * 384u + sc.hoff + sc.lc);                  \
    P##b = *(const uint2*)(sc.BB + row_ * 384u + sc.hoff + sc.lc);                   \
    P##r = *(const float4*)(sc.CZ + row_ * 1408u + sc.hoff + sc.lc);                 \
    P##v = *(const float4*)(sc.CZ + row_ * 1408u + 768 + sc.hoff + sc.lc);           \
  }
#define SCAN_LSTORE(P, b_)                                                           \
  {                                                                                  \
    float* dst_ = buf + (((b_) * 16 + sc.ls) * 6) * 64 + sc.lc;                      \
    const float4 kk_ = cvt4(P##kk);                                                  \
    *(float4*)(dst_) = P##w;                                                         \
    *(float4*)(dst_ + 64) = cvt4(P##kt);                                             \
    *(float4*)(dst_ + 128) = make_float4(-kk_.x, -kk_.y, -kk_.z, -kk_.w);           \
    *(float4*)(dst_ + 192) = cvt4(P##b);                                             \
    *(float4*)(dst_ + 256) = P##r;                                                   \
    *(float4*)(dst_ + 320) = P##v;                                                   \
  }

template <int R>
__device__ __forceinline__ void scan_chunk(f32x2 (&S)[R][2], const float* cbuf, int k0, int v0, int kq,
                                           bf16_t* Yhv, int row0, int T, int d, int ch) {
  const float* sb = cbuf + k0;
  const float* vb = cbuf + 320 + v0;
  float ykeep[R];
#pragma unroll
  for (int j = 0; j < R; ++j) ykeep[j] = 0.f;
  f32x4 cw, ckt, ca, cbv, cr;
  float cvv[R];
  cw = *(const f32x4*)(sb);
  ckt = *(const f32x4*)(sb + 64);
  ca = *(const f32x4*)(sb + 128);
  cbv = *(const f32x4*)(sb + 192);
  cr = *(const f32x4*)(sb + 256);
  if constexpr (R == 4) { const f32x4 t = *(const f32x4*)vb; cvv[0] = t.x; cvv[1] = t.y; cvv[2] = t.z; cvv[3] = t.w; }
  else {
#pragma unroll
    for (int j = 0; j < R; ++j) cvv[j] = vb[j];
  }
#pragma unroll
  for (int s = 0; s < 16; ++s) {
    f32x4 nw, nkt, na, nbv, nr;
    float nvv[R];
    if (s < 15) {
      nw = *(const f32x4*)(sb + (s + 1) * 384);
      nkt = *(const f32x4*)(sb + (s + 1) * 384 + 64);
      na = *(const f32x4*)(sb + (s + 1) * 384 + 128);
      nbv = *(const f32x4*)(sb + (s + 1) * 384 + 192);
      nr = *(const f32x4*)(sb + (s + 1) * 384 + 256);
      if constexpr (R == 4) { const f32x4 t = *(const f32x4*)(vb + (s + 1) * 384); nvv[0] = t.x; nvv[1] = t.y; nvv[2] = t.z; nvv[3] = t.w; }
      else {
#pragma unroll
        for (int j = 0; j < R; ++j) nvv[j] = vb[(s + 1) * 384 + j];
      }
    }
#pragma unroll
    for (int j = 0; j < R; ++j) {
      f32x2 acc = S[j][0] * ca.xy;
      acc = fma2(S[j][1], ca.zw, acc);
      float sa = acc.x + acc.y;
      sa += dppf<DPP_XOR1>(sa);
      sa += dppf<DPP_XOR2>(sa);
      sa += dppf<DPP_ROR4>(sa);
      sa += dppf<DPP_ROR8>(sa);
      const f32x2 sa2 = {sa, sa}, vv2 = {cvv[j], cvv[j]};
      S[j][0] = fma2(S[j][0], cw.xy, fma2(sa2, cbv.xy, vv2 * ckt.xy));
      S[j][1] = fma2(S[j][1], cw.zw, fma2(sa2, cbv.zw, vv2 * ckt.zw));
      f32x2 yacc = S[j][0] * cr.xy;
      yacc = fma2(S[j][1], cr.zw, yacc);
      float y = yacc.x + yacc.y;
      y += dppf<DPP_XOR1>(y);
      y += dppf<DPP_XOR2>(y);
      y += dppf<DPP_ROR4>(y);
      y += dppf<DPP_ROR8>(y);
      ykeep[j] = (kq == s) ? y : ykeep[j];
    }
    if (s < 15) {
      cw = nw; ckt = nkt; ca = na; cbv = nbv; cr = nr;
#pragma unroll
      for (int j = 0; j < R; ++j) cvv[j] = nvv[j];
    }
  }
  int t = ch * 16 + kq;
  if (d) t = T - 1 - t;
#pragma unroll
  for (int j = 0; j < R; ++j) Yhv[(unsigned)(row0 + t) * 384u + j] = f2bf(ykeep[j]);
}

constexpr int DPP_HMIRROR = 0x141;
__device__ __forceinline__ void scan_chunk8(f32x2 (&S)[2][4], const float* cbuf, int k0, int v0, int kq,
                                            bf16_t* Yhv, int row0, int T, int d, int ch) {
  const float* sb = cbuf + k0;
  const float* vb = cbuf + 320 + v0;
  float ykeep[2][2];
#pragma unroll
  for (int j = 0; j < 2; ++j) { ykeep[j][0] = 0.f; ykeep[j][1] = 0.f; }
  f32x4 cw[2], ckt[2], ca[2], cbv[2], cr[2];
  f32x2 cvv;
#pragma unroll
  for (int q = 0; q < 2; ++q) {
    cw[q] = *(const f32x4*)(sb + q * 4);
    ckt[q] = *(const f32x4*)(sb + 64 + q * 4);
    ca[q] = *(const f32x4*)(sb + 128 + q * 4);
    cbv[q] = *(const f32x4*)(sb + 192 + q * 4);
    cr[q] = *(const f32x4*)(sb + 256 + q * 4);
  }
  cvv = *(const f32x2*)vb;
#pragma unroll
  for (int s = 0; s < 16; ++s) {
    f32x4 nw[2], nkt[2], na[2], nbv[2], nr[2];
    f32x2 nvv = {0.f, 0.f};
    if (s < 15) {
#pragma unroll
      for (int q = 0; q < 2; ++q) {
        nw[q] = *(const f32x4*)(sb + (s + 1) * 384 + q * 4);
        nkt[q] = *(const f32x4*)(sb + (s + 1) * 384 + 64 + q * 4);
        na[q] = *(const f32x4*)(sb + (s + 1) * 384 + 128 + q * 4);
        nbv[q] = *(const f32x4*)(sb + (s + 1) * 384 + 192 + q * 4);
        nr[q] = *(const f32x4*)(sb + (s + 1) * 384 + 256 + q * 4);
      }
      nvv = *(const f32x2*)(vb + (s + 1) * 384);
    }
#pragma unroll
    for (int j = 0; j < 2; ++j) {
      f32x2 acc = S[j][0] * ca[0].xy;
      acc = fma2(S[j][1], ca[0].zw, acc);
      acc = fma2(S[j][2], ca[1].xy, acc);
      acc = fma2(S[j][3], ca[1].zw, acc);
      float sa = acc.x + acc.y;
      sa += dppf<DPP_XOR1>(sa);
      sa += dppf<DPP_XOR2>(sa);
      sa += dppf<DPP_HMIRROR>(sa);
      const float vj = j ? cvv.y : cvv.x;
      const f32x2 sa2 = {sa, sa}, vv2 = {vj, vj};
      S[j][0] = fma2(S[j][0], cw[0].xy, fma2(sa2, cbv[0].xy, vv2 * ckt[0].xy));
      S[j][1] = fma2(S[j][1], cw[0].zw, fma2(sa2, cbv[0].zw, vv2 * ckt[0].zw));
      S[j][2] = fma2(S[j][2], cw[1].xy, fma2(sa2, cbv[1].xy, vv2 * ckt[1].xy));
      S[j][3] = fma2(S[j][3], cw[1].zw, fma2(sa2, cbv[1].zw, vv2 * ckt[1].zw));
      f32x2 yacc = S[j][0] * cr[0].xy;
      yacc = fma2(S[j][1], cr[0].zw, yacc);
      yacc = fma2(S[j][2], cr[1].xy, yacc);
      yacc = fma2(S[j][3], cr[1].zw, yacc);
      float y = yacc.x + yacc.y;
      y += dppf<DPP_XOR1>(y);
      y += dppf<DPP_XOR2>(y);
      y += dppf<DPP_HMIRROR>(y);
      ykeep[j][s >> 3] = (kq == (s & 7)) ? y : ykeep[j][s >> 3];
    }
    if (s < 15) {
#pragma unroll
      for (int q = 0; q < 2; ++q) { cw[q] = nw[q]; ckt[q] = nkt[q]; ca[q] = na[q]; cbv[q] = nbv[q]; cr[q] = nr[q]; }
      cvv = nvv;
    }
  }
#pragma unroll
  for (int hs = 0; hs < 2; ++hs) {
    int t = ch * 16 + hs * 8 + kq;
    if (d) t = T - 1 - t;
#pragma unroll
    for (int j = 0; j < 2; ++j) Yhv[(unsigned)(row0 + t) * 384u + j] = f2bf(ykeep[j][hs]);
  }
}

__device__ __forceinline__ void scan_unit8(const Params& p, int l, int row0, int T, int h, int d, float* fin, unsigned char* smem) {
  const int tid = opq_tid();
  const int v0 = (tid >> 3) * 2, kq = tid & 7, k0 = kq * 8;
  f32x2 S[2][4];
#pragma unroll
  for (int j = 0; j < 2; ++j)
#pragma unroll
    for (int i = 0; i < 4; ++i) S[j][i] = (f32x2){0.f, 0.f};
  float* buf = (float*)smem;
  ScanSrc sc;
  sc.DEC = (const float*)(p.ws + WS_DEC) + (size_t)d * MTOT * 384;
  sc.KT = (const bf16_t*)(p.ws + WS_KT) + (size_t)d * MTOT * 384;
  sc.BB = (const bf16_t*)(p.ws + WS_BB) + (size_t)d * MTOT * 384;
  sc.KK = (const bf16_t*)(p.ws + WS_KK);
  sc.CZ = (const float*)(p.ws + WS_CZ);
  sc.row0 = row0; sc.T = T; sc.d = d; sc.hoff = h * 64; sc.ls = tid >> 4; sc.lc = (tid & 15) * 4;
  bf16_t* Yhv = (bf16_t*)(p.ws + WS_Y) + (size_t)d * MTOT * 384 + h * 64 + v0;
  const int nch = T / 16;
  float* buf0 = buf;
  float* buf1 = buf + 16 * 384;
  __syncthreads();
  SCAN_DECL(A)
  SCAN_GLOAD(A, 0);
  SCAN_LSTORE(A, 0);
  __syncthreads();
  for (int ch = 0; ch < nch; ++ch) {
    if (ch + 1 < nch) SCAN_GLOAD(A, ch + 1);
    scan_chunk8(S, (ch & 1) ? buf1 : buf0, k0, v0, kq, Yhv, row0, T, d, ch);
    if (ch + 1 < nch) SCAN_LSTORE(A, (ch + 1) & 1);
    __syncthreads();
  }
#pragma unroll
  for (int j = 0; j < 2; ++j) {
    float4 t0, t1;
    t0.x = S[j][0].x; t0.y = S[j][0].y; t0.z = S[j][1].x; t0.w = S[j][1].y;
    t1.x = S[j][2].x; t1.y = S[j][2].y; t1.z = S[j][3].x; t1.w = S[j][3].y;
    *(float4*)(fin + (v0 + j) * 64 + k0) = t0;
    *(float4*)(fin + (v0 + j) * 64 + k0 + 4) = t1;
  }
}

template <int R>
__device__ __forceinline__ void scan_unit(const Params& p, int l, int row0, int T, int h, int d, int vbase,
                                          const float* init, float* fin, unsigned char* smem) {
  const int tid = opq_tid();
  const int v0 = vbase + (tid >> 4) * R, kq = tid & 15, k0 = kq * 4;
  f32x2 S[R][2];
#pragma unroll
  for (int j = 0; j < R; ++j) {
    if (init) {
      const float4 t = *(const float4*)(init + (v0 + j) * 64 + k0);
      S[j][0].x = t.x; S[j][0].y = t.y; S[j][1].x = t.z; S[j][1].y = t.w;
    } else {
      S[j][0] = (f32x2){0.f, 0.f}; S[j][1] = (f32x2){0.f, 0.f};
    }
  }
  float* buf = (float*)smem;
  ScanSrc sc;
  sc.DEC = (const float*)(p.ws + WS_DEC) + (size_t)d * MTOT * 384;
  sc.KT = (const bf16_t*)(p.ws + WS_KT) + (size_t)d * MTOT * 384;
  sc.BB = (const bf16_t*)(p.ws + WS_BB) + (size_t)d * MTOT * 384;
  sc.KK = (const bf16_t*)(p.ws + WS_KK);
  sc.CZ = (const float*)(p.ws + WS_CZ);
  sc.row0 = row0; sc.T = T; sc.d = d; sc.hoff = h * 64; sc.ls = tid >> 4; sc.lc = (tid & 15) * 4;
  bf16_t* Yhv = (bf16_t*)(p.ws + WS_Y) + (size_t)d * MTOT * 384 + h * 64 + v0;
  const int nch = T / 16;
  float* buf0 = buf;
  float* buf1 = buf + 16 * 384;
  __syncthreads();
  if constexpr (R == 1) {
    __builtin_amdgcn_s_setprio(3);
    SCAN_DECL(A) SCAN_DECL(B) SCAN_DECL(C) SCAN_DECL(Dd)
    SCAN_GLOAD(A, 0);
    SCAN_LSTORE(A, 0);
    SCAN_GLOAD(A, 1);
    SCAN_GLOAD(B, 2);
    SCAN_GLOAD(C, 3);
    __syncthreads();
    for (int ch = 0; ch < nch; ch += 4) {
      if (ch + 4 < nch) SCAN_GLOAD(Dd, ch + 4);
      scan_chunk<R>(S, buf0, k0, v0, kq, Yhv, row0, T, d, ch);
      SCAN_LSTORE(A, 1);
      __syncthreads();
      if (ch + 5 < nch) SCAN_GLOAD(A, ch + 5);
      scan_chunk<R>(S, buf1, k0, v0, kq, Yhv, row0, T, d, ch + 1);
      SCAN_LSTORE(B, 0);
      __syncthreads();
      if (ch + 6 < nch) SCAN_GLOAD(B, ch + 6);
      scan_chunk<R>(S, buf0, k0, v0, kq, Yhv, row0, T, d, ch + 2);
      SCAN_LSTORE(C, 1);
      __syncthreads();
      if (ch + 7 < nch) SCAN_GLOAD(C, ch + 7);
      scan_chunk<R>(S, buf1, k0, v0, kq, Yhv, row0, T, d, ch + 3);
      if (ch + 4 < nch) SCAN_LSTORE(Dd, 0);
      __syncthreads();
    }
    __builtin_amdgcn_s_setprio(0);
  } else {
    SCAN_DECL(A)
    SCAN_GLOAD(A, 0);
    SCAN_LSTORE(A, 0);
    __syncthreads();
    for (int ch = 0; ch < nch; ++ch) {
      if (ch + 1 < nch) SCAN_GLOAD(A, ch + 1);
      scan_chunk<R>(S, (ch & 1) ? buf1 : buf0, k0, v0, kq, Yhv, row0, T, d, ch);
      if (ch + 1 < nch) SCAN_LSTORE(A, (ch + 1) & 1);
      __syncthreads();
    }
  }
  if (fin) {
#pragma unroll
    for (int j = 0; j < R; ++j) {
      float4 t;
      t.x = S[j][0].x; t.y = S[j][0].y; t.z = S[j][1].x; t.w = S[j][1].y;
      *(float4*)(fin + (v0 + j) * 64 + k0) = t;
    }
  }
}

struct AttnDesc {
  const bf16_t* q;
  const bf16_t* kloc;
  const bf16_t* vloc;
  const bf16_t* kctx;
  const bf16_t* vctx;
  bf16_t* o;
  int qpos0;
  int lo, hi;
  int window;
  float sink; int has_sink;
};

__device__ __forceinline__ void attn_unit(const AttnDesc& a, unsigned char* smem) {
  const int tid = opq_tid(), lane = tid & 63, wid = tid >> 6, fr = lane & 15, fq = lane >> 4;
  unsigned char* sK = smem;
  unsigned char* sV = smem + 8192;
  bf16x8 qf[2];
  {
    const bf16_t* qp = a.q + (size_t)(wid * 16 + fr) * 896 + fq * 8;
    qf[0] = *(const bf16x8*)(qp);
    qf[1] = *(const bf16x8*)(qp + 32);
  }
  f32x4 o[4];
#pragma unroll
  for (int i = 0; i < 4; ++i) o[i] = (f32x4){0.f, 0.f, 0.f, 0.f};
  float mrun = -1e30f, lsum = 0.f;
  const int nctx = a.kctx ? 4 : 0;
  const int ntl = nctx + (a.hi - a.lo + 1);
  const int sw = (fr >> 1) & 7;
  const int qpos = a.qpos0 + wid * 16 + fr;
  const int r0_ = tid >> 3, chn = tid & 7, r1_ = r0_ + 32;
  const int rho0 = (r0_ & 32) | (((r0_ >> 2) & 1) << 4) | (((r0_ >> 3) & 3) << 2) | (r0_ & 3);
  const int rho1 = rho0 + 32;
  uint4 rk0, rk1, rv0, rv1;
#define ATTN_TLOAD(it_)                                                                          \
  {                                                                                              \
    const bool ic_ = (it_) < nctx;                                                               \
    const int kt_ = ic_ ? (it_) : a.lo + ((it_) - nctx);                                         \
    const bf16_t* kb_ = ic_ ? a.kctx + (size_t)kt_ * 64 * 64 : a.kloc + (size_t)kt_ * 64 * 896;  \
    const int kstr_ = ic_ ? 64 : 896;                                                            \
    const bf16_t* vb_ = ic_ ? a.vctx + kt_ * 64 : a.vloc + kt_ * 64;                             \
    const int vstr_ = ic_ ? 256 : MTOT;                                                          \
    rk0 = *(const uint4*)(kb_ + (size_t)r0_ * kstr_ + chn * 8);                                  \
    rk1 = *(const uint4*)(kb_ + (size_t)r1_ * kstr_ + chn * 8);                                  \
    rv0 = *(const uint4*)(vb_ + (size_t)r0_ * vstr_ + chn * 8);                                  \
    rv1 = *(const uint4*)(vb_ + (size_t)r1_ * vstr_ + chn * 8);                                  \
  }
  ATTN_TLOAD(0);
  for (int it = 0; it < ntl; ++it) {
    const bool isctx = it < nctx;
    const int kt = isctx ? it : a.lo + (it - nctx);
    __syncthreads();
    *(uint4*)(sK + rho0 * 128 + ((chn ^ ((rho0 >> 1) & 7)) << 4)) = rk0;
    *(uint4*)(sK + rho1 * 128 + ((chn ^ ((rho1 >> 1) & 7)) << 4)) = rk1;
    *(uint4*)(sV + r0_ * 128 + ((chn ^ ((r0_ >> 1) & 7)) << 4)) = rv0;
    *(uint4*)(sV + r1_ * 128 + ((chn ^ ((r1_ >> 1) & 7)) << 4)) = rv1;
    __syncthreads();
    if (it + 1 < ntl) ATTN_TLOAD(it + 1);
    f32x4 st[4];
#pragma unroll
    for (int kb4 = 0; kb4 < 4; ++kb4) {
      st[kb4] = (f32x4){0.f, 0.f, 0.f, 0.f};
#pragma unroll
      for (int ks = 0; ks < 2; ++ks) {
        const bf16x8 af = *(const bf16x8*)(sK + (kb4 * 16 + fr) * 128 + (((ks * 4 + fq) ^ sw) << 4));
        st[kb4] = mfma16(af, qf[ks], st[kb4]);
      }
    }
    float mt = -1e30f;
#pragma unroll
    for (int kb4 = 0; kb4 < 4; ++kb4)
#pragma unroll
      for (int jj = 0; jj < 4; ++jj) {
        float s = st[kb4][jj] * 0.125f;
        if (a.window && !isctx) {
          const int key = (kb4 >> 1) * 32 + fq * 8 + (kb4 & 1) * 4 + jj;
          const int dlt = kt * 64 + key - qpos;
          if (dlt > 128 || dlt < -128) s = -1e30f;
        }
        st[kb4][jj] = s;
        mt = fmaxf(mt, s);
      }
    mt = fmaxf(mt, __shfl_xor(mt, 16));
    mt = fmaxf(mt, __shfl_xor(mt, 32));
    const float mnew = fmaxf(mrun, mt);
    const float alpha = __expf(mrun - mnew);
    mrun = mnew;
    float ps = 0.f;
#pragma unroll
    for (int kb4 = 0; kb4 < 4; ++kb4)
#pragma unroll
      for (int jj = 0; jj < 4; ++jj) {
        const float pv = __expf(st[kb4][jj] - mnew);
        st[kb4][jj] = pv;
        ps += pv;
      }
    lsum = lsum * alpha + ps;
#pragma unroll
    for (int i = 0; i < 4; ++i) o[i] *= alpha;
    bf16x8 pb[2];
#pragma unroll
    for (int kg = 0; kg < 2; ++kg) {
      union { uint4 u4; bf16x8 v8; } r;
      r.u4.x = pk_bf16(st[2 * kg][0], st[2 * kg][1]);
      r.u4.y = pk_bf16(st[2 * kg][2], st[2 * kg][3]);
      r.u4.z = pk_bf16(st[2 * kg + 1][0], st[2 * kg + 1][1]);
      r.u4.w = pk_bf16(st[2 * kg + 1][2], st[2 * kg + 1][3]);
      pb[kg] = r.v8;
    }
#pragma unroll
    for (int db = 0; db < 4; ++db)
#pragma unroll
      for (int kg = 0; kg < 2; ++kg) {
        const bf16x8 vf = *(const bf16x8*)(sV + (db * 16 + fr) * 128 + (((kg * 4 + fq) ^ sw) << 4));
        o[db] = mfma16(vf, pb[kg], o[db]);
      }
  }
  lsum += __shfl_xor(lsum, 16);
  lsum += __shfl_xor(lsum, 32);
  if (a.has_sink) lsum += __expf(a.sink - mrun);
  const float inv = frcp(lsum);
  bf16_t* op = a.o + (size_t)(wid * 16 + fr) * 1024 + fq * 4;
#pragma unroll
  for (int db = 0; db < 4; ++db) {
    uint2 v;
    v.x = pk_bf16(o[db][0] * inv, o[db][1] * inv);
    v.y = pk_bf16(o[db][2] * inv, o[db][3] * inv);
    *(uint2*)(op + db * 16) = v;
  }
}

constexpr int U_LSCAN = 96, U_CSCAN = 384, U_LATB = 192, U_LATA = 128, U_CTX = 1280;
constexpr int U_TOTAL = U_LSCAN + U_CSCAN + U_LATB + U_LATA + U_CTX;

__device__ __forceinline__ void mix_phase(const Params& p, int slot, int l, unsigned char* smem, int ulo = 0, int uhi = U_TOTAL) {
  unsigned* cnt = (unsigned*)(p.ws + WS_CNT) + slot * 8;
  int* s_u = (int*)(smem + SMEM_CTL);
  const bf16_t* QK = (const bf16_t*)(p.ws + WS_QK);
  const bf16_t* VT = (const bf16_t*)(p.ws + WS_VT);
  bf16_t* MIX = (bf16_t*)(p.ws + WS_H);
  for (;;) {
    __syncthreads();
    if (opq_tid() == 0) *s_u = (int)atomicAdd(cnt, 1u);
    __syncthreads();
    int u = *s_u + ulo;
    if (u >= uhi) break;
    if (u < U_LSCAN) {
      const int chain = u >> 2, part = u & 3;
      const int b = chain / 12, h = (chain % 12) >> 1, d = chain & 1;
      const float* init = p.state_c + ((((size_t)b * 2 + l) * 2 + d) * 6 + h) * 4096;
      scan_unit<1>(p, l, M_CTX + b * 1024, 1024, h, d, part * 16, init, nullptr, smem);
      continue;
    }
    u -= U_LSCAN;
    if (u < U_CSCAN) {
      const int b = u / 12, h = (u % 12) >> 1, d = u & 1;
      float* fin = p.out + OUT_ST + ((((size_t)b * 2 + l) * 2 + d) * 6 + h) * 4096;
      scan_unit8(p, l, b * 256, 256, h, d, fin, smem);
      continue;
    }
    u -= U_CSCAN;
    AttnDesc a;
    if (u < U_LATB) {
      const int b = u / 96, h = (u % 96) >> 4, qb = u & 15, kvh = h / 3;
      const int r0 = M_CTX + b * 1024;
      a.q = QK + (size_t)(r0 + qb * 64) * 896 + 384 + h * 64;
      a.kloc = QK + (size_t)r0 * 896 + 768 + kvh * 64;
      a.vloc = VT + (size_t)((2 + kvh) * 64) * MTOT + r0;
      a.kctx = (const bf16_t*)(p.ws + WS_CKB) + (size_t)((b * 2 + l) * 2 + kvh) * 16384;
      a.vctx = (const bf16_t*)(p.ws + WS_CVTB) + (size_t)((b * 2 + l) * 2 + kvh) * 16384;
      a.o = MIX + (size_t)(r0 + qb * 64) * 1024 + 256 + h * 64;
      a.qpos0 = qb * 64; a.lo = 0; a.hi = 15; a.window = 0; a.sink = 0.f; a.has_sink = 0;
    } else if (u < U_LATB + U_LATA) {
      u -= U_LATB;
      const int b = u >> 6, h = (u & 63) >> 4, qb = u & 15, kvh = h >> 1;
      const int r0 = M_CTX + b * 1024;
      a.q = QK + (size_t)(r0 + qb * 64) * 896 + h * 64;
      a.kloc = QK + (size_t)r0 * 896 + 256 + kvh * 64;
      a.vloc = VT + (size_t)(kvh * 64) * MTOT + r0;
      a.kctx = (const bf16_t*)(p.ws + WS_CKA) + (size_t)((b * 2 + l) * 2 + kvh) * 16384;
      a.vctx = (const bf16_t*)(p.ws + WS_CVTA) + (size_t)((b * 2 + l) * 2 + kvh) * 16384;
      a.o = MIX + (size_t)(r0 + qb * 64) * 1024 + h * 64;
      a.qpos0 = qb * 64; a.lo = qb - 2 < 0 ? 0 : qb - 2; a.hi = qb + 2 > 15 ? 15 : qb + 2; a.window = 1;
      a.sink = p.a_sink[l * 4 + h]; a.has_sink = 1;
    } else {
      u -= U_LATB + U_LATA;
      const int b = u / 40, rem = u % 40, hh = rem >> 2, qb = rem & 3;
      const int r0 = b * 256;
      a.kctx = nullptr; a.vctx = nullptr;
      a.qpos0 = qb * 64; a.lo = 0; a.hi = 3; a.window = 0;
      if (hh < 4) {
        const int h = hh, kvh = h >> 1;
        a.q = QK + (size_t)(r0 + qb * 64) * 896 + h * 64;
        a.kloc = QK + (size_t)r0 * 896 + 256 + kvh * 64;
        a.vloc = VT + (size_t)(kvh * 64) * MTOT + r0;
        a.o = MIX + (size_t)(r0 + qb * 64) * 1024 + h * 64;
        a.sink = p.a_sink[l * 4 + h]; a.has_sink = 1;
      } else {
        const int h = hh - 4, kvh = h / 3;
        a.q = QK + (size_t)(r0 + qb * 64) * 896 + 384 + h * 64;
        a.kloc = QK + (size_t)r0 * 896 + 768 + kvh * 64;
        a.vloc = VT + (size_t)((2 + kvh) * 64) * MTOT + r0;
        a.o = MIX + (size_t)(r0 + qb * 64) * 1024 + 256 + h * 64;
        a.sink = 0.f; a.has_sink = 0;
      }
    }
    attn_unit(a, smem);
  }
}

__device__ __forceinline__ void post_phase(const Params& p, int l) {
  const int tid_ = opq_tid(); const int lane = tid_ & 63, wave = tid_ >> 6;
  const bf16_t* Y = (const bf16_t*)(p.ws + WS_Y);
  const bf16_t* Gb = (const bf16_t*)(p.ws + WS_G);
  const float* BON = (const float*)(p.ws + WS_BON);
  const float* CZ = (const float*)(p.ws + WS_CZ);
  bf16_t* MIX = (bf16_t*)(p.ws + WS_H);
  for (int row = opq_bid() * 4 + wave; row < MTOT; row += gridDim.x * 4) {
#pragma unroll
    for (int h = 0; h < 6; ++h) {
      const int col = h * 64 + lane;
      const float y = bf2f(Y[(size_t)row * 384 + col]) + bf2f(Y[((size_t)MTOT + row) * 384 + col]);
      const float mu = wave_sum(y) * (1.f / 64.f);
      const float dv = y - mu;
      const float var = wave_sum(dv * dv) * (1.f / 64.f);
      const float yn = dv * __builtin_amdgcn_rsqf(var + 64e-5f);
      const float vv = CZ[(size_t)row * 1408 + 768 + col];
      const float o = (yn * p.c_ln_w[l * 384 + col] + p.c_ln_b[l * 384 + col] + BON[(size_t)row * 8 + h] * vv) *
                      bf2f(Gb[(size_t)row * 384 + col]);
      MIX[(size_t)row * 1024 + 640 + col] = f2bf(o);
    }
  }
}


#define XB_TMO      128
#define XB_XCNT(j)  (256  + 64 * (j))
#define XB_XSUB(j)  (1280 + 64 * (j))
#define XB_XGEN(j)  (2304 + 64 * (j))
#define XB_TOP      3328
#define XB_TOPGEN   3392
#define XCD_BAR_WORDS 3456
#define XB_SPIN_CAP (1u << 22)
#define LAS __attribute__((address_space(3)))
__device__ __forceinline__ unsigned xb_ld(unsigned* p)              { return __hip_atomic_load(p, __ATOMIC_RELAXED, __HIP_MEMORY_SCOPE_AGENT); }
__device__ __forceinline__ unsigned xb_add(unsigned* p, unsigned v) { return __hip_atomic_fetch_add(p, v, __ATOMIC_RELAXED, __HIP_MEMORY_SCOPE_AGENT); }
__device__ __forceinline__ unsigned xb_xcc_id() { return (unsigned)__builtin_amdgcn_s_getreg((3 << 11) | 20) & 0xFu; }
#define XB_SPIN(cond, bar) do { unsigned _sp = 0; while (cond) { __builtin_amdgcn_s_sleep(1); \
    if ((++_sp & 255u) == 0u) { if (xb_ld(&(bar)[XB_TMO])) break; if (_sp > XB_SPIN_CAP) { atomicAdd(&(bar)[XB_TMO], 1u); break; } } } } while (0)
struct XcdBarrier { unsigned* bar; unsigned x; volatile LAS unsigned* st; };
__device__ __forceinline__ XcdBarrier xcd_barrier_post(unsigned* bar, volatile LAS unsigned* st) {
  XcdBarrier b; b.bar = bar; b.x = xb_xcc_id(); b.st = st;
  if (threadIdx.x == 0) (void)xb_add(&bar[XB_XCNT(b.x)], 1u);
  return b;
}
__device__ __forceinline__ void xcd_barrier_complete(unsigned* bar, unsigned x, unsigned& nloc, unsigned& nx) {
  const unsigned G = gridDim.x * gridDim.y * gridDim.z;
  unsigned sum, cnt, mine, sp = 0u;
  for (;;) {
    sum = 0u; cnt = 0u; mine = 0u;
#pragma unroll
    for (unsigned j = 0; j < 16; ++j) { const unsigned c = xb_ld(&bar[XB_XCNT(j)]); sum += c; cnt += (c > 0u) ? 1u : 0u; mine = (j == x) ? c : mine; }
    if (sum == G) break;
    __builtin_amdgcn_s_sleep(1);
    if ((++sp & 255u) == 0u) { if (xb_ld(&bar[XB_TMO])) break; if (sp > XB_SPIN_CAP) { atomicAdd(&bar[XB_TMO], 1u); break; } }
  }
  nloc = mine > 0u ? mine : 1u; nx = cnt > 0u ? cnt : 1u;
}
__device__ __forceinline__ void xcd_barrier(const XcdBarrier& b) {
  asm volatile("s_waitcnt vmcnt(0)" ::: "memory");
  __syncthreads();
  if (threadIdx.x == 0) {
    unsigned* bar = b.bar;
    __builtin_amdgcn_s_waitcnt(0);
    unsigned nloc = b.st[0], nx = b.st[1];
    if (nloc == 0u) { xcd_barrier_complete(bar, b.x, nloc, nx); b.st[0] = nloc; b.st[1] = nx; }
    const unsigned old = xb_add(&bar[XB_XSUB(b.x)], 1u);
    const unsigned gen = old / nloc;
    if (old + 1u == (gen + 1u) * nloc) {
      __builtin_amdgcn_fence(__ATOMIC_RELEASE, "agent");
      asm volatile("s_waitcnt vmcnt(0)" ::: "memory");
      const unsigned og = xb_add(&bar[XB_TOP], 1u);
      const unsigned tg = og / nx;
      if (og + 1u == (tg + 1u) * nx) xb_add(&bar[XB_TOPGEN], 1u);
      else XB_SPIN(xb_ld(&bar[XB_TOPGEN]) == tg, bar);
      __builtin_amdgcn_fence(__ATOMIC_ACQUIRE, "agent");
      xb_add(&bar[XB_XGEN(b.x)], 1u);
      asm volatile("s_waitcnt vmcnt(0)" ::: "memory");
    } else {
      XB_SPIN(xb_ld(&bar[XB_XGEN(b.x)]) == gen, bar);
      __builtin_amdgcn_fence(__ATOMIC_ACQUIRE, "agent");
      asm volatile("s_waitcnt vmcnt(0)" ::: "memory");
    }
  }
  __syncthreads();
}

__device__ __forceinline__ void run_phase(const Params& p, int ph, unsigned char* smem) {
  if (ph == 0) { phase0(p, smem); return; }
  if (ph == NPHASE - 1) { rpass(p, 2, 1); return; }
  const int l = (ph - 1) / 9, s = (ph - 1) % 9;
  const bf16_t* H = (const bf16_t*)(p.ws + WS_H);
  switch (s) {
    case 0: if (l == 0) rpass(p, 0, 0); else rpass(p, 2, 0); break;
    case 1: gemm_phase<0>(p, l, H, D, (const bf16_t*)(p.ws + WS_WT_IN) + (size_t)l * IN_COLS * D, D, IN_COLS, D, smem); break;
    case 2: prep_phase(p, l, smem); break;
    case 3: mix_phase(p, l * 2, l, smem); break;
    case 4: post_phase(p, l); break;
    case 5: gemm_phase<1>(p, l, H, D, (const bf16_t*)(p.ws + WS_WT_OUT) + (size_t)l * D * D, D, D, D, smem); break;
    case 6: rpass(p, 1, l); break;
    case 7: gemm_phase<2>(p, l, H, D, (const bf16_t*)(p.ws + WS_WT_GU) + (size_t)l * GU * D, D, GU, D, smem); break;
    case 8: gemm_phase<1>(p, l, (const bf16_t*)(p.ws + WS_CZ), FF, (const bf16_t*)(p.ws + WS_WT_DN) + (size_t)l * D * FF, FF, D, FF, smem); break;
  }
}

#if N_LAUNCH_MODE == 0
__global__ void __launch_bounds__(256, 2) fwd_phases(Params p) {
  extern __shared__ __attribute__((aligned(16))) unsigned char smem[];
  run_phase(p, p.ph_lo, smem);
}
#define FWD_KERNEL fwd_phases
#else
template <int L>
__device__ __forceinline__ void layer_phases(const Params& p, unsigned char* smem, const XcdBarrier& xb) {
  const bf16_t* H = (const bf16_t*)(p.ws + WS_H);
  if (L == 0) {
#pragma unroll
    for (int rep = 0; rep < REP_R0; ++rep) rpass(p, 0, 0);
  } else rpass(p, 2, 0);
  xcd_barrier(xb);
#pragma unroll
  for (int rep = 0; rep < REP_GEMM; ++rep) {
    gemm_phase<0>(p, L, H, D, (const bf16_t*)(p.ws + WS_WT_IN) + (size_t)L * IN_COLS * D, D, IN_COLS, D, smem);
    xcd_barrier(xb);
  }
#pragma unroll
  for (int rep = 0; rep < REP_OTHER * REP_PREP; ++rep) {
    prep_phase(p, L, smem);
    xcd_barrier(xb);
  }
#if MIX_SPLIT
#pragma unroll
  for (int rep = 0; rep < REP_MA; ++rep) { mix_phase(p, L * 4 + 0 + 0 * rep, L, smem, 0, U_LSCAN); xcd_barrier(xb); if (rep + 1 < REP_MA) { if (threadIdx.x == 0 && blockIdx.x == 0) ((unsigned*)(p.ws + WS_CNT))[(L * 4 + 0) * 8] = 0u; xcd_barrier(xb); } }
#pragma unroll
  for (int rep = 0; rep < REP_MB; ++rep) { mix_phase(p, L * 4 + 1, L, smem, U_LSCAN, U_LSCAN + U_CSCAN); xcd_barrier(xb); if (rep + 1 < REP_MB) { if (threadIdx.x == 0 && blockIdx.x == 0) ((unsigned*)(p.ws + WS_CNT))[(L * 4 + 1) * 8] = 0u; xcd_barrier(xb); } }
#pragma unroll
  for (int rep = 0; rep < REP_MC; ++rep) { mix_phase(p, L * 4 + 2, L, smem, U_LSCAN + U_CSCAN, U_TOTAL); xcd_barrier(xb); if (rep + 1 < REP_MC) { if (threadIdx.x == 0 && blockIdx.x == 0) ((unsigned*)(p.ws + WS_CNT))[(L * 4 + 2) * 8] = 0u; xcd_barrier(xb); } }
#else
#pragma unroll
  for (int rep = 0; rep < REP_MIX; ++rep) {
    mix_phase(p, L * 2 + rep, L, smem);
    xcd_barrier(xb);
  }
#endif
#pragma unroll
  for (int rep = 0; rep < REP_OTHER; ++rep) {
    post_phase(p, L);
    xcd_barrier(xb);
  }
#pragma unroll
  for (int rep = 0; rep < REP_GEMM; ++rep) {
    gemm160_phase(p, H, D, (const bf16_t*)(p.ws + WS_WT_OUT) + (size_t)L * D * D, D, D, smem);
    xcd_barrier(xb);
  }
  rpass(p, 1, L);
  xcd_barrier(xb);
#pragma unroll
  for (int rep = 0; rep < REP_GEMM; ++rep) {
    gemm_phase<2>(p, L, H, D, (const bf16_t*)(p.ws + WS_WT_GU) + (size_t)L * GU * D, D, GU, D, smem);
    xcd_barrier(xb);
  }
#pragma unroll
  for (int rep = 0; rep < REP_GEMM; ++rep) {
    gemm160_phase(p, (const bf16_t*)(p.ws + WS_CZ), FF, (const bf16_t*)(p.ws + WS_WT_DN) + (size_t)L * D * FF, FF, FF, smem);
    xcd_barrier(xb);
  }
}
__global__ void __launch_bounds__(256, 2) fwd_mega(Params p) {
  extern __shared__ __attribute__((aligned(16))) unsigned char smem[];
  if (threadIdx.x == 0) { *(unsigned*)(smem + SMEM_CTL + 8) = 0u; *(unsigned*)(smem + SMEM_CTL + 12) = 0u; }
  __syncthreads();
  XcdBarrier xb = xcd_barrier_post((unsigned*)(p.ws + WS_BAR), (volatile LAS unsigned*)(smem + SMEM_CTL + 8));
#pragma unroll
  for (int rep = 0; rep < REP_P0; ++rep) phase0(p, smem);
#pragma unroll
  for (int rep = 0; rep < REP_BAR; ++rep) xcd_barrier(xb);
#if USE_CG_SYNC
  cg::this_grid().sync();
#else
  if (p.ph_hi < 0) cg::this_grid().sync();
  xcd_barrier(xb);
#endif
  layer_phases<0>(p, smem, xb);
  layer_phases<1>(p, smem, xb);
  rpass(p, 2, 1);
}
#define FWD_KERNEL fwd_mega
#endif

extern "C" void kernel_launch(void* const* d_in, const int* in_sizes, int n_in, void* d_out, int out_size, void* d_ws,
                              size_t ws_size, hipStream_t stream) {
  static int grid_blocks = 0;
  if (!grid_blocks) {
    int dev = 0, cus = 0, per_cu = 0;
    (void)hipGetDevice(&dev);
    (void)hipDeviceGetAttribute(&cus, hipDeviceAttributeMultiprocessorCount, dev);
    (void)hipFuncSetAttribute((const void*)FWD_KERNEL, hipFuncAttributeMaxDynamicSharedMemorySize, SMEM_BYTES);
    (void)hipOccupancyMaxActiveBlocksPerMultiprocessor(&per_cu, (const void*)FWD_KERNEL, 256, SMEM_BYTES);
    if (per_cu > 2) per_cu = 2;
    if (per_cu < 1) per_cu = 1;
    grid_blocks = cus * per_cu;
    if (n_in != 32 || ws_size < WS_END) {
      fprintf(stderr, "kernel_launch: unexpected n_in %d or ws_size %zu (< %zu)\n", n_in, ws_size, (size_t)WS_END);
      grid_blocks = -1;
    }
  }
  if (grid_blocks < 0) return;
  Params p{};
  const float** pp = (const float**)&p;
  for (int i = 0; i < 32; ++i) pp[i] = (const float*)d_in[i];
  p.out = (float*)d_out;
  p.ws = (unsigned char*)d_ws;
#if N_LAUNCH_MODE
  p.ph_lo = 0; p.ph_hi = NPHASE;
  (void)hipMemsetAsync((unsigned char*)d_ws + WS_BAR, 0, 16384, stream);
  void* args[] = {&p};
  hipError_t e = hipLaunchCooperativeKernel((const void*)fwd_mega, dim3(grid_blocks), dim3(256), args, SMEM_BYTES, stream);
  if (e != hipSuccess) fprintf(stderr, "cooperative launch failed: %s (grid %d)\n", hipGetErrorString(e), grid_blocks);
#else
  for (int ph = 0; ph < NPHASE; ++ph) {
    p.ph_lo = ph; p.ph_hi = ph + 1;
    hipLaunchKernelGGL(fwd_phases, dim3(grid_blocks), dim3(256), SMEM_BYTES, stream, p);
  }
#endif
}
```

```cpp
#include <hip/hip_runtime.h>
#include <hip/hip_bf16.h>
#include <hip/hip_cooperative_groups.h>
#include <cstdio>
#include <cstdint>
namespace cg = cooperative_groups;

typedef unsigned short bf16_t;
using bf16x8 = __attribute__((ext_vector_type(8))) short;
using f32x4 = __attribute__((ext_vector_type(4))) float;

#ifndef REP_GEMM
#define REP_GEMM 1
#endif
#ifndef REP_MIX
#define REP_MIX 1
#endif
#ifndef REP_P0
#define REP_P0 1
#endif
#ifndef REP_R0
#define REP_R0 1
#endif
#ifndef REP_BAR
#define REP_BAR 0
#endif
#ifndef REP_PREP
#define REP_PREP 1
#endif
#ifndef MIX_SPLIT
#define MIX_SPLIT 0
#endif
#ifndef REP_MA
#define REP_MA 1
#endif
#ifndef REP_MB
#define REP_MB 1
#endif
#ifndef REP_MC
#define REP_MC 1
#endif
#ifndef REP_OTHER
#define REP_OTHER 1
#endif
#ifndef USE_CG_SYNC
#define USE_CG_SYNC 0
#endif
#ifndef N_LAUNCH_MODE
#define N_LAUNCH_MODE 1
#endif

constexpr int D = 1024, M_CTX = 8192, M_LAT = 2048, MTOT = 10240;
constexpr int IN_COLS = 2560, FF = 2816, GU = 5632;
constexpr int NPHASE = 20;
constexpr int SMEM_CTL = 73728;
constexpr int SMEM_BYTES = SMEM_CTL + 64;

constexpr size_t al256(size_t x) { return (x + 255) & ~(size_t)255; }
constexpr size_t WS_WT_IN = 0;
constexpr size_t WS_WT_OUT = WS_WT_IN + (size_t)2 * IN_COLS * D * 2;
constexpr size_t WS_WT_GU = WS_WT_OUT + (size_t)2 * D * D * 2;
constexpr size_t WS_WT_DN = WS_WT_GU + (size_t)2 * GU * D * 2;
constexpr size_t WS_WUPT = WS_WT_DN + (size_t)2 * D * FF * 2;
constexpr size_t WS_AUPT = WS_WUPT + (size_t)4 * 384 * 64 * 2;
constexpr size_t WS_GUPT = WS_AUPT + (size_t)4 * 384 * 64 * 2;
constexpr size_t WS_MOD = WS_GUPT + (size_t)2 * 384 * 128 * 2;
constexpr size_t WS_ROPE = WS_MOD + (size_t)2 * 3 * 6144 * 4;
constexpr size_t WS_CKA = WS_ROPE + (size_t)1024 * 32 * 2 * 4;
constexpr size_t WS_CVTA = WS_CKA + (size_t)131072 * 2;
constexpr size_t WS_CKB = WS_CVTA + (size_t)131072 * 2;
constexpr size_t WS_CVTB = WS_CKB + (size_t)131072 * 2;
constexpr size_t WS_CNT = WS_CVTB + (size_t)131072 * 2;
constexpr size_t WS_BAR = WS_CNT + 256;
constexpr size_t WS_H = WS_BAR + 16384;
constexpr size_t WS_QK = WS_H + (size_t)MTOT * D * 2;
constexpr size_t WS_VT = WS_QK + (size_t)MTOT * 896 * 2;
constexpr size_t WS_CZ = WS_VT + (size_t)4 * 64 * MTOT * 2;
constexpr size_t WS_DEC = WS_CZ + (size_t)MTOT * 1408 * 4;
constexpr size_t WS_KT = WS_DEC + (size_t)2 * MTOT * 384 * 4;
constexpr size_t WS_BB = WS_KT + (size_t)2 * MTOT * 384 * 2;
constexpr size_t WS_KK = WS_BB + (size_t)2 * MTOT * 384 * 2;
constexpr size_t WS_G = WS_KK + (size_t)MTOT * 384 * 2;
constexpr size_t WS_BON = WS_G + (size_t)MTOT * 384 * 2;
constexpr size_t WS_Y = WS_BON + (size_t)MTOT * 8 * 4;
constexpr size_t WS_PA = WS_Y + (size_t)2 * MTOT * 384 * 2;
constexpr size_t WS_END = WS_PA + (size_t)MTOT * 256 * 2;
static_assert((size_t)MTOT * D * 4 <= (WS_BB - WS_DEC), "O alias");
static_assert(WS_END <= (size_t)256 * 1024 * 1024, "workspace too big");

constexpr size_t OUT_X = 0;
constexpr size_t OUT_AK = (size_t)MTOT * D;
constexpr size_t OUT_AV = OUT_AK + 2097152;
constexpr size_t OUT_BK = OUT_AV + 2097152;
constexpr size_t OUT_BV = OUT_BK + 2097152;
constexpr size_t OUT_ST = OUT_BV + 2097152;

struct Params {
  const float *x_prompt, *x_sample, *cache_a_k, *cache_a_v, *cache_b_k, *cache_b_v, *state_c, *c, *c_ctx,
      *w_mod, *b_mod, *norm_mix_pre, *norm_mix_post, *norm_ffn_pre, *norm_ffn_post, *w_in, *w_out, *a_sink,
      *b_q_norm, *b_k_norm, *c_w0, *c_w_up, *c_a0, *c_a_up, *c_g_up, *c_k_k, *c_k_a, *c_r_k, *c_ln_w, *c_ln_b,
      *w_gu, *w_down;
  float* out;
  unsigned char* ws;
  int ph_lo, ph_hi;
};

typedef __bf16 bf16x2_t __attribute__((ext_vector_type(2)));
typedef float f32x2_t __attribute__((ext_vector_type(2)));
__device__ __forceinline__ unsigned pk_bf16(float lo, float hi) {
  f32x2_t f = {lo, hi};
  bf16x2_t b = __builtin_convertvector(f, bf16x2_t);
  return __builtin_bit_cast(unsigned, b);
}
__device__ __forceinline__ bf16_t f2bf(float f) { return (bf16_t)(pk_bf16(f, 0.f) & 0xffffu); }
__device__ __forceinline__ float bf2f(bf16_t b) { return __uint_as_float(((unsigned)b) << 16); }
__device__ __forceinline__ float bflo(unsigned u) { return __uint_as_float(u << 16); }
__device__ __forceinline__ float bfhi(unsigned u) { return __uint_as_float(u & 0xffff0000u); }
__device__ __forceinline__ int opq_tid() { int x = threadIdx.x; asm volatile("" : "+v"(x)); return x; }
__device__ __forceinline__ int opq_bid() { int x = blockIdx.x; asm volatile("" : "+s"(x)); return x; }
__device__ __forceinline__ float4 cvt4(uint2 u) { return make_float4(bflo(u.x), bfhi(u.x), bflo(u.y), bfhi(u.y)); }
__device__ __forceinline__ float frcp(float x) { return __builtin_amdgcn_rcpf(x); }
__device__ __forceinline__ float sigmoidf_(float x) { return frcp(1.f + __expf(-x)); }
__device__ __forceinline__ float wave_sum(float v) {
#pragma unroll
  for (int o = 1; o < 64; o <<= 1) v += __shfl_xor(v, o);
  return v;
}
template <int CTRL>
__device__ __forceinline__ float dppf(float x) {
  return __builtin_bit_cast(float, __builtin_amdgcn_mov_dpp(__builtin_bit_cast(int, x), CTRL, 0xf, 0xf, true));
}
constexpr int DPP_XOR1 = 0xB1, DPP_XOR2 = 0x4E, DPP_ROR4 = 0x124, DPP_ROR8 = 0x128;
__device__ __forceinline__ float row16_sum(float v) {
  v += dppf<DPP_XOR1>(v);
  v += dppf<DPP_XOR2>(v);
  v += dppf<DPP_ROR4>(v);
  v += dppf<DPP_ROR8>(v);
  return v;
}
__device__ __forceinline__ f32x4 mfma16(bf16x8 a, bf16x8 b, f32x4 c) {
  return __builtin_amdgcn_mfma_f32_16x16x32_bf16(a, b, c, 0, 0, 0);
}

__device__ __forceinline__ void transpose_tile(const float* __restrict__ src, int K, int N, bf16_t* __restrict__ dst,
                                               int tile, bool perm, float* lds) {
  const int nkt = K / 64, nnt = N / 64, per = nkt * nnt;
  const int lyr = tile / per, r = tile % per, kt = r / nnt, nt = r % nnt;
  src += (size_t)lyr * K * N;
  dst += (size_t)lyr * K * N;
  const int tid = opq_tid();
#pragma unroll
  for (int i = 0; i < 16; ++i) {
    const int row = (tid >> 6) + 4 * i;
    lds[row * 65 + (tid & 63)] = src[(size_t)(kt * 64 + row) * N + nt * 64 + (tid & 63)];
  }
  __syncthreads();
#pragma unroll
  for (int it = 0; it < 2; ++it) {
    const int idx = tid + it * 256, n = idx >> 3, kc = idx & 7;
    uint4 v;
    v.x = pk_bf16(lds[(kc * 8 + 0) * 65 + n], lds[(kc * 8 + 1) * 65 + n]);
    v.y = pk_bf16(lds[(kc * 8 + 2) * 65 + n], lds[(kc * 8 + 3) * 65 + n]);
    v.z = pk_bf16(lds[(kc * 8 + 4) * 65 + n], lds[(kc * 8 + 5) * 65 + n]);
    v.w = pk_bf16(lds[(kc * 8 + 6) * 65 + n], lds[(kc * 8 + 7) * 65 + n]);
    const int col = nt * 64 + n;
    int prow = col;
    if (perm) {
      if (col < FF) prow = (col >> 5) * 64 + (col & 31);
      else { const int c2 = col - FF; prow = (c2 >> 5) * 64 + 32 + (c2 & 31); }
    }
    *(uint4*)(dst + (size_t)prow * K + kt * 64 + kc * 8) = v;
  }
  __syncthreads();
}

__device__ __forceinline__ void gemv_item(const Params& p, int item, float* lds) {
  const int l = item / 192, n0 = (item % 192) * 32;
  const int tid = opq_tid();
  float* s_c = lds;
  float* red = lds + 3072;
  for (int i = tid; i < 3072; i += 256) {
    const int ci = i >> 10, k = i & 1023;
    const float x = (ci == 0) ? p.c_ctx[k] : p.c[(ci - 1) * 1024 + k];
    s_c[i] = x * sigmoidf_(x);
  }
  __syncthreads();
  const int kg = tid >> 5, col = tid & 31;
  const float* w = p.w_mod + (size_t)l * 1024 * 6144 + (size_t)(kg * 128) * 6144 + n0 + col;
  float a0 = 0.f, a1 = 0.f, a2 = 0.f;
#pragma unroll 32
  for (int k = 0; k < 128; ++k) {
    const float wv = __builtin_nontemporal_load(w + (size_t)k * 6144);
    a0 += s_c[kg * 128 + k] * wv;
    a1 += s_c[1024 + kg * 128 + k] * wv;
    a2 += s_c[2048 + kg * 128 + k] * wv;
  }
  red[(kg * 3 + 0) * 32 + col] = a0;
  red[(kg * 3 + 1) * 32 + col] = a1;
  red[(kg * 3 + 2) * 32 + col] = a2;
  __syncthreads();
  if (tid < 96) {
    const int ci = tid >> 5, cc = tid & 31;
    float sum = p.b_mod[l * 6144 + n0 + cc];
#pragma unroll
    for (int g = 0; g < 8; ++g) sum += red[(g * 3 + ci) * 32 + cc];
    ((float*)(p.ws + WS_MOD))[(l * 3 + ci) * 6144 + n0 + cc] = sum;
  }
  __syncthreads();
}

constexpr int WL_IN = 16 * 40, WL_OUT = 16 * 16, WL_GU = 16 * 88, WL_DN = 44 * 16, WL_UP = 2 * 6, WL_G = 2 * 6;
constexpr int WL_TOTAL = WL_IN + WL_OUT + WL_GU + WL_DN + 2 * WL_UP + WL_G;
__device__ __forceinline__ void weight_item(const Params& p, int layer, int r, float* lds) {
  if (r < WL_IN) { transpose_tile(p.w_in, 1024, IN_COLS, (bf16_t*)(p.ws + WS_WT_IN), layer * WL_IN + r, false, lds); return; }
  r -= WL_IN;
  if (r < WL_OUT) { transpose_tile(p.w_out, 1024, 1024, (bf16_t*)(p.ws + WS_WT_OUT), layer * WL_OUT + r, false, lds); return; }
  r -= WL_OUT;
  if (r < WL_GU) { transpose_tile(p.w_gu, 1024, GU, (bf16_t*)(p.ws + WS_WT_GU), layer * WL_GU + r, true, lds); return; }
  r -= WL_GU;
  if (r < WL_DN) { transpose_tile(p.w_down, FF, 1024, (bf16_t*)(p.ws + WS_WT_DN), layer * WL_DN + r, false, lds); return; }
  r -= WL_DN;
  if (r < WL_UP) { transpose_tile(p.c_w_up, 64, 384, (bf16_t*)(p.ws + WS_WUPT), layer * WL_UP + r, false, lds); return; }
  r -= WL_UP;
  if (r < WL_UP) { transpose_tile(p.c_a_up, 64, 384, (bf16_t*)(p.ws + WS_AUPT), layer * WL_UP + r, false, lds); return; }
  r -= WL_UP;
  transpose_tile(p.c_g_up, 128, 384, (bf16_t*)(p.ws + WS_GUPT), layer * WL_G + r, false, lds);
}

constexpr int P0_GEMV = 384;
constexpr int P0_ROPE = 128, P0_CACHE = 256;
constexpr int P0_TOTAL = P0_GEMV + WL_TOTAL + P0_ROPE + P0_CACHE;

__device__ __forceinline__ void phase0(const Params& p, unsigned char* smem) {
  float* lds = (float*)smem;
  const int tid = opq_tid();
  const int bid = opq_bid();
  if (bid == 0 && tid < 64) ((unsigned*)(p.ws + WS_CNT))[tid] = 0u;
  for (int it = bid; it < P0_TOTAL; it += gridDim.x) {
    int r = it;
    if (r < P0_GEMV) { gemv_item(p, r, lds); continue; }
    r -= P0_GEMV;
    if (r < WL_TOTAL) { weight_item(p, 0, r, lds); continue; }
    r -= WL_TOTAL;
    if (r < P0_ROPE) {
      const int idx = r * 256 + tid, t = idx >> 5, i = idx & 31, fi = i & 15;
      const float pos = (i < 16) ? (float)(t >> 6) : (float)(t & 63);
      const float freq = exp2f(-(float)fi * (13.287712379549449f / 16.f));
      float rev = pos * freq * 0.15915494309189535f;
      rev -= floorf(rev);
      float2 cs;
      cs.x = __builtin_amdgcn_cosf(rev);
      cs.y = __builtin_amdgcn_sinf(rev);
      ((float2*)(p.ws + WS_ROPE))[idx] = cs;
      continue;
    }
    r -= P0_ROPE;
    {
#pragma unroll
      for (int j = 0; j < 8; ++j) {
        const int idx = r * 2048 + j * 256 + tid;
        const int tensor = idx >> 17, e = idx & 131071;
        const float* src = tensor == 0 ? p.cache_a_k : tensor == 1 ? p.cache_a_v : tensor == 2 ? p.cache_b_k : p.cache_b_v;
        bf16_t* dst = (bf16_t*)(p.ws + (tensor == 0 ? WS_CKA : tensor == 1 ? WS_CVTA : tensor == 2 ? WS_CKB : WS_CVTB));
        int b, l, h, t, d;
        if ((tensor & 1) == 0) { d = e & 63; t = (e >> 6) & 255; h = (e >> 14) & 1; l = (e >> 15) & 1; b = e >> 16; }
        else { t = e & 255; d = (e >> 8) & 63; h = (e >> 14) & 1; l = (e >> 15) & 1; b = e >> 16; }
        dst[e] = f2bf(src[((((size_t)b * 2 + l) * 256 + t) * 2 + h) * 64 + d]);
      }
    }
  }
}

__device__ __forceinline__ void rpass(const Params& p, int mode, int l) {
  const int tid_ = opq_tid(); const int lane = tid_ & 63, wave = tid_ >> 6;
  const float* MOD = (const float*)(p.ws + WS_MOD);
  const bf16_t* O = (const bf16_t*)(p.ws + WS_DEC);
  float* X = p.out + OUT_X;
  bf16_t* H = (bf16_t*)(p.ws + WS_H);
  for (int row = opq_bid() * 4 + wave; row < MTOT; row += gridDim.x * 4) {
    const int ci = row < M_CTX ? 0 : 1 + ((row - M_CTX) >> 10);
    const float* xs;
    if (mode == 0 || (mode == 1 && l == 0)) xs = row < M_CTX ? p.x_prompt + (size_t)row * D : p.x_sample + (size_t)(row - M_CTX) * D;
    else xs = X + (size_t)row * D;
    float4 x[4];
#pragma unroll
    for (int j = 0; j < 4; ++j) x[j] = *(const float4*)(xs + j * 256 + lane * 4);
    if (mode != 0) {
      float4 o[4];
      float ss = 0.f;
#pragma unroll
      for (int j = 0; j < 4; ++j) {
        o[j] = cvt4(*(const uint2*)(O + (size_t)row * D + j * 256 + lane * 4));
        ss += o[j].x * o[j].x + o[j].y * o[j].y + o[j].z * o[j].z + o[j].w * o[j].w;
      }
      ss = wave_sum(ss);
      const float rs = __builtin_amdgcn_rsqf(ss * (1.f / D) + 1e-6f);
      const float* gate = MOD + (l * 3 + ci) * 6144 + (mode == 1 ? 2 : 5) * 1024;
      const float* gp = (mode == 1 ? p.norm_mix_post : p.norm_ffn_post) + l * D;
#pragma unroll
      for (int j = 0; j < 4; ++j) {
        const float4 g = *(const float4*)(gate + j * 256 + lane * 4);
        const float4 w = *(const float4*)(gp + j * 256 + lane * 4);
        x[j].x += g.x * (o[j].x * rs * w.x);
        x[j].y += g.y * (o[j].y * rs * w.y);
        x[j].z += g.z * (o[j].z * rs * w.z);
        x[j].w += g.w * (o[j].w * rs * w.w);
        *(float4*)(X + (size_t)row * D + j * 256 + lane * 4) = x[j];
      }
    }
    if (mode == 2 && l == 1) continue;
    const int nl = (mode == 2) ? l + 1 : l;
    float ss2 = 0.f;
#pragma unroll
    for (int j = 0; j < 4; ++j) ss2 += x[j].x * x[j].x + x[j].y * x[j].y + x[j].z * x[j].z + x[j].w * x[j].w;
    ss2 = wave_sum(ss2);
    const float rs2 = __builtin_amdgcn_rsqf(ss2 * (1.f / D) + 1e-6f);
    const float* gpre = (mode == 1 ? p.norm_ffn_pre : p.norm_mix_pre) + nl * D;
    const float* sc = MOD + (nl * 3 + ci) * 6144 + (mode == 1 ? 4 : 1) * 1024;
    const float* sh = MOD + (nl * 3 + ci) * 6144 + (mode == 1 ? 3 : 0) * 1024;
#pragma unroll
    for (int j = 0; j < 4; ++j) {
      const float4 g = *(const float4*)(gpre + j * 256 + lane * 4);
      const float4 s = *(const float4*)(sc + j * 256 + lane * 4);
      const float4 t = *(const float4*)(sh + j * 256 + lane * 4);
      const float h0 = x[j].x * rs2 * g.x * (1.f + s.x) + t.x;
      const float h1 = x[j].y * rs2 * g.y * (1.f + s.y) + t.y;
      const float h2 = x[j].z * rs2 * g.z * (1.f + s.z) + t.z;
      const float h3 = x[j].w * rs2 * g.w * (1.f + s.w) + t.w;
      uint2 v;
      v.x = pk_bf16(h0, h1);
      v.y = pk_bf16(h2, h3);
      *(uint2*)(H + (size_t)row * D + j * 256 + lane * 4) = v;
    }
  }
}

template <int FN>
__device__ __forceinline__ float xform(float t) {
  if (FN == 1) { const float e = __expf(2.f * t); return 1.f - 2.f * frcp(e + 1.f); }
  if (FN == 2) return sigmoidf_(t);
  return t;
}
__device__ __forceinline__ void epi_f32(const Params& p, f32x4 (&acc)[4][4], int rb, int cb, int lane) {
  const int fr = lane & 15, fq = lane >> 4;
  float* O = (float*)(p.ws + WS_DEC);
#pragma unroll
  for (int m = 0; m < 4; ++m)
#pragma unroll
    for (int n = 0; n < 4; ++n)
#pragma unroll
      for (int j = 0; j < 4; ++j) O[(size_t)(rb + m * 16 + fq * 4 + j) * D + cb + n * 16 + fr] = acc[m][n][j];
}

__device__ __forceinline__ void epi_gu(const Params& p, f32x4 (&acc)[4][4], int rb, int cb, int lane) {
  const int fr = lane & 15, fq = lane >> 4;
  bf16_t* ACT = (bf16_t*)(p.ws + WS_CZ);
  const int chunk = cb >> 6;
#pragma unroll
  for (int m = 0; m < 4; ++m)
#pragma unroll
    for (int n = 0; n < 2; ++n)
#pragma unroll
      for (int j = 0; j < 4; ++j) {
        const float g = acc[m][n][j], u = acc[m][n + 2][j];
        const float a = g * sigmoidf_(g) * u;
        ACT[(size_t)(rb + m * 16 + fq * 4 + j) * FF + chunk * 32 + n * 16 + fr] = f2bf(a);
      }
}

__device__ __forceinline__ void epi_in(const Params& p, int l, f32x4 (&acc)[4][4], int rb, int cb, int lane) {
  const int fr = lane & 15, fq = lane >> 4;
  const int cidx = cb >> 6;
  const bool lat = rb >= M_CTX;
  if (cidx >= 36) {
    bf16_t* PA = (bf16_t*)(p.ws + WS_PA);
    const int pc = cb - 2304;
#pragma unroll
    for (int m = 0; m < 4; ++m)
#pragma unroll
      for (int n = 0; n < 4; ++n)
#pragma unroll
        for (int j = 0; j < 4; ++j) {
          float t = acc[m][n][j];
          if (cidx == 36) t = xform<1>(t); else if (cidx >= 38) t = xform<2>(t);
          PA[(size_t)(rb + m * 16 + fq * 4 + j) * 256 + pc + n * 16 + fr] = f2bf(t);
        }
    return;
  }
  if (cidx >= 18) {
    float* CZ = (float*)(p.ws + WS_CZ);
    const int cc = cb - 1152;
#pragma unroll
    for (int m = 0; m < 4; ++m)
#pragma unroll
      for (int n = 0; n < 4; ++n)
#pragma unroll
        for (int j = 0; j < 4; ++j) CZ[(size_t)(rb + m * 16 + fq * 4 + j) * 1408 + cc + n * 16 + fr] = acc[m][n][j];
    return;
  }
  if (cidx >= 8 && cidx < 16) {
    const float* gw = (cidx < 14 ? p.b_q_norm : p.b_k_norm) + l * 64;
    float g[4];
#pragma unroll
    for (int n = 0; n < 4; ++n) g[n] = gw[n * 16 + fr];
#pragma unroll
    for (int m = 0; m < 4; ++m)
#pragma unroll
      for (int j = 0; j < 4; ++j) {
        float ss = 0.f;
#pragma unroll
        for (int n = 0; n < 4; ++n) ss += acc[m][n][j] * acc[m][n][j];
        ss = row16_sum(ss);
        const float rs = __builtin_amdgcn_rsqf(ss * (1.f / 64.f) + 1e-6f);
#pragma unroll
        for (int n = 0; n < 4; ++n) acc[m][n][j] *= rs * g[n];
      }
  }
  const bool isv = (cidx == 6 || cidx == 7 || cidx == 16 || cidx == 17);
  if (lat && !isv) {
    const float2* ROPE = (const float2*)(p.ws + WS_ROPE);
#pragma unroll
    for (int m = 0; m < 4; ++m)
#pragma unroll
      for (int j = 0; j < 4; ++j) {
        const int t = (rb + m * 16 + fq * 4 + j - M_CTX) & 1023;
        const float2 a0 = ROPE[t * 32 + fr], a1 = ROPE[t * 32 + 16 + fr];
        float x1 = acc[m][0][j], x2 = acc[m][2][j];
        acc[m][0][j] = x1 * a0.x - x2 * a0.y;
        acc[m][2][j] = x1 * a0.y + x2 * a0.x;
        x1 = acc[m][1][j]; x2 = acc[m][3][j];
        acc[m][1][j] = x1 * a1.x - x2 * a1.y;
        acc[m][3][j] = x1 * a1.y + x2 * a1.x;
      }
  }
  if (!isv) {
    bf16_t* QK = (bf16_t*)(p.ws + WS_QK);
    const int qc = (cidx < 6) ? cb : cb - 128;
#pragma unroll
    for (int m = 0; m < 4; ++m)
#pragma unroll
      for (int n = 0; n < 4; ++n)
#pragma unroll
        for (int j = 0; j < 4; ++j) QK[(size_t)(rb + m * 16 + fq * 4 + j) * 896 + qc + n * 16 + fr] = f2bf(acc[m][n][j]);
    if (!lat && (cidx == 4 || cidx == 5 || cidx == 14 || cidx == 15)) {
      float* dst = p.out + (cidx < 6 ? OUT_AK : OUT_BK);
      const int h = cidx & 1;
#pragma unroll
      for (int m = 0; m < 4; ++m)
#pragma unroll
        for (int n = 0; n < 4; ++n)
#pragma unroll
          for (int j = 0; j < 4; ++j) {
            const int row = rb + m * 16 + fq * 4 + j, b = row >> 8, t = row & 255;
            dst[((((size_t)b * 2 + l) * 256 + t) * 2 + h) * 64 + n * 16 + fr] = acc[m][n][j];
          }
    }
  } else {
    bf16_t* VT = (bf16_t*)(p.ws + WS_VT);
    const int vh = (cidx < 8) ? cidx - 6 : 2 + cidx - 16;
#pragma unroll
    for (int m = 0; m < 4; ++m)
#pragma unroll
      for (int n = 0; n < 4; ++n) {
        uint2 v;
        v.x = pk_bf16(acc[m][n][0], acc[m][n][1]);
        v.y = pk_bf16(acc[m][n][2], acc[m][n][3]);
        *(uint2*)(VT + ((size_t)(vh * 64 + n * 16 + fr)) * MTOT + rb + m * 16 + fq * 4) = v;
      }
    if (!lat) {
      float* dst = p.out + (cidx < 8 ? OUT_AV : OUT_BV);
      const int h = cidx & 1;
#pragma unroll
      for (int m = 0; m < 4; ++m)
#pragma unroll
        for (int n = 0; n < 4; ++n)
#pragma unroll
          for (int j = 0; j < 4; ++j) {
            const int row = rb + m * 16 + fq * 4 + j, b = row >> 8, t = row & 255;
            dst[((((size_t)b * 2 + l) * 256 + t) * 2 + h) * 64 + n * 16 + fr] = acc[m][n][j];
          }
    }
  }
}

template <int EPI>
__device__ __forceinline__ void gemm_phase(const Params& p, int l, const bf16_t* __restrict__ A, int lda,
                                           const bf16_t* __restrict__ Bt, int ldb, int N, int K, unsigned char* smem) {
  const int tid = opq_tid(), lane = tid & 63, wid = tid >> 6, wr = wid >> 1, wc = wid & 1, fr = lane & 15, fq = lane >> 4;
  const int bid = opq_bid();
  const int nN = N / 128, ntiles = (MTOT / 128) * nN;
  const int G = gridDim.x, per = G >> 3;
  const int srow = wid * 32 + (lane >> 3);
  const int sw = (fr >> 1) & 7;
  const int nk = K / 64;
  for (int base = 0; base < ntiles; base += G) {
    const int tile = base + (bid & 7) * per + (bid >> 3);
    if (tile >= ntiles) {
      if (EPI == 0 && l == 0) {
        const int nidle = base + G - ntiles;
        for (int it = tile - ntiles; it < WL_TOTAL; it += nidle) weight_item(p, 1, it, (float*)smem);
      }
      continue;
    }
    const int patch = tile >> 5, within = tile & 31, nPN = nN >> 2;
    const int mt = (patch / nPN) * 8 + (within >> 2), nt = (patch % nPN) * 4 + (within & 3);
    const int brow = mt * 128, bcol = nt * 128;
    f32x4 acc[4][4];
#pragma unroll
    for (int m = 0; m < 4; ++m)
#pragma unroll
      for (int n = 0; n < 4; ++n) acc[m][n] = (f32x4){0.f, 0.f, 0.f, 0.f};
    const bf16_t* ga = A + (size_t)(brow + srow) * lda;
    const bf16_t* gb = Bt + (size_t)(bcol + srow) * ldb;
#define GEMM_STAGE(bufi, kt_)                                                                                     \
  {                                                                                                               \
    unsigned char* sa_ = smem + (bufi) * 32768 + wid * 4096 + lane * 16;                                          \
    _Pragma("unroll") for (int i_ = 0; i_ < 4; ++i_) {                                                            \
      const int c_ = (lane & 7) ^ (((srow + i_ * 8) >> 1) & 7);                                                   \
      __builtin_amdgcn_global_load_lds((const unsigned*)(ga + (size_t)(i_ * 8) * lda + (kt_) * 64 + c_ * 8),      \
                                       (unsigned*)(sa_ + i_ * 1024), 16, 0, 0);                                   \
      __builtin_amdgcn_global_load_lds((const unsigned*)(gb + (size_t)(i_ * 8) * ldb + (kt_) * 64 + c_ * 8),      \
                                       (unsigned*)(sa_ + 16384 + i_ * 1024), 16, 0, 0);                           \
    }                                                                                                             \
  }
    __syncthreads();
    GEMM_STAGE(0, 0);
    for (int kt = 0; kt < nk; ++kt) {
      asm volatile("s_waitcnt vmcnt(0)" ::: "memory");
      __syncthreads();
      if (kt + 1 < nk) GEMM_STAGE((kt + 1) & 1, kt + 1);
      const unsigned char* sA = smem + (kt & 1) * 32768;
      const unsigned char* sB = sA + 16384;
#pragma unroll
      for (int s = 0; s < 2; ++s) {
        bf16x8 a[4], b[4];
        const int co = ((s * 4 + fq) ^ sw) << 4;
#pragma unroll
        for (int m = 0; m < 4; ++m) a[m] = *(const bf16x8*)(sA + (wr * 64 + m * 16 + fr) * 128 + co);
#pragma unroll
        for (int n = 0; n < 4; ++n) b[n] = *(const bf16x8*)(sB + (wc * 64 + n * 16 + fr) * 128 + co);
        __builtin_amdgcn_s_setprio(1);
#pragma unroll
        for (int m = 0; m < 4; ++m)
#pragma unroll
          for (int n = 0; n < 4; ++n) acc[m][n] = mfma16(a[m], b[n], acc[m][n]);
        __builtin_amdgcn_s_setprio(0);
      }
    }
    const int rb = brow + wr * 64, cb = bcol + wc * 64;
    if constexpr (EPI == 0) epi_in(p, l, acc, rb, cb, lane);
    else if constexpr (EPI == 1) epi_f32(p, acc, rb, cb, lane);
    else epi_gu(p, acc, rb, cb, lane);
  }
}

constexpr int G160_BUF = 36864;
__device__ __forceinline__ void gemm160_phase(const Params& p, const bf16_t* __restrict__ A, int lda,
                                              const bf16_t* __restrict__ Bt, int ldb, int K, unsigned char* smem) {
  const int tid = opq_tid(), lane = tid & 63, wid = tid >> 6, wr = wid >> 1, wc = wid & 1, fr = lane & 15, fq = lane >> 4;
  const int bid = opq_bid();
  constexpr int nN = 8, ntiles = 64 * nN;
  const int G = gridDim.x, per = G >> 3;
  const int sw = (fr >> 1) & 7;
  const int nk = K / 64;
  const int lrow = lane >> 3;
  bf16_t* O = (bf16_t*)(p.ws + WS_DEC);
  for (int base = 0; base < ntiles; base += G) {
    const int tile = base + (bid & 7) * per + (bid >> 3);
    if (tile >= ntiles) continue;
    const int mt = tile / nN, nt = tile % nN;
    const int brow = mt * 160, bcol = nt * 128;
    f32x4 acc[5][4];
#pragma unroll
    for (int m = 0; m < 5; ++m)
#pragma unroll
      for (int n = 0; n < 4; ++n) acc[m][n] = (f32x4){0.f, 0.f, 0.f, 0.f};
    const bf16_t* ga = A + (size_t)(brow + lrow) * lda;
    const bf16_t* gb = Bt + (size_t)(bcol + wid * 32 + lrow) * ldb;
#define GEMM160_STAGE(bufi, kt_)                                                                                  \
  {                                                                                                               \
    unsigned char* sb_ = smem + (bufi) * G160_BUF;                                                                \
    _Pragma("unroll") for (int i_ = 0; i_ < 5; ++i_) {                                                            \
      const int pc_ = wid + i_ * 4;                                                                               \
      const int c_ = (lane & 7) ^ (((pc_ * 8 + lrow) >> 1) & 7);                                                  \
      __builtin_amdgcn_global_load_lds((const unsigned*)(ga + (size_t)(pc_ * 8) * lda + (kt_) * 64 + c_ * 8),     \
                                       (unsigned*)(sb_ + pc_ * 1024 + lane * 16), 16, 0, 0);                      \
    }                                                                                                             \
    _Pragma("unroll") for (int i_ = 0; i_ < 4; ++i_) {                                                            \
      const int c_ = (lane & 7) ^ (((wid * 32 + i_ * 8 + lrow) >> 1) & 7);                                        \
      __builtin_amdgcn_global_load_lds((const unsigned*)(gb + (size_t)(i_ * 8) * ldb + (kt_) * 64 + c_ * 8),      \
                                       (unsigned*)(sb_ + 20480 + wid * 4096 + i_ * 1024 + lane * 16), 16, 0, 0);  \
    }                                                                                                             \
  }
    __syncthreads();
    GEMM160_STAGE(0, 0);
    for (int kt = 0; kt < nk; ++kt) {
      asm volatile("s_waitcnt vmcnt(0)" ::: "memory");
      __syncthreads();
      if (kt + 1 < nk) GEMM160_STAGE((kt + 1) & 1, kt + 1);
      const unsigned char* sA = smem + (kt & 1) * G160_BUF;
      const unsigned char* sB = sA + 20480;
#pragma unroll
      for (int s = 0; s < 2; ++s) {
        bf16x8 a[5], b[4];
        const int co = ((s * 4 + fq) ^ sw) << 4;
#pragma unroll
        for (int m = 0; m < 5; ++m) a[m] = *(const bf16x8*)(sA + (wr * 80 + m * 16 + fr) * 128 + co);
#pragma unroll
        for (int n = 0; n < 4; ++n) b[n] = *(const bf16x8*)(sB + (wc * 64 + n * 16 + fr) * 128 + co);
        __builtin_amdgcn_s_setprio(1);
#pragma unroll
        for (int m = 0; m < 5; ++m)
#pragma unroll
          for (int n = 0; n < 4; ++n) acc[m][n] = mfma16(a[m], b[n], acc[m][n]);
        __builtin_amdgcn_s_setprio(0);
      }
    }
#pragma unroll
    for (int m = 0; m < 5; ++m)
#pragma unroll
      for (int n = 0; n < 4; ++n)
#pragma unroll
        for (int j = 0; j < 4; ++j)
          O[(size_t)(brow + wr * 80 + m * 16 + fq * 4 + j) * D + bcol + wc * 64 + n * 16 + fr] = f2bf(acc[m][n][j]);
  }
}

template <int FN>
__device__ __forceinline__ bf16x8 ld_frag_f32(const float* src) {
  const float4 u = *(const float4*)src, v = *(const float4*)(src + 4);
  union { uint4 u4; bf16x8 v8; } r;
  r.u4.x = pk_bf16(xform<FN>(u.x), xform<FN>(u.y));
  r.u4.y = pk_bf16(xform<FN>(u.z), xform<FN>(u.w));
  r.u4.z = pk_bf16(xform<FN>(v.x), xform<FN>(v.y));
  r.u4.w = pk_bf16(xform<FN>(v.z), xform<FN>(v.w));
  return r.v8;
}

__device__ __forceinline__ void prep_phase(const Params& p, int l, unsigned char* smem) {
  const int tid = opq_tid(), lane = tid & 63, wid = tid >> 6, fr = lane & 15, fq = lane >> 4;
  const float* CZ = (const float*)(p.ws + WS_CZ);
  float* DEC = (float*)(p.ws + WS_DEC);
  bf16_t* KT = (bf16_t*)(p.ws + WS_KT);
  bf16_t* BB = (bf16_t*)(p.ws + WS_BB);
  bf16_t* KK = (bf16_t*)(p.ws + WS_KK);
  bf16_t* Gb = (bf16_t*)(p.ws + WS_G);
  float* BON = (float*)(p.ws + WS_BON);
  const bf16_t* WUPT = (const bf16_t*)(p.ws + WS_WUPT);
  const bf16_t* AUPT = (const bf16_t*)(p.ws + WS_AUPT);
  const bf16_t* GUPT = (const bf16_t*)(p.ws + WS_GUPT);
  const bf16_t* PA = (const bf16_t*)(p.ws + WS_PA);
  const int swz = (fr >> 1) & 7;
  for (int u = opq_bid(); u < 80 * 6; u += gridDim.x) {
    const int tile = u / 6, h = u % 6;
    __syncthreads();
    {
      uint4 tw_[4], tg_[4];
#pragma unroll
      for (int i = 0; i < 4; ++i) {
        const bf16_t* src = (i < 2 ? WUPT : AUPT) + ((unsigned)(l * 2 + (i & 1)) * 384 + h * 64) * 64;
        const int pc0 = tid, pc1 = tid + 256;
        const uint4 v0 = *(const uint4*)(src + (pc0 >> 3) * 64 + (pc0 & 7) * 8);
        const uint4 v1 = *(const uint4*)(src + (pc1 >> 3) * 64 + (pc1 & 7) * 8);
        tw_[i] = v0; tg_[i] = v1;
      }
#pragma unroll
      for (int i = 0; i < 4; ++i) {
        const int pc0 = tid, pc1 = tid + 256;
        *(uint4*)(smem + i * 8192 + (pc0 >> 3) * 128 + (((pc0 & 7) ^ (((pc0 >> 3) >> 1) & 7)) << 4)) = tw_[i];
        *(uint4*)(smem + i * 8192 + (pc1 >> 3) * 128 + (((pc1 & 7) ^ (((pc1 >> 3) >> 1) & 7)) << 4)) = tg_[i];
      }
#pragma unroll
      for (int i = 0; i < 4; ++i) {
        const int pc = tid + i * 256, col = pc >> 4, chn = pc & 15;
        const uint4 v = *(const uint4*)(GUPT + ((unsigned)l * 384 + h * 64 + col) * 128 + chn * 8);
        *(uint4*)(smem + 32768 + col * 256 + ((chn ^ (col & 15)) << 4)) = v;
      }
    }
    __syncthreads();
#pragma unroll 1
    for (int mb = 0; mb < 2; ++mb) {
      const int rb = tile * 128 + wid * 32 + mb * 16;
      const int arow = rb + fr;
      bf16x8 ftw[2], fxa[2];
#pragma unroll
      for (int ks = 0; ks < 2; ++ks) {
        ftw[ks] = *(const bf16x8*)(PA + (unsigned)arow * 256 + ks * 32 + fq * 8);
        fxa[ks] = *(const bf16x8*)(PA + (unsigned)arow * 256 + 64 + ks * 32 + fq * 8);
      }
      float kv[4][4], rv[4][4], kkn[4][4], bon[4];
      float kkw[4], kaw[4], rkw[4];
#pragma unroll
      for (int n = 0; n < 4; ++n) {
        kkw[n] = p.c_k_k[l * 384 + h * 64 + n * 16 + fr];
        kaw[n] = p.c_k_a[l * 384 + h * 64 + n * 16 + fr];
        rkw[n] = p.c_r_k[l * 384 + h * 64 + n * 16 + fr];
      }
#pragma unroll
      for (int j = 0; j < 4; ++j) {
        const int row = rb + fq * 4 + j;
        float ss = 0.f;
#pragma unroll
        for (int n = 0; n < 4; ++n) {
          kv[n][j] = CZ[(unsigned)row * 1408 + 384 + h * 64 + n * 16 + fr];
          rv[n][j] = CZ[(unsigned)row * 1408 + h * 64 + n * 16 + fr];
          kkn[n][j] = kv[n][j] * kkw[n];
          ss += kkn[n][j] * kkn[n][j];
        }
        ss = row16_sum(ss);
        const float rs = __builtin_amdgcn_rsqf(ss + 1e-12f);
#pragma unroll
        for (int n = 0; n < 4; ++n) {
          kkn[n][j] *= rs;
          KK[(unsigned)row * 384 + h * 64 + n * 16 + fr] = f2bf(kkn[n][j]);
        }
        bon[j] = 0.f;
      }
#pragma unroll 1
      for (int d = 0; d < 2; ++d) {
        f32x4 aw[4], aa[4];
#pragma unroll
        for (int n = 0; n < 4; ++n) {
          aw[n] = (f32x4){0.f, 0.f, 0.f, 0.f};
          aa[n] = (f32x4){0.f, 0.f, 0.f, 0.f};
          const int col = h * 64 + n * 16 + fr;
#pragma unroll
          for (int ks = 0; ks < 2; ++ks) {
            const bf16x8 bw = *(const bf16x8*)(smem + d * 8192 + (n * 16 + fr) * 128 + (((ks * 4 + fq) ^ swz) << 4));
            const bf16x8 ba = *(const bf16x8*)(smem + 16384 + d * 8192 + (n * 16 + fr) * 128 + (((ks * 4 + fq) ^ swz) << 4));
            aw[n] = mfma16(ftw[ks], bw, aw[n]);
            aa[n] = mfma16(fxa[ks], ba, aa[n]);
          }
        }
#pragma unroll
        for (int n = 0; n < 4; ++n) {
          const int col = h * 64 + n * 16 + fr;
          const float w0 = p.c_w0[(l * 2 + d) * 384 + col], a0 = p.c_a0[(l * 2 + d) * 384 + col];
#pragma unroll
          for (int j = 0; j < 4; ++j) {
            const int row = rb + fq * 4 + j;
            const float dec = __expf(-0.6065306597126334f * sigmoidf_(aw[n][j] + w0));
            const float a = sigmoidf_(aa[n][j] + a0);
            const float kt = kv[n][j] * (1.f + (a - 1.f) * kaw[n]);
            DEC[((unsigned)d * MTOT + row) * 384 + col] = dec;
            KT[((unsigned)d * MTOT + row) * 384 + col] = f2bf(kt);
            BB[((unsigned)d * MTOT + row) * 384 + col] = f2bf(kkn[n][j] * a);
            bon[j] += rv[n][j] * kt * rkw[n];
          }
        }
      }
#pragma unroll
      for (int j = 0; j < 4; ++j) {
        const float b = row16_sum(bon[j]);
        if (fr == 0) BON[(unsigned)(rb + fq * 4 + j) * 8 + h] = b;
      }
      f32x4 ag[4];
#pragma unroll
      for (int n = 0; n < 4; ++n) ag[n] = (f32x4){0.f, 0.f, 0.f, 0.f};
#pragma unroll
      for (int ks = 0; ks < 4; ++ks) {
        const bf16x8 fa = *(const bf16x8*)(PA + (unsigned)arow * 256 + 128 + ks * 32 + fq * 8);
#pragma unroll
        for (int n = 0; n < 4; ++n) {
          const int col = h * 64 + n * 16 + fr;
          const bf16x8 bg = *(const bf16x8*)(smem + 32768 + (n * 16 + fr) * 256 + (((ks * 4 + fq) ^ fr) << 4));
          ag[n] = mfma16(fa, bg, ag[n]);
        }
      }
#pragma unroll
      for (int n = 0; n < 4; ++n)
#pragma unroll
        for (int j = 0; j < 4; ++j) Gb[(unsigned)(rb + fq * 4 + j) * 384 + h * 64 + n * 16 + fr] = f2bf(ag[n][j]);
    }
  }
}


typedef float f32x2 __attribute__((ext_vector_type(2)));
__device__ __forceinline__ f32x2 fma2(f32x2 a, f32x2 b, f32x2 c) { return __builtin_elementwise_fma(a, b, c); }

struct ScanSrc { const float* DEC; const bf16_t* KT; const bf16_t* BB; const bf16_t* KK; const float* CZ; int row0, T, d, hoff, ls, lc; };
#define SCAN_DECL(P) float4 P##w, P##r, P##v; uint2 P##kt, P##kk, P##b;
#define SCAN_GLOAD(P, chunk)                                                         \
  {                                                                                  \
    int t_ = (chunk) * 16 + sc.ls;                                                   \
    if (sc.d) t_ = sc.T - 1 - t_;                                                    \
    const unsigned row_ = (unsigned)(sc.row0 + t_);                                  \
    P##w = *(const float4*)(sc.DEC + row_ * 384u + sc.hoff + sc.lc);                 \
    P##kt = *(const uint2*)(sc.KT + row_ * 384u + sc.hoff + sc.lc);                  \
    P##kk = *(const uint2*)(sc.KK + row_ * 384u + sc.hoff + sc.lc);                  \
    P##b = *(const uint2*)(sc.BB + row_ * 384u + sc.hoff + sc.lc);                   \
    P##r = *(const float4*)(sc.CZ + row_ * 1408u + sc.hoff + sc.lc);                 \
    P##v = *(const float4*)(sc.CZ + row_ * 1408u + 768 + sc.hoff + sc.lc);           \
  }
#define SCAN_LSTORE(P, b_)                                                           \
  {                                                                                  \
    float* dst_ = buf + (((b_) * 16 + sc.ls) * 6) * 64 + sc.lc;                      \
    const float4 kk_ = cvt4(P##kk);                                                  \
    *(float4*)(dst_) = P##w;                                                         \
    *(float4*)(dst_ + 64) = cvt4(P##kt);                                             \
    *(float4*)(dst_ + 128) = make_float4(-kk_.x, -kk_.y, -kk_.z, -kk_.w);           \
    *(float4*)(dst_ + 192) = cvt4(P##b);                                             \
    *(float4*)(dst_ + 256) = P##r;                                                   \
    *(float4*)(dst_ + 320) = P##v;                                                   \
  }

template <int R>
__device__ __forceinline__ void scan_chunk(f32x2 (&S)[R][2], const float* cbuf, int k0, int v0, int kq,
                                           bf16_t* Yhv, int row0, int T, int d, int ch) {
  const float* sb = cbuf + k0;
  const float* vb = cbuf + 320 + v0;
  float ykeep[R];
#pragma unroll
  for (int j = 0; j < R; ++j) ykeep[j] = 0.f;
  f32x4 cw, ckt, ca, cbv, cr;
  float cvv[R];
  cw = *(const f32x4*)(sb);
  ckt = *(const f32x4*)(sb + 64);
  ca = *(const f32x4*)(sb + 128);
  cbv = *(const f32x4*)(sb + 192);
  cr = *(const f32x4*)(sb + 256);
  if constexpr (R == 4) { const f32x4 t = *(const f32x4*)vb; cvv[0] = t.x; cvv[1] = t.y; cvv[2] = t.z; cvv[3] = t.w; }
  else {
#pragma unroll
    for (int j = 0; j < R; ++j) cvv[j] = vb[j];
  }
#pragma unroll
  for (int s = 0; s < 16; ++s) {
    f32x4 nw, nkt, na, nbv, nr;
    float nvv[R];
    if (s < 15) {
      nw = *(const f32x4*)(sb + (s + 1) * 384);
      nkt = *(const f32x4*)(sb + (s + 1) * 384 + 64);
      na = *(const f32x4*)(sb + (s + 1) * 384 + 128);
      nbv = *(const f32x4*)(sb + (s + 1) * 384 + 192);
      nr = *(const f32x4*)(sb + (s + 1) * 384 + 256);
      if constexpr (R == 4) { const f32x4 t = *(const f32x4*)(vb + (s + 1) * 384); nvv[0] = t.x; nvv[1] = t.y; nvv[2] = t.z; nvv[3] = t.w; }
      else {
#pragma unroll
        for (int j = 0; j < R; ++j) nvv[j] = vb[(s + 1) * 384 + j];
      }
    }
#pragma unroll
    for (int j = 0; j < R; ++j) {
      f32x2 acc = S[j][0] * ca.xy;
      acc = fma2(S[j][1], ca.zw, acc);
      float sa = acc.x + acc.y;
      sa += dppf<DPP_XOR1>(sa);
      sa += dppf<DPP_XOR2>(sa);
      sa += dppf<DPP_ROR4>(sa);
      sa += dppf<DPP_ROR8>(sa);
      const f32x2 sa2 = {sa, sa}, vv2 = {cvv[j], cvv[j]};
      S[j][0] = fma2(S[j][0], cw.xy, fma2(sa2, cbv.xy, vv2 * ckt.xy));
      S[j][1] = fma2(S[j][1], cw.zw, fma2(sa2, cbv.zw, vv2 * ckt.zw));
      f32x2 yacc = S[j][0] * cr.xy;
      yacc = fma2(S[j][1], cr.zw, yacc);
      float y = yacc.x + yacc.y;
      y += dppf<DPP_XOR1>(y);
      y += dppf<DPP_XOR2>(y);
      y += dppf<DPP_ROR4>(y);
      y += dppf<DPP_ROR8>(y);
      ykeep[j] = (kq == s) ? y : ykeep[j];
    }
    if (s < 15) {
      cw = nw; ckt = nkt; ca = na; cbv = nbv; cr = nr;
#pragma unroll
      for (int j = 0; j < R; ++j) cvv[j] = nvv[j];
    }
  }
  int t = ch * 16 + kq;
  if (d) t = T - 1 - t;
#pragma unroll
  for (int j = 0; j < R; ++j) Yhv[(unsigned)(row0 + t) * 384u + j] = f2bf(ykeep[j]);
}

constexpr int DPP_HMIRROR = 0x141;
__device__ __forceinline__ void scan_chunk8(f32x2 (&S)[2][4], const float* cbuf, int k0, int v0, int kq,
                                            bf16_t* Yhv, int row0, int T, int d, int ch) {
  const float* sb = cbuf + k0;
  const float* vb = cbuf + 320 + v0;
  float ykeep[2][2];
#pragma unroll
  for (int j = 0; j < 2; ++j) { ykeep[j][0] = 0.f; ykeep[j][1] = 0.f; }
  f32x4 cw[2], ckt[2], ca[2], cbv[2], cr[2];
  f32x2 cvv;
#pragma unroll
  for (int q = 0; q < 2; ++q) {
    cw[q] = *(const f32x4*)(sb + q * 4);
    ckt[q] = *(const f32x4*)(sb + 64 + q * 4);
    ca[q] = *(const f32x4*)(sb + 128 + q * 4);
    cbv[q] = *(const f32x4*)(sb + 192 + q * 4);
    cr[q] = *(const f32x4*)(sb + 256 + q * 4);
  }
  cvv = *(const f32x2*)vb;
#pragma unroll
  for (int s = 0; s < 16; ++s) {
    f32x4 nw[2], nkt[2], na[2], nbv[2], nr[2];
    f32x2 nvv = {0.f, 0.f};
    if (s < 15) {
#pragma unroll
      for (int q = 0; q < 2; ++q) {
        nw[q] = *(const f32x4*)(sb + (s + 1) * 384 + q * 4);
        nkt[q] = *(const f32x4*)(sb + (s + 1) * 384 + 64 + q * 4);
        na[q] = *(const f32x4*)(sb + (s + 1) * 384 + 128 + q * 4);
        nbv[q] = *(const f32x4*)(sb + (s + 1) * 384 + 192 + q * 4);
        nr[q] = *(const f32x4*)(sb + (s + 1) * 384 + 256 + q * 4);
      }
      nvv = *(const f32x2*)(vb + (s + 1) * 384);
    }
#pragma unroll
    for (int j = 0; j < 2; ++j) {
      f32x2 acc = S[j][0] * ca[0].xy;
      acc = fma2(S[j][1], ca[0].zw, acc);
      acc = fma2(S[j][2], ca[1].xy, acc);
      acc = fma2(S[j][3], ca[1].zw, acc);
      float sa = acc.x + acc.y;
      sa += dppf<DPP_XOR1>(sa);
      sa += dppf<DPP_XOR2>(sa);
      sa += dppf<DPP_HMIRROR>(sa);
      const float vj = j ? cvv.y : cvv.x;
      const f32x2 sa2 = {sa, sa}, vv2 = {vj, vj};
      S[j][0] = fma2(S[j][0], cw[0].xy, fma2(sa2, cbv[0].xy, vv2 * ckt[0].xy));
      S[j][1] = fma2(S[j][1], cw[0].zw, fma2(sa2, cbv[0].zw, vv2 * ckt[0].zw));
      S[j][2] = fma2(S[j][2], cw[1].xy, fma2(sa2, cbv[1].xy, vv2 * ckt[1].xy));
      S[j][3] = fma2(S[j][3], cw[1].zw, fma2(sa2, cbv[1].zw, vv2 * ckt[1].zw));
      f32x2 yacc = S[j][0] * cr[0].xy;
      yacc = fma2(S[j][1], cr[0].zw, yacc);
      yacc = fma2(S[j][2], cr[1].xy, yacc);
      yacc = fma2(S[j][3], cr[1].zw, yacc);
      float y = yacc.x + yacc.y;
      y += dppf<DPP_XOR1>(y);
      y += dppf<DPP_XOR2>(y);
      y += dppf<DPP_HMIRROR>(y);
      ykeep[j][s >> 3] = (kq == (s & 7)) ? y : ykeep[j][s >> 3];
    }
    if (s < 15) {
#pragma unroll
      for (int q = 0; q < 2; ++q) { cw[q] = nw[q]; ckt[q] = nkt[q]; ca[q] = na[q]; cbv[q] = nbv[q]; cr[q] = nr[q]; }
      cvv = nvv;
    }
  }
#pragma unroll
  for (int hs = 0; hs < 2; ++hs) {
    int t = ch * 16 + hs * 8 + kq;
    if (d) t = T - 1 - t;
#pragma unroll
    for (int j = 0; j < 2; ++j) Yhv[(unsigned)(row0 + t) * 384u + j] = f2bf(ykeep[j][hs]);
  }
}

__device__ __forceinline__ void scan_unit8(const Params& p, int l, int row0, int T, int h, int d, float* fin, unsigned char* smem) {
  const int tid = opq_tid();
  const int v0 = (tid >> 3) * 2, kq = tid & 7, k0 = kq * 8;
  f32x2 S[2][4];
#pragma unroll
  for (int j = 0; j < 2; ++j)
#pragma unroll
    for (int i = 0; i < 4; ++i) S[j][i] = (f32x2){0.f, 0.f};
  float* buf = (float*)smem;
  ScanSrc sc;
  sc.DEC = (const float*)(p.ws + WS_DEC) + (size_t)d * MTOT * 384;
  sc.KT = (const bf16_t*)(p.ws + WS_KT) + (size_t)d * MTOT * 384;
  sc.BB = (const bf16_t*)(p.ws + WS_BB) + (size_t)d * MTOT * 384;
  sc.KK = (const bf16_t*)(p.ws + WS_KK);
  sc.CZ = (const float*)(p.ws + WS_CZ);
  sc.row0 = row0; sc.T = T; sc.d = d; sc.hoff = h * 64; sc.ls = tid >> 4; sc.lc = (tid & 15) * 4;
  bf16_t* Yhv = (bf16_t*)(p.ws + WS_Y) + (size_t)d * MTOT * 384 + h * 64 + v0;
  const int nch = T / 16;
  float* buf0 = buf;
  float* buf1 = buf + 16 * 384;
  __syncthreads();
  SCAN_DECL(A)
  SCAN_GLOAD(A, 0);
  SCAN_LSTORE(A, 0);
  __syncthreads();
  for (int ch = 0; ch < nch; ++ch) {
    if (ch + 1 < nch) SCAN_GLOAD(A, ch + 1);
    scan_chunk8(S, (ch & 1) ? buf1 : buf0, k0, v0, kq, Yhv, row0, T, d, ch);
    if (ch + 1 < nch) SCAN_LSTORE(A, (ch + 1) & 1);
    __syncthreads();
  }
#pragma unroll
  for (int j = 0; j < 2; ++j) {
    float4 t0, t1;
    t0.x = S[j][0].x; t0.y = S[j][0].y; t0.z = S[j][1].x; t0.w = S[j][1].y;
    t1.x = S[j][2].x; t1.y = S[j][2].y; t1.z = S[j][3].x; t1.w = S[j][3].y;
    *(float4*)(fin + (v0 + j) * 64 + k0) = t0;
    *(float4*)(fin + (v0 + j) * 64 + k0 + 4) = t1;
  }
}

template <int R>
__device__ __forceinline__ void scan_unit(const Params& p, int l, int row0, int T, int h, int d, int vbase,
                                          const float* init, float* fin, unsigned char* smem) {
  const int tid = opq_tid();
  const int v0 = vbase + (tid >> 4) * R, kq = tid & 15, k0 = kq * 4;
  f32x2 S[R][2];
#pragma unroll
  for (int j = 0; j < R; ++j) {
    if (init) {
      const float4 t = *(const float4*)(init + (v0 + j) * 64 + k0);
      S[j][0].x = t.x; S[j][0].y = t.y; S[j][1].x = t.z; S[j][1].y = t.w;
    } else {
      S[j][0] = (f32x2){0.f, 0.f}; S[j][1] = (f32x2){0.f, 0.f};
    }
  }
  float* buf = (float*)smem;
  ScanSrc sc;
  sc.DEC = (const float*)(p.ws + WS_DEC) + (size_t)d * MTOT * 384;
  sc.KT = (const bf16_t*)(p.ws + WS_KT) + (size_t)d * MTOT * 384;
  sc.BB = (const bf16_t*)(p.ws + WS_BB) + (size_t)d * MTOT * 384;
  sc.KK = (const bf16_t*)(p.ws + WS_KK);
  sc.CZ = (const float*)(p.ws + WS_CZ);
  sc.row0 = row0; sc.T = T; sc.d = d; sc.hoff = h * 64; sc.ls = tid >> 4; sc.lc = (tid & 15) * 4;
  bf16_t* Yhv = (bf16_t*)(p.ws + WS_Y) + (size_t)d * MTOT * 384 + h * 64 + v0;
  const int nch = T / 16;
  float* buf0 = buf;
  float* buf1 = buf + 16 * 384;
  __syncthreads();
  if constexpr (R == 1) {
    __builtin_amdgcn_s_setprio(3);
    SCAN_DECL(A) SCAN_DECL(B) SCAN_DECL(C) SCAN_DECL(Dd)
    SCAN_GLOAD(A, 0);
    SCAN_LSTORE(A, 0);
    SCAN_GLOAD(A, 1);
    SCAN_GLOAD(B, 2);
    SCAN_GLOAD(C, 3);
    __syncthreads();
    for (int ch = 0; ch < nch; ch += 4) {
      if (ch + 4 < nch) SCAN_GLOAD(Dd, ch + 4);
      scan_chunk<R>(S, buf0, k0, v0, kq, Yhv, row0, T, d, ch);
      SCAN_LSTORE(A, 1);
      __syncthreads();
      if (ch + 5 < nch) SCAN_GLOAD(A, ch + 5);
      scan_chunk<R>(S, buf1, k0, v0, kq, Yhv, row0, T, d, ch + 1);
      SCAN_LSTORE(B, 0);
      __syncthreads();
      if (ch + 6 < nch) SCAN_GLOAD(B, ch + 6);
      scan_chunk<R>(S, buf0, k0, v0, kq, Yhv, row0, T, d, ch + 2);
      SCAN_LSTORE(C, 1);
      __syncthreads();
      if (ch + 7 < nch) SCAN_GLOAD(C, ch + 7);
      scan_chunk<R>(S, buf1, k0, v0, kq, Yhv, row0, T, d, ch + 3);
      if (ch + 4 < nch) SCAN_LSTORE(Dd, 0);
      __syncthreads();
    }
    __builtin_amdgcn_s_setprio(0);
  } else {
    SCAN_DECL(A)
    SCAN_GLOAD(A, 0);
    SCAN_LSTORE(A, 0);
    __syncthreads();
    for (int ch = 0; ch < nch; ++ch) {
      if (ch + 1 < nch) SCAN_GLOAD(A, ch + 1);
      scan_chunk<R>(S, (ch & 1) ? buf1 : buf0, k0, v0, kq, Yhv, row0, T, d, ch);
      if (ch + 1 < nch) SCAN_LSTORE(A, (ch + 1) & 1);
      __syncthreads();
    }
  }
  if (fin) {
#pragma unroll
    for (int j = 0; j < R; ++j) {
      float4 t;
      t.x = S[j][0].x; t.y = S[j][0].y; t.z = S[j][1].x; t.w = S[j][1].y;
      *(float4*)(fin + (v0 + j) * 64 + k0) = t;
    }
  }
}

struct AttnDesc {
  const bf16_t* q;
  const bf16_t* kloc;
  const bf16_t* vloc;
  const bf16_t* kctx;
  const bf16_t* vctx;
  bf16_t* o;
  int qpos0;
  int lo, hi;
  int window;
  float sink; int has_sink;
};

__device__ __forceinline__ void attn_unit(const AttnDesc& a, unsigned char* smem) {
  const int tid = opq_tid(), lane = tid & 63, wid = tid >> 6, fr = lane & 15, fq = lane >> 4;
  unsigned char* sK = smem;
  unsigned char* sV = smem + 8192;
  bf16x8 qf[2];
  {
    const bf16_t* qp = a.q + (size_t)(wid * 16 + fr) * 896 + fq * 8;
    qf[0] = *(const bf16x8*)(qp);
    qf[1] = *(const bf16x8*)(qp + 32);
  }
  f32x4 o[4];
#pragma unroll
  for (int i = 0; i < 4; ++i) o[i] = (f32x4){0.f, 0.f, 0.f, 0.f};
  float mrun = -1e30f, lsum = 0.f;
  const int nctx = a.kctx ? 4 : 0;
  const int ntl = nctx + (a.hi - a.lo + 1);
  const int sw = (fr >> 1) & 7;
  const int qpos = a.qpos0 + wid * 16 + fr;
  const int r0_ = tid >> 3, chn = tid & 7, r1_ = r0_ + 32;
  const int rho0 = (r0_ & 32) | (((r0_ >> 2) & 1) << 4) | (((r0_ >> 3) & 3) << 2) | (r0_ & 3);
  const int rho1 = rho0 + 32;
  uint4 rk0, rk1, rv0, rv1;
#define ATTN_TLOAD(it_)                                                                          \
  {                                                                                              \
    const bool ic_ = (it_) < nctx;                                                               \
    const int kt_ = ic_ ? (it_) : a.lo + ((it_) - nctx);                                         \
    const bf16_t* kb_ = ic_ ? a.kctx + (size_t)kt_ * 64 * 64 : a.kloc + (size_t)kt_ * 64 * 896;  \
    const int kstr_ = ic_ ? 64 : 896;                                                            \
    const bf16_t* vb_ = ic_ ? a.vctx + kt_ * 64 : a.vloc + kt_ * 64;                             \
    const int vstr_ = ic_ ? 256 : MTOT;                                                          \
    rk0 = *(const uint4*)(kb_ + (size_t)r0_ * kstr_ + chn * 8);                                  \
    rk1 = *(const uint4*)(kb_ + (size_t)r1_ * kstr_ + chn * 8);                                  \
    rv0 = *(const uint4*)(vb_ + (size_t)r0_ * vstr_ + chn * 8);                                  \
    rv1 = *(const uint4*)(vb_ + (size_t)r1_ * vstr_ + chn * 8);                                  \
  }
  ATTN_TLOAD(0);
  for (int it = 0; it < ntl; ++it) {
    const bool isctx = it < nctx;
    const int kt = isctx ? it : a.lo + (it - nctx);
    __syncthreads();
    *(uint4*)(sK + rho0 * 128 + ((chn ^ ((rho0 >> 1) & 7)) << 4)) = rk0;
    *(uint4*)(sK + rho1 * 128 + ((chn ^ ((rho1 >> 1) & 7)) << 4)) = rk1;
    *(uint4*)(sV + r0_ * 128 + ((chn ^ ((r0_ >> 1) & 7)) << 4)) = rv0;
    *(uint4*)(sV + r1_ * 128 + ((chn ^ ((r1_ >> 1) & 7)) << 4)) = rv1;
    __syncthreads();
    if (it + 1 < ntl) ATTN_TLOAD(it + 1);
    f32x4 st[4];
#pragma unroll
    for (int kb4 = 0; kb4 < 4; ++kb4) {
      st[kb4] = (f32x4){0.f, 0.f, 0.f, 0.f};
#pragma unroll
      for (int ks = 0; ks < 2; ++ks) {
        const bf16x8 af = *(const bf16x8*)(sK + (kb4 * 16 + fr) * 128 + (((ks * 4 + fq) ^ sw) << 4));
        st[kb4] = mfma16(af, qf[ks], st[kb4]);
      }
    }
    float mt = -1e30f;
#pragma unroll
    for (int kb4 = 0; kb4 < 4; ++kb4)
#pragma unroll
      for (int jj = 0; jj < 4; ++jj) {
        float s = st[kb4][jj] * 0.125f;
        if (a.window && !isctx) {
          const int key = (kb4 >> 1) * 32 + fq * 8 + (kb4 & 1) * 4 + jj;
          const int dlt = kt * 64 + key - qpos;
          if (dlt > 128 || dlt < -128) s = -1e30f;
        }
        st[kb4][jj] = s;
        mt = fmaxf(mt, s);
      }
    mt = fmaxf(mt, __shfl_xor(mt, 16));
    mt = fmaxf(mt, __shfl_xor(mt, 32));
    const float mnew = fmaxf(mrun, mt);
    const float alpha = __expf(mrun - mnew);
    mrun = mnew;
    float ps = 0.f;
#pragma unroll
    for (int kb4 = 0; kb4 < 4; ++kb4)
#pragma unroll
      for (int jj = 0; jj < 4; ++jj) {
        const float pv = __expf(st[kb4][jj] - mnew);
        st[kb4][jj] = pv;
        ps += pv;
      }
    lsum = lsum * alpha + ps;
#pragma unroll
    for (int i = 0; i < 4; ++i) o[i] *= alpha;
    bf16x8 pb[2];
#pragma unroll
    for (int kg = 0; kg < 2; ++kg) {
      union { uint4 u4; bf16x8 v8; } r;
      r.u4.x = pk_bf16(st[2 * kg][0], st[2 * kg][1]);
      r.u4.y = pk_bf16(st[2 * kg][2], st[2 * kg][3]);
      r.u4.z = pk_bf16(st[2 * kg + 1][0], st[2 * kg + 1][1]);
      r.u4.w = pk_bf16(st[2 * kg + 1][2], st[2 * kg + 1][3]);
      pb[kg] = r.v8;
    }
#pragma unroll
    for (int db = 0; db < 4; ++db)
#pragma unroll
      for (int kg = 0; kg < 2; ++kg) {
        const bf16x8 vf = *(const bf16x8*)(sV + (db * 16 + fr) * 128 + (((kg * 4 + fq) ^ sw) << 4));
        o[db] = mfma16(vf, pb[kg], o[db]);
      }
  }
  lsum += __shfl_xor(lsum, 16);
  lsum += __shfl_xor(lsum, 32);
  if (a.has_sink) lsum += __expf(a.sink - mrun);
  const float inv = frcp(lsum);
  bf16_t* op = a.o + (size_t)(wid * 16 + fr) * 1024 + fq * 4;
#pragma unroll
  for (int db = 0; db < 4; ++db) {
    uint2 v;
    v.x = pk_bf16(o[db][0] * inv, o[db][1] * inv);
    v.y = pk_bf16(o[db][2] * inv, o[db][3] * inv);
    *(uint2*)(op + db * 16) = v;
  }
}

constexpr int U_LSCAN = 96, U_CSCAN = 384, U_LATB = 192, U_LATA = 128, U_CTX = 1280;
constexpr int U_TOTAL = U_LSCAN + U_CSCAN + U_LATB + U_LATA + U_CTX;

__device__ __forceinline__ void mix_phase(const Params& p, int slot, int l, unsigned char* smem, int ulo = 0, int uhi = U_TOTAL) {
  unsigned* cnt = (unsigned*)(p.ws + WS_CNT) + slot * 8;
  int* s_u = (int*)(smem + SMEM_CTL);
  const bf16_t* QK = (const bf16_t*)(p.ws + WS_QK);
  const bf16_t* VT = (const bf16_t*)(p.ws + WS_VT);
  bf16_t* MIX = (bf16_t*)(p.ws + WS_H);
  for (;;) {
    __syncthreads();
    if (opq_tid() == 0) *s_u = (int)atomicAdd(cnt, 1u);
    __syncthreads();
    int u = *s_u + ulo;
    if (u >= uhi) break;
    if (u < U_LSCAN) {
      const int chain = u >> 2, part = u & 3;
      const int b = chain / 12, h = (chain % 12) >> 1, d = chain & 1;
      const float* init = p.state_c + ((((size_t)b * 2 + l) * 2 + d) * 6 + h) * 4096;
      scan_unit<1>(p, l, M_CTX + b * 1024, 1024, h, d, part * 16, init, nullptr, smem);
      continue;
    }
    u -= U_LSCAN;
    if (u < U_CSCAN) {
      const int b = u / 12, h = (u % 12) >> 1, d = u & 1;
      float* fin = p.out + OUT_ST + ((((size_t)b * 2 + l) * 2 + d) * 6 + h) * 4096;
      scan_unit8(p, l, b * 256, 256, h, d, fin, smem);
      continue;
    }
    u -= U_CSCAN;
    AttnDesc a;
    if (u < U_LATB) {
      const int b = u / 96, h = (u % 96) >> 4, qb = u & 15, kvh = h / 3;
      const int r0 = M_CTX + b * 1024;
      a.q = QK + (size_t)(r0 + qb * 64) * 896 + 384 + h * 64;
      a.kloc = QK + (size_t)r0 * 896 + 768 + kvh * 64;
      a.vloc = VT + (size_t)((2 + kvh) * 64) * MTOT + r0;
      a.kctx = (const bf16_t*)(p.ws + WS_CKB) + (size_t)((b * 2 + l) * 2 + kvh) * 16384;
      a.vctx = (const bf16_t*)(p.ws + WS_CVTB) + (size_t)((b * 2 + l) * 2 + kvh) * 16384;
      a.o = MIX + (size_t)(r0 + qb * 64) * 1024 + 256 + h * 64;
      a.qpos0 = qb * 64; a.lo = 0; a.hi = 15; a.window = 0; a.sink = 0.f; a.has_sink = 0;
    } else if (u < U_LATB + U_LATA) {
      u -= U_LATB;
      const int b = u >> 6, h = (u & 63) >> 4, qb = u & 15, kvh = h >> 1;
      const int r0 = M_CTX + b * 1024;
      a.q = QK + (size_t)(r0 + qb * 64) * 896 + h * 64;
      a.kloc = QK + (size_t)r0 * 896 + 256 + kvh * 64;
      a.vloc = VT + (size_t)(kvh * 64) * MTOT + r0;
      a.kctx = (const bf16_t*)(p.ws + WS_CKA) + (size_t)((b * 2 + l) * 2 + kvh) * 16384;
      a.vctx = (const bf16_t*)(p.ws + WS_CVTA) + (size_t)((b * 2 + l) * 2 + kvh) * 16384;
      a.o = MIX + (size_t)(r0 + qb * 64) * 1024 + h * 64;
      a.qpos0 = qb * 64; a.lo = qb - 2 < 0 ? 0 : qb - 2; a.hi = qb + 2 > 15 ? 15 : qb + 2; a.window = 1;
      a.sink = p.a_sink[l * 4 + h]; a.has_sink = 1;
    } else {
      u -= U_LATB + U_LATA;
      const int b = u / 40, rem = u % 40, hh = rem >> 2, qb = rem & 3;
      const int r0 = b * 256;
      a.kctx = nullptr; a.vctx = nullptr;
      a.qpos0 = qb * 64; a.lo = 0; a.hi = 3; a.window = 0;
      if (hh < 4) {
        const int h = hh, kvh = h >> 1;
        a.q = QK + (size_t)(r0 + qb * 64) * 896 + h * 64;
        a.kloc = QK + (size_t)r0 * 896 + 256 + kvh * 64;
        a.vloc = VT + (size_t)(kvh * 64) * MTOT + r0;
        a.o = MIX + (size_t)(r0 + qb * 64) * 1024 + h * 64;
        a.sink = p.a_sink[l * 4 + h]; a.has_sink = 1;
      } else {
        const int h = hh - 4, kvh = h / 3;
        a.q = QK + (size_t)(r0 + qb * 64) * 896 + 384 + h * 64;
        a.kloc = QK + (size_t)r0 * 896 + 768 + kvh * 64;
        a.vloc = VT + (size_t)((2 + kvh) * 64) * MTOT + r0;
        a.o = MIX + (size_t)(r0 + qb * 64) * 1024 + 256 + h * 64;
        a.sink = 0.f; a.has_sink = 0;
      }
    }
    attn_unit(a, smem);
  }
}

__device__ __forceinline__ void post_phase(const Params& p, int l) {
  const int tid_ = opq_tid(); const int lane = tid_ & 63, wave = tid_ >> 6;
  const bf16_t* Y = (const bf16_t*)(p.ws + WS_Y);
  const bf16_t* Gb = (const bf16_t*)(p.ws + WS_G);
  const float* BON = (const float*)(p.ws + WS_BON);
  const float* CZ = (const float*)(p.ws + WS_CZ);
  bf16_t* MIX = (bf16_t*)(p.ws + WS_H);
  for (int row = opq_bid() * 4 + wave; row < MTOT; row += gridDim.x * 4) {
#pragma unroll
    for (int h = 0; h < 6; ++h) {
      const int col = h * 64 + lane;
      const float y = bf2f(Y[(size_t)row * 384 + col]) + bf2f(Y[((size_t)MTOT + row) * 384 + col]);
      const float mu = wave_sum(y) * (1.f / 64.f);
      const float dv = y - mu;
      const float var = wave_sum(dv * dv) * (1.f / 64.f);
      const float yn = dv * __builtin_amdgcn_rsqf(var + 64e-5f);
      const float vv = CZ[(size_t)row * 1408 + 768 + col];
      const float o = (yn * p.c_ln_w[l * 384 + col] + p.c_ln_b[l * 384 + col] + BON[(size_t)row * 8 + h] * vv) *
                      bf2f(Gb[(size_t)row * 384 + col]);
      MIX[(size_t)row * 1024 + 640 + col] = f2bf(o);
    }
  }
}


#define XB_TMO      128
#define XB_XCNT(j)  (256  + 64 * (j))
#define XB_XSUB(j)  (1280 + 64 * (j))
#define XB_XGEN(j)  (2304 + 64 * (j))
#define XB_TOP      3328
#define XB_TOPGEN   3392
#define XCD_BAR_WORDS 3456
#define XB_SPIN_CAP (1u << 22)
#define LAS __attribute__((address_space(3)))
__device__ __forceinline__ unsigned xb_ld(unsigned* p)              { return __hip_atomic_load(p, __ATOMIC_RELAXED, __HIP_MEMORY_SCOPE_AGENT); }
__device__ __forceinline__ unsigned xb_add(unsigned* p, unsigned v) { return __hip_atomic_fetch_add(p, v, __ATOMIC_RELAXED, __HIP_MEMORY_SCOPE_AGENT); }
__device__ __forceinline__ unsigned xb_xcc_id() { return (unsigned)__builtin_amdgcn_s_getreg((3 << 11) | 20) & 0xFu; }
#define XB_SPIN(cond, bar) do { unsigned _sp = 0; while (cond) { __builtin_amdgcn_s_sleep(1); \
    if ((++_sp & 255u) == 0u) { if (xb_ld(&(bar)[XB_TMO])) break; if (_sp > XB_SPIN_CAP) { atomicAdd(&(bar)[XB_TMO], 1u); break; } } } } while (0)
struct XcdBarrier { unsigned* bar; unsigned x; volatile LAS unsigned* st; };
__device__ __forceinline__ XcdBarrier xcd_barrier_post(unsigned* bar, volatile LAS unsigned* st) {
  XcdBarrier b; b.bar = bar; b.x = xb_xcc_id(); b.st = st;
  if (threadIdx.x == 0) (void)xb_add(&bar[XB_XCNT(b.x)], 1u);
  return b;
}
__device__ __forceinline__ void xcd_barrier_complete(unsigned* bar, unsigned x, unsigned& nloc, unsigned& nx) {
  const unsigned G = gridDim.x * gridDim.y * gridDim.z;
  unsigned sum, cnt, mine, sp = 0u;
  for (;;) {
    sum = 0u; cnt = 0u; mine = 0u;
#pragma unroll
    for (unsigned j = 0; j < 16; ++j) { const unsigned c = xb_ld(&bar[XB_XCNT(j)]); sum += c; cnt += (c > 0u) ? 1u : 0u; mine = (j == x) ? c : mine; }
    if (sum == G) break;
    __builtin_amdgcn_s_sleep(1);
    if ((++sp & 255u) == 0u) { if (xb_ld(&bar[XB_TMO])) break; if (sp > XB_SPIN_CAP) { atomicAdd(&bar[XB_TMO], 1u); break; } }
  }
  nloc = mine > 0u ? mine : 1u; nx = cnt > 0u ? cnt : 1u;
}
__device__ __forceinline__ void xcd_barrier(const XcdBarrier& b) {
  asm volatile("s_waitcnt vmcnt(0)" ::: "memory");
  __syncthreads();
  if (threadIdx.x == 0) {
    unsigned* bar = b.bar;
    __builtin_amdgcn_s_waitcnt(0);
    unsigned nloc = b.st[0], nx = b.st[1];
    if (nloc == 0u) { xcd_barrier_complete(bar, b.x, nloc, nx); b.st[0] = nloc; b.st[1] = nx; }
    const unsigned old = xb_add(&bar[XB_XSUB(b.x)], 1u);
    const unsigned gen = old / nloc;
    if (old + 1u == (gen + 1u) * nloc) {
      __builtin_amdgcn_fence(__ATOMIC_RELEASE, "agent");
      asm volatile("s_waitcnt vmcnt(0)" ::: "memory");
      const unsigned og = xb_add(&bar[XB_TOP], 1u);
      const unsigned tg = og / nx;
      if (og + 1u == (tg + 1u) * nx) xb_add(&bar[XB_TOPGEN], 1u);
      else XB_SPIN(xb_ld(&bar[XB_TOPGEN]) == tg, bar);
      __builtin_amdgcn_fence(__ATOMIC_ACQUIRE, "agent");
      xb_add(&bar[XB_XGEN(b.x)], 1u);
      asm volatile("s_waitcnt vmcnt(0)" ::: "memory");
    } else {
      XB_SPIN(xb_ld(&bar[XB_XGEN(b.x)]) == gen, bar);
      __builtin_amdgcn_fence(__ATOMIC_ACQUIRE, "agent");
      asm volatile("s_waitcnt vmcnt(0)" ::: "memory");
    }
  }
  __syncthreads();
}

__device__ __forceinline__ void run_phase(const Params& p, int ph, unsigned char* smem) {
  if (ph == 0) { phase0(p, smem); return; }
  if (ph == NPHASE - 1) { rpass(p, 2, 1); return; }
  const int l = (ph - 1) / 9, s = (ph - 1) % 9;
  const bf16_t* H = (const bf16_t*)(p.ws + WS_H);
  switch (s) {
    case 0: if (l == 0) rpass(p, 0, 0); else rpass(p, 2, 0); break;
    case 1: gemm_phase<0>(p, l, H, D, (const bf16_t*)(p.ws + WS_WT_IN) + (size_t)l * IN_COLS * D, D, IN_COLS, D, smem); break;
    case 2: prep_phase(p, l, smem); break;
    case 3: mix_phase(p, l * 2, l, smem); break;
    case 4: post_phase(p, l); break;
    case 5: gemm_phase<1>(p, l, H, D, (const bf16_t*)(p.ws + WS_WT_OUT) + (size_t)l * D * D, D, D, D, smem); break;
    case 6: rpass(p, 1, l); break;
    case 7: gemm_phase<2>(p, l, H, D, (const bf16_t*)(p.ws + WS_WT_GU) + (size_t)l * GU * D, D, GU, D, smem); break;
    case 8: gemm_phase<1>(p, l, (const bf16_t*)(p.ws + WS_CZ), FF, (const bf16_t*)(p.ws + WS_WT_DN) + (size_t)l * D * FF, FF, D, FF, smem); break;
  }
}

#if N_LAUNCH_MODE == 0
__global__ void __launch_bounds__(256, 2) fwd_phases(Params p) {
  extern __shared__ __attribute__((aligned(16))) unsigned char smem[];
  run_phase(p, p.ph_lo, smem);
}
#define FWD_KERNEL fwd_phases
#else
template <int L>
__device__ __forceinline__ void layer_phases(const Params& p, unsigned char* smem, const XcdBarrier& xb) {
  const bf16_t* H = (const bf16_t*)(p.ws + WS_H);
  if (L == 0) {
#pragma unroll
    for (int rep = 0; rep < REP_R0; ++rep) rpass(p, 0, 0);
  } else rpass(p, 2, 0);
  xcd_barrier(xb);
#pragma unroll
  for (int rep = 0; rep < REP_GEMM; ++rep) {
    gemm_phase<0>(p, L, H, D, (const bf16_t*)(p.ws + WS_WT_IN) + (size_t)L * IN_COLS * D, D, IN_COLS, D, smem);
    xcd_barrier(xb);
  }
#pragma unroll
  for (int rep = 0; rep < REP_OTHER * REP_PREP; ++rep) {
    prep_phase(p, L, smem);
    xcd_barrier(xb);
  }
#if MIX_SPLIT
#pragma unroll
  for (int rep = 0; rep < REP_MA; ++rep) { mix_phase(p, L * 4 + 0 + 0 * rep, L, smem, 0, U_LSCAN); xcd_barrier(xb); if (rep + 1 < REP_MA) { if (threadIdx.x == 0 && blockIdx.x == 0) ((unsigned*)(p.ws + WS_CNT))[(L * 4 + 0) * 8] = 0u; xcd_barrier(xb); } }
#pragma unroll
  for (int rep = 0; rep < REP_MB; ++rep) { mix_phase(p, L * 4 + 1, L, smem, U_LSCAN, U_LSCAN + U_CSCAN); xcd_barrier(xb); if (rep + 1 < REP_MB) { if (threadIdx.x == 0 && blockIdx.x == 0) ((unsigned*)(p.ws + WS_CNT))[(L * 4 + 1) * 8] = 0u; xcd_barrier(xb); } }
#pragma unroll
  for (int rep = 0; rep < REP_MC; ++rep) { mix_phase(p, L * 4 + 2, L, smem, U_LSCAN + U_CSCAN, U_TOTAL); xcd_barrier(xb); if (rep + 1 < REP_MC) { if (threadIdx.x == 0 && blockIdx.x == 0) ((unsigned*)(p.ws + WS_CNT))[(L * 4 + 2) * 8] = 0u; xcd_barrier(xb); } }
#else
#pragma unroll
  for (int rep = 0; rep < REP_MIX; ++rep) {
    mix_phase(p, L * 2 + rep, L, smem);
    xcd_barrier(xb);
  }
#endif
#pragma unroll
  for (int rep = 0; rep < REP_OTHER; ++rep) {
    post_phase(p, L);
    xcd_barrier(xb);
  }
#pragma unroll
  for (int rep = 0; rep < REP_GEMM; ++rep) {
    gemm160_phase(p, H, D, (const bf16_t*)(p.ws + WS_WT_OUT) + (size_t)L * D * D, D, D, smem);
    xcd_barrier(xb);
  }
  rpass(p, 1, L);
  xcd_barrier(xb);
#pragma unroll
  for (int rep = 0; rep < REP_GEMM; ++rep) {
    gemm_phase<2>(p, L, H, D, (const bf16_t*)(p.ws + WS_WT_GU) + (size_t)L * GU * D, D, GU, D, smem);
    xcd_barrier(xb);
  }
#pragma unroll
  for (int rep = 0; rep < REP_GEMM; ++rep) {
    gemm160_phase(p, (const bf16_t*)(p.ws + WS_CZ), FF, (const bf16_t*)(p.ws + WS_WT_DN) + (size_t)L * D * FF, FF, FF, smem);
    xcd_barrier(xb);
  }
}
__global__ void __launch_bounds__(256, 2) fwd_mega(Params p) {
  extern __shared__ __attribute__((aligned(16))) unsigned char smem[];
  if (threadIdx.x == 0) { *(unsigned*)(smem + SMEM_CTL + 8) = 0u; *(unsigned*)(smem + SMEM_CTL + 12) = 0u; }
  __syncthreads();
  XcdBarrier xb = xcd_barrier_post((unsigned*)(p.ws + WS_BAR), (volatile LAS unsigned*)(smem + SMEM_CTL + 8));
#pragma unroll
  for (int rep = 0; rep < REP_P0; ++rep) phase0(p, smem);
#pragma unroll
  for (int rep = 0; rep < REP_BAR; ++rep) xcd_barrier(xb);
#if USE_CG_SYNC
  cg::this_grid().sync();
#else
  if (p.ph_hi < 0) cg::this_grid().sync();
  xcd_barrier(xb);
#endif
  layer_phases<0>(p, smem, xb);
  layer_phases<1>(p, smem, xb);
  rpass(p, 2, 1);
}
#define FWD_KERNEL fwd_mega
#endif

extern "C" void kernel_launch(void* const* d_in, const int* in_sizes, int n_in, void* d_out, int out_size, void* d_ws,
                              size_t ws_size, hipStream_t stream) {
  static int grid_blocks = 0;
  if (!grid_blocks) {
    int dev = 0, cus = 0, per_cu = 0;
    (void)hipGetDevice(&dev);
    (void)hipDeviceGetAttribute(&cus, hipDeviceAttributeMultiprocessorCount, dev);
    (void)hipFuncSetAttribute((const void*)FWD_KERNEL, hipFuncAttributeMaxDynamicSharedMemorySize, SMEM_BYTES);
    (void)hipOccupancyMaxActiveBlocksPerMultiprocessor(&per_cu, (const void*)FWD_KERNEL, 256, SMEM_BYTES);
    if (per_cu > 2) per_cu = 2;
    if (per_cu < 1) per_cu = 1;
    grid_blocks = cus * per_cu;
    if (n_in != 32 || ws_size < WS_END) {
      fprintf(stderr, "kernel_launch: unexpected n_in %d or ws_size %zu (< %zu)\n", n_in, ws_size, (size_t)WS_END);
      grid_blocks = -1;
    }
  }
  if (grid_blocks < 0) return;
  Params p{};
  const float** pp = (const float**)&p;
  for (int i = 0; i < 32; ++i) pp[i] = (const float*)d_in[i];
  p.out = (float*)d_out;
  p.ws = (unsigned char*)d_ws;
#if N_LAUNCH_MODE
  p.ph_lo = 0; p.ph_hi = NPHASE;
  (void)hipMemsetAsync((unsigned char*)d_ws + WS_BAR, 0, 16384, stream);
  void* args[] = {&p};
  hipError_t e = hipLaunchCooperativeKernel((const void*)fwd_mega, dim3(grid_blocks), dim3(256), args, SMEM_BYTES, stream);
  if (e != hipSuccess) fprintf(stderr, "cooperative launch failed: %s (grid %d)\n", hipGetErrorString(e), grid_blocks);
#else
  for (int ph = 0; ph < NPHASE; ++ph) {
    p.ph_lo = ph; p.ph_hi = ph + 1;
    hipLaunchKernelGGL(fwd_phases, dim3(grid_blocks), dim3(256), SMEM_BYTES, stream, p);
  }
#endif
}
```

```cpp
#include <hip/hip_runtime.h>
#include <hip/hip_bf16.h>
#include <hip/hip_cooperative_groups.h>
#include <cstdio>
#include <cstdint>
namespace cg = cooperative_groups;

typedef unsigned short bf16_t;
using bf16x8 = __attribute__((ext_vector_type(8))) short;
using f32x4 = __attribute__((ext_vector_type(4))) float;

#ifndef REP_GEMM
#define REP_GEMM 1
#endif
#ifndef REP_MIX
#define REP_MIX 1
#endif
#ifndef REP_P0
#define REP_P0 1
#endif
#ifndef REP_R0
#define REP_R0 1
#endif
#ifndef REP_BAR
#define REP_BAR 0
#endif
#ifndef REP_PREP
#define REP_PREP 1
#endif
#ifndef MIX_SPLIT
#define MIX_SPLIT 0
#endif
#ifndef REP_MA
#define REP_MA 1
#endif
#ifndef REP_MB
#define REP_MB 1
#endif
#ifndef REP_MC
#define REP_MC 1
#endif
#ifndef REP_OTHER
#define REP_OTHER 1
#endif
#ifndef USE_CG_SYNC
#define USE_CG_SYNC 0
#endif
#ifndef N_LAUNCH_MODE
#define N_LAUNCH_MODE 1
#endif

constexpr int D = 1024, M_CTX = 8192, M_LAT = 2048, MTOT = 10240;
constexpr int IN_COLS = 2560, FF = 2816, GU = 5632;
constexpr int NPHASE = 20;
constexpr int SMEM_CTL = 73728;
constexpr int SMEM_BYTES = SMEM_CTL + 64;

constexpr size_t al256(size_t x) { return (x + 255) & ~(size_t)255; }
constexpr size_t WS_WT_IN = 0;
constexpr size_t WS_WT_OUT = WS_WT_IN + (size_t)2 * IN_COLS * D * 2;
constexpr size_t WS_WT_GU = WS_WT_OUT + (size_t)2 * D * D * 2;
constexpr size_t WS_WT_DN = WS_WT_GU + (size_t)2 * GU * D * 2;
constexpr size_t WS_WUPT = WS_WT_DN + (size_t)2 * D * FF * 2;
constexpr size_t WS_AUPT = WS_WUPT + (size_t)4 * 384 * 64 * 2;
constexpr size_t WS_GUPT = WS_AUPT + (size_t)4 * 384 * 64 * 2;
constexpr size_t WS_MOD = WS_GUPT + (size_t)2 * 384 * 128 * 2;
constexpr size_t WS_ROPE = WS_MOD + (size_t)2 * 3 * 6144 * 4;
constexpr size_t WS_CKA = WS_ROPE + (size_t)1024 * 32 * 2 * 4;
constexpr size_t WS_CVTA = WS_CKA + (size_t)131072 * 2;
constexpr size_t WS_CKB = WS_CVTA + (size_t)131072 * 2;
constexpr size_t WS_CVTB = WS_CKB + (size_t)131072 * 2;
constexpr size_t WS_CNT = WS_CVTB + (size_t)131072 * 2;
constexpr size_t WS_BAR = WS_CNT + 256;
constexpr size_t WS_H = WS_BAR + 16384;
constexpr size_t WS_QK = WS_H + (size_t)MTOT * D * 2;
constexpr size_t WS_VT = WS_QK + (size_t)MTOT * 896 * 2;
constexpr size_t WS_CZ = WS_VT + (size_t)4 * 64 * MTOT * 2;
constexpr size_t WS_DEC = WS_CZ + (size_t)MTOT * 1408 * 4;
constexpr size_t WS_KT = WS_DEC + (size_t)2 * MTOT * 384 * 4;
constexpr size_t WS_BB = WS_KT + (size_t)2 * MTOT * 384 * 2;
constexpr size_t WS_KK = WS_BB + (size_t)2 * MTOT * 384 * 2;
constexpr size_t WS_G = WS_KK + (size_t)MTOT * 384 * 2;
constexpr size_t WS_BON = WS_G + (size_t)MTOT * 384 * 2;
constexpr size_t WS_Y = WS_BON + (size_t)MTOT * 8 * 4;
constexpr size_t WS_PA = WS_Y + (size_t)2 * MTOT * 384 * 2;
constexpr size_t WS_END = WS_PA + (size_t)MTOT * 256 * 2;
static_assert((size_t)MTOT * D * 4 <= (WS_BB - WS_DEC), "O alias");
static_assert(WS_END <= (size_t)256 * 1024 * 1024, "workspace too big");

constexpr size_t OUT_X = 0;
constexpr size_t OUT_AK = (size_t)MTOT * D;
constexpr size_t OUT_AV = OUT_AK + 2097152;
constexpr size_t OUT_BK = OUT_AV + 2097152;
constexpr size_t OUT_BV = OUT_BK + 2097152;
constexpr size_t OUT_ST = OUT_BV + 2097152;

struct Params {
  const float *x_prompt, *x_sample, *cache_a_k, *cache_a_v, *cache_b_k, *cache_b_v, *state_c, *c, *c_ctx,
      *w_mod, *b_mod, *norm_mix_pre, *norm_mix_post, *norm_ffn_pre, *norm_ffn_post, *w_in, *w_out, *a_sink,
      *b_q_norm, *b_k_norm, *c_w0, *c_w_up, *c_a0, *c_a_up, *c_g_up, *c_k_k, *c_k_a, *c_r_k, *c_ln_w, *c_ln_b,
      *w_gu, *w_down;
  float* out;
  unsigned char* ws;
  int ph_lo, ph_hi;
};

typedef __bf16 bf16x2_t __attribute__((ext_vector_type(2)));
typedef float f32x2_t __attribute__((ext_vector_type(2)));
__device__ __forceinline__ unsigned pk_bf16(float lo, float hi) {
  f32x2_t f = {lo, hi};
  bf16x2_t b = __builtin_convertvector(f, bf16x2_t);
  return __builtin_bit_cast(unsigned, b);
}
__device__ __forceinline__ bf16_t f2bf(float f) { return (bf16_t)(pk_bf16(f, 0.f) & 0xffffu); }
__device__ __forceinline__ float bf2f(bf16_t b) { return __uint_as_float(((unsigned)b) << 16); }
__device__ __forceinline__ float bflo(unsigned u) { return __uint_as_float(u << 16); }
__device__ __forceinline__ float bfhi(unsigned u) { return __uint_as_float(u & 0xffff0000u); }
__device__ __forceinline__ int opq_tid() { int x = threadIdx.x; asm volatile("" : "+v"(x)); return x; }
__device__ __forceinline__ int opq_bid() { int x = blockIdx.x; asm volatile("" : "+s"(x)); return x; }
__device__ __forceinline__ float4 cvt4(uint2 u) { return make_float4(bflo(u.x), bfhi(u.x), bflo(u.y), bfhi(u.y)); }
__device__ __forceinline__ float frcp(float x) { return __builtin_amdgcn_rcpf(x); }
__device__ __forceinline__ float sigmoidf_(float x) { return frcp(1.f + __expf(-x)); }
__device__ __forceinline__ float wave_sum(float v) {
#pragma unroll
  for (int o = 1; o < 64; o <<= 1) v += __shfl_xor(v, o);
  return v;
}
template <int CTRL>
__device__ __forceinline__ float dppf(float x) {
  return __builtin_bit_cast(float, __builtin_amdgcn_mov_dpp(__builtin_bit_cast(int, x), CTRL, 0xf, 0xf, true));
}
constexpr int DPP_XOR1 = 0xB1, DPP_XOR2 = 0x4E, DPP_ROR4 = 0x124, DPP_ROR8 = 0x128;
__device__ __forceinline__ float row16_sum(float v) {
  v += dppf<DPP_XOR1>(v);
  v += dppf<DPP_XOR2>(v);
  v += dppf<DPP_ROR4>(v);
  v += dppf<DPP_ROR8>(v);
  return v;
}
__device__ __forceinline__ f32x4 mfma16(bf16x8 a, bf16x8 b, f32x4 c) {
  return __builtin_amdgcn_mfma_f32_16x16x32_bf16(a, b, c, 0, 0, 0);
}

__device__ __forceinline__ void transpose_tile(const float* __restrict__ src, int K, int N, bf16_t* __restrict__ dst,
                                               int tile, bool perm, float* lds) {
  const int nkt = K / 64, nnt = N / 64, per = nkt * nnt;
  const int lyr = tile / per, r = tile % per, kt = r / nnt, nt = r % nnt;
  src += (size_t)lyr * K * N;
  dst += (size_t)lyr * K * N;
  const int tid = opq_tid();
#pragma unroll
  for (int i = 0; i < 16; ++i) {
    const int row = (tid >> 6) + 4 * i;
    lds[row * 65 + (tid & 63)] = src[(size_t)(kt * 64 + row) * N + nt * 64 + (tid & 63)];
  }
  __syncthreads();
#pragma unroll
  for (int it = 0; it < 2; ++it) {
    const int idx = tid + it * 256, n = idx >> 3, kc = idx & 7;
    uint4 v;
    v.x = pk_bf16(lds[(kc * 8 + 0) * 65 + n], lds[(kc * 8 + 1) * 65 + n]);
    v.y = pk_bf16(lds[(kc * 8 + 2) * 65 + n], lds[(kc * 8 + 3) * 65 + n]);
    v.z = pk_bf16(lds[(kc * 8 + 4) * 65 + n], lds[(kc * 8 + 5) * 65 + n]);
    v.w = pk_bf16(lds[(kc * 8 + 6) * 65 + n], lds[(kc * 8 + 7) * 65 + n]);
    const int col = nt * 64 + n;
    int prow = col;
    if (perm) {
      if (col < FF) prow = (col >> 5) * 64 + (col & 31);
      else { const int c2 = col - FF; prow = (c2 >> 5) * 64 + 32 + (c2 & 31); }
    }
    *(uint4*)(dst + (size_t)prow * K + kt * 64 + kc * 8) = v;
  }
  __syncthreads();
}

__device__ __forceinline__ void gemv_item(const Params& p, int item, float* lds) {
  const int l = item / 192, n0 = (item % 192) * 32;
  const int tid = opq_tid();
  float* s_c = lds;
  float* red = lds + 3072;
  for (int i = tid; i < 3072; i += 256) {
    const int ci = i >> 10, k = i & 1023;
    const float x = (ci == 0) ? p.c_ctx[k] : p.c[(ci - 1) * 1024 + k];
    s_c[i] = x * sigmoidf_(x);
  }
  __syncthreads();
  const int kg = tid >> 5, col = tid & 31;
  const float* w = p.w_mod + (size_t)l * 1024 * 6144 + (size_t)(kg * 128) * 6144 + n0 + col;
  float a0 = 0.f, a1 = 0.f, a2 = 0.f;
#pragma unroll 32
  for (int k = 0; k < 128; ++k) {
    const float wv = __builtin_nontemporal_load(w + (size_t)k * 6144);
    a0 += s_c[kg * 128 + k] * wv;
    a1 += s_c[1024 + kg * 128 + k] * wv;
    a2 += s_c[2048 + kg * 128 + k] * wv;
  }
  red[(kg * 3 + 0) * 32 + col] = a0;
  red[(kg * 3 + 1) * 32 + col] = a1;
  red[(kg * 3 + 2) * 32 + col] = a2;
  __syncthreads();
  if (tid < 96) {
    const int ci = tid >> 5, cc = tid & 31;
    float sum = p.b_mod[l * 6144 + n0 + cc];
#pragma unroll
    for (int g = 0; g < 8; ++g) sum += red[(g * 3 + ci) * 32 + cc];
    ((float*)(p.ws + WS_MOD))[(l * 3 + ci) * 6144 + n0 + cc] = sum;
  }
  __syncthreads();
}

constexpr int WL_IN = 16 * 40, WL_OUT = 16 * 16, WL_GU = 16 * 88, WL_DN = 44 * 16, WL_UP = 2 * 6, WL_G = 2 * 6;
constexpr int WL_TOTAL = WL_IN + WL_OUT + WL_GU + WL_DN + 2 * WL_UP + WL_G;
__device__ __forceinline__ void weight_item(const Params& p, int layer, int r, float* lds) {
  if (r < WL_IN) { transpose_tile(p.w_in, 1024, IN_COLS, (bf16_t*)(p.ws + WS_WT_IN), layer * WL_IN + r, false, lds); return; }
  r -= WL_IN;
  if (r < WL_OUT) { transpose_tile(p.w_out, 1024, 1024, (bf16_t*)(p.ws + WS_WT_OUT), layer * WL_OUT + r, false, lds); return; }
  r -= WL_OUT;
  if (r < WL_GU) { transpose_tile(p.w_gu, 1024, GU, (bf16_t*)(p.ws + WS_WT_GU), layer * WL_GU + r, true, lds); return; }
  r -= WL_GU;
  if (r < WL_DN) { transpose_tile(p.w_down, FF, 1024, (bf16_t*)(p.ws + WS_WT_DN), layer * WL_DN + r, false, lds); return; }
  r -= WL_DN;
  if (r < WL_UP) { transpose_tile(p.c_w_up, 64, 384, (bf16_t*)(p.ws + WS_WUPT), layer * WL_UP + r, false, lds); return; }
  r -= WL_UP;
  if (r < WL_UP) { transpose_tile(p.c_a_up, 64, 384, (bf16_t*)(p.ws + WS_AUPT), layer * WL_UP + r, false, lds); return; }
  r -= WL_UP;
  transpose_tile(p.c_g_up, 128, 384, (bf16_t*)(p.ws + WS_GUPT), layer * WL_G + r, false, lds);
}

constexpr int P0_GEMV = 384;
constexpr int P0_ROPE = 128, P0_CACHE = 256;
constexpr int P0_TOTAL = P0_GEMV + WL_TOTAL + P0_ROPE + P0_CACHE;

__device__ __forceinline__ void phase0(const Params& p, unsigned char* smem) {
  float* lds = (float*)smem;
  const int tid = opq_tid();
  const int bid = opq_bid();
  if (bid == 0 && tid < 64) ((unsigned*)(p.ws + WS_CNT))[tid] = 0u;
  for (int it = bid; it < P0_TOTAL; it += gridDim.x) {
    int r = it;
    if (r < P0_GEMV) { gemv_item(p, r, lds); continue; }
    r -= P0_GEMV;
    if (r < WL_TOTAL) { weight_item(p, 0, r, lds); continue; }
    r -= WL_TOTAL;
    if (r < P0_ROPE) {
      const int idx = r * 256 + tid, t = idx >> 5, i = idx & 31, fi = i & 15;
      const float pos = (i < 16) ? (float)(t >> 6) : (float)(t & 63);
      const float freq = exp2f(-(float)fi * (13.287712379549449f / 16.f));
      float rev = pos * freq * 0.15915494309189535f;
      rev -= floorf(rev);
      float2 cs;
      cs.x = __builtin_amdgcn_cosf(rev);
      cs.y = __builtin_amdgcn_sinf(rev);
      ((float2*)(p.ws + WS_ROPE))[idx] = cs;
      continue;
    }
    r -= P0_ROPE;
    {
#pragma unroll
      for (int j = 0; j < 8; ++j) {
        const int idx = r * 2048 + j * 256 + tid;
        const int tensor = idx >> 17, e = idx & 131071;
        const float* src = tensor == 0 ? p.cache_a_k : tensor == 1 ? p.cache_a_v : tensor == 2 ? p.cache_b_k : p.cache_b_v;
        bf16_t* dst = (bf16_t*)(p.ws + (tensor == 0 ? WS_CKA : tensor == 1 ? WS_CVTA : tensor == 2 ? WS_CKB : WS_CVTB));
        int b, l, h, t, d;
        if ((tensor & 1) == 0) { d = e & 63; t = (e >> 6) & 255; h = (e >> 14) & 1; l = (e >> 15) & 1; b = e >> 16; }
        else { t = e & 255; d = (e >> 8) & 63; h = (e >> 14) & 1; l = (e >> 15) & 1; b = e >> 16; }
        dst[e] = f2bf(src[((((size_t)b * 2 + l) * 256 + t) * 2 + h) * 64 + d]);
      }
    }
  }
}

__device__ __forceinline__ void rpass(const Params& p, int mode, int l) {
  const int tid_ = opq_tid(); const int lane = tid_ & 63, wave = tid_ >> 6;
  const float* MOD = (const float*)(p.ws + WS_MOD);
  const bf16_t* O = (const bf16_t*)(p.ws + WS_DEC);
  float* X = p.out + OUT_X;
  bf16_t* H = (bf16_t*)(p.ws + WS_H);
  const int nwaves = gridDim.x * 4, rpw = (MTOT + nwaves - 1) / nwaves;
  const int gw_ = opq_bid() * 4 + wave;
  const int rbeg = gw_ * rpw, rend = (rbeg + rpw < MTOT) ? rbeg + rpw : MTOT;
  const bool has_next = !(mode == 2 && l == 1);
  const int nl = (mode == 2) ? l + 1 : l;
  float4 vgw[4], vgs[4], vsh[4];
  int ci_cur = -1;
  for (int row = rbeg; row < rend; ++row) {
    const int ci = row < M_CTX ? 0 : 1 + ((row - M_CTX) >> 10);
    if (ci != ci_cur) {
      ci_cur = ci;
      if (mode != 0) {
        const float* gate = MOD + (l * 3 + ci) * 6144 + (mode == 1 ? 2 : 5) * 1024;
        const float* gp = (mode == 1 ? p.norm_mix_post : p.norm_ffn_post) + l * D;
#pragma unroll
        for (int j = 0; j < 4; ++j) {
          const float4 g = *(const float4*)(gate + j * 256 + lane * 4);
          const float4 w = *(const float4*)(gp + j * 256 + lane * 4);
          vgw[j] = make_float4(g.x * w.x, g.y * w.y, g.z * w.z, g.w * w.w);
        }
      }
      if (has_next) {
        const float* gpre = (mode == 1 ? p.norm_ffn_pre : p.norm_mix_pre) + nl * D;
        const float* sc = MOD + (nl * 3 + ci) * 6144 + (mode == 1 ? 4 : 1) * 1024;
        const float* sh = MOD + (nl * 3 + ci) * 6144 + (mode == 1 ? 3 : 0) * 1024;
#pragma unroll
        for (int j = 0; j < 4; ++j) {
          const float4 g = *(const float4*)(gpre + j * 256 + lane * 4);
          const float4 s = *(const float4*)(sc + j * 256 + lane * 4);
          vgs[j] = make_float4(g.x * (1.f + s.x), g.y * (1.f + s.y), g.z * (1.f + s.z), g.w * (1.f + s.w));
          vsh[j] = *(const float4*)(sh + j * 256 + lane * 4);
        }
      }
    }
    const float* xs;
    if (mode == 0 || (mode == 1 && l == 0)) xs = row < M_CTX ? p.x_prompt + (size_t)row * D : p.x_sample + (size_t)(row - M_CTX) * D;
    else xs = X + (size_t)row * D;
    float4 x[4];
#pragma unroll
    for (int j = 0; j < 4; ++j) x[j] = *(const float4*)(xs + j * 256 + lane * 4);
    if (mode != 0) {
      float4 o[4];
      float ss = 0.f;
#pragma unroll
      for (int j = 0; j < 4; ++j) {
        o[j] = cvt4(*(const uint2*)(O + (size_t)row * D + j * 256 + lane * 4));
        ss += o[j].x * o[j].x + o[j].y * o[j].y + o[j].z * o[j].z + o[j].w * o[j].w;
      }
      ss = wave_sum(ss);
      const float rs = __builtin_amdgcn_rsqf(ss * (1.f / D) + 1e-6f);
#pragma unroll
      for (int j = 0; j < 4; ++j) {
        x[j].x += vgw[j].x * (o[j].x * rs);
        x[j].y += vgw[j].y * (o[j].y * rs);
        x[j].z += vgw[j].z * (o[j].z * rs);
        x[j].w += vgw[j].w * (o[j].w * rs);
        *(float4*)(X + (size_t)row * D + j * 256 + lane * 4) = x[j];
      }
    }
    if (!has_next) continue;
    float ss2 = 0.f;
#pragma unroll
    for (int j = 0; j < 4; ++j) ss2 += x[j].x * x[j].x + x[j].y * x[j].y + x[j].z * x[j].z + x[j].w * x[j].w;
    ss2 = wave_sum(ss2);
    const float rs2 = __builtin_amdgcn_rsqf(ss2 * (1.f / D) + 1e-6f);
#pragma unroll
    for (int j = 0; j < 4; ++j) {
      const float h0 = x[j].x * rs2 * vgs[j].x + vsh[j].x;
      const float h1 = x[j].y * rs2 * vgs[j].y + vsh[j].y;
      const float h2 = x[j].z * rs2 * vgs[j].z + vsh[j].z;
      const float h3 = x[j].w * rs2 * vgs[j].w + vsh[j].w;
      uint2 v;
      v.x = pk_bf16(h0, h1);
      v.y = pk_bf16(h2, h3);
      *(uint2*)(H + (size_t)row * D + j * 256 + lane * 4) = v;
    }
  }
}

template <int FN>
__device__ __forceinline__ float xform(float t) {
  if (FN == 1) { const float e = __expf(2.f * t); return 1.f - 2.f * frcp(e + 1.f); }
  if (FN == 2) return sigmoidf_(t);
  return t;
}
__device__ __forceinline__ void epi_f32(const Params& p, f32x4 (&acc)[4][4], int rb, int cb, int lane) {
  const int fr = lane & 15, fq = lane >> 4;
  float* O = (float*)(p.ws + WS_DEC);
#pragma unroll
  for (int m = 0; m < 4; ++m)
#pragma unroll
    for (int n = 0; n < 4; ++n)
#pragma unroll
      for (int j = 0; j < 4; ++j) O[(size_t)(rb + m * 16 + fq * 4 + j) * D + cb + n * 16 + fr] = acc[m][n][j];
}

__device__ __forceinline__ void epi_gu(const Params& p, f32x4 (&acc)[4][4], int rb, int cb, int lane) {
  const int fr = lane & 15, fq = lane >> 4;
  bf16_t* ACT = (bf16_t*)(p.ws + WS_CZ);
  const int chunk = cb >> 6;
#pragma unroll
  for (int m = 0; m < 4; ++m)
#pragma unroll
    for (int n = 0; n < 2; ++n)
#pragma unroll
      for (int j = 0; j < 4; ++j) {
        const float g = acc[m][n][j], u = acc[m][n + 2][j];
        const float a = g * sigmoidf_(g) * u;
        ACT[(size_t)(rb + m * 16 + fq * 4 + j) * FF + chunk * 32 + n * 16 + fr] = f2bf(a);
      }
}

template <int MB>
__device__ __forceinline__ void epi_in(const Params& p, int l, f32x4 (&acc)[MB][4], int rb, int cb, int lane) {
  const int fr = lane & 15, fq = lane >> 4;
  const int cidx = cb >> 6;
  const bool lat = rb >= M_CTX;
  if (cidx >= 36) {
    bf16_t* PA = (bf16_t*)(p.ws + WS_PA);
    const int pc = cb - 2304;
#pragma unroll
    for (int m = 0; m < MB; ++m)
#pragma unroll
      for (int n = 0; n < 4; ++n)
#pragma unroll
        for (int j = 0; j < 4; ++j) {
          float t = acc[m][n][j];
          if (cidx == 36) t = xform<1>(t); else if (cidx >= 38) t = xform<2>(t);
          PA[(size_t)(rb + m * 16 + fq * 4 + j) * 256 + pc + n * 16 + fr] = f2bf(t);
        }
    return;
  }
  if (cidx >= 18) {
    float* CZ = (float*)(p.ws + WS_CZ);
    const int cc = cb - 1152;
#pragma unroll
    for (int m = 0; m < MB; ++m)
#pragma unroll
      for (int n = 0; n < 4; ++n)
#pragma unroll
        for (int j = 0; j < 4; ++j) CZ[(size_t)(rb + m * 16 + fq * 4 + j) * 1408 + cc + n * 16 + fr] = acc[m][n][j];
    return;
  }
  if (cidx >= 8 && cidx < 16) {
    const float* gw = (cidx < 14 ? p.b_q_norm : p.b_k_norm) + l * 64;
    float g[4];
#pragma unroll
    for (int n = 0; n < 4; ++n) g[n] = gw[n * 16 + fr];
#pragma unroll
    for (int m = 0; m < MB; ++m)
#pragma unroll
      for (int j = 0; j < 4; ++j) {
        float ss = 0.f;
#pragma unroll
        for (int n = 0; n < 4; ++n) ss += acc[m][n][j] * acc[m][n][j];
        ss = row16_sum(ss);
        const float rs = __builtin_amdgcn_rsqf(ss * (1.f / 64.f) + 1e-6f);
#pragma unroll
        for (int n = 0; n < 4; ++n) acc[m][n][j] *= rs * g[n];
      }
  }
  const bool isv = (cidx == 6 || cidx == 7 || cidx == 16 || cidx == 17);
  if (lat && !isv) {
    const float2* ROPE = (const float2*)(p.ws + WS_ROPE);
#pragma unroll
    for (int m = 0; m < MB; ++m)
#pragma unroll
      for (int j = 0; j < 4; ++j) {
        const int t = (rb + m * 16 + fq * 4 + j - M_CTX) & 1023;
        const float2 a0 = ROPE[t * 32 + fr], a1 = ROPE[t * 32 + 16 + fr];
        float x1 = acc[m][0][j], x2 = acc[m][2][j];
        acc[m][0][j] = x1 * a0.x - x2 * a0.y;
        acc[m][2][j] = x1 * a0.y + x2 * a0.x;
        x1 = acc[m][1][j]; x2 = acc[m][3][j];
        acc[m][1][j] = x1 * a1.x - x2 * a1.y;
        acc[m][3][j] = x1 * a1.y + x2 * a1.x;
      }
  }
  if (!isv) {
    bf16_t* QK = (bf16_t*)(p.ws + WS_QK);
    const int qc = (cidx < 6) ? cb : cb - 128;
#pragma unroll
    for (int m = 0; m < MB; ++m)
#pragma unroll
      for (int n = 0; n < 4; ++n)
#pragma unroll
        for (int j = 0; j < 4; ++j) QK[(size_t)(rb + m * 16 + fq * 4 + j) * 896 + qc + n * 16 + fr] = f2bf(acc[m][n][j]);
    if (!lat && (cidx == 4 || cidx == 5 || cidx == 14 || cidx == 15)) {
      float* dst = p.out + (cidx < 6 ? OUT_AK : OUT_BK);
      const int h = cidx & 1;
#pragma unroll
      for (int m = 0; m < MB; ++m)
#pragma unroll
        for (int n = 0; n < 4; ++n)
#pragma unroll
          for (int j = 0; j < 4; ++j) {
            const int row = rb + m * 16 + fq * 4 + j, b = row >> 8, t = row & 255;
            dst[((((size_t)b * 2 + l) * 256 + t) * 2 + h) * 64 + n * 16 + fr] = acc[m][n][j];
          }
    }
  } else {
    bf16_t* VT = (bf16_t*)(p.ws + WS_VT);
    const int vh = (cidx < 8) ? cidx - 6 : 2 + cidx - 16;
#pragma unroll
    for (int m = 0; m < MB; ++m)
#pragma unroll
      for (int n = 0; n < 4; ++n) {
        uint2 v;
        v.x = pk_bf16(acc[m][n][0], acc[m][n][1]);
        v.y = pk_bf16(acc[m][n][2], acc[m][n][3]);
        *(uint2*)(VT + ((size_t)(vh * 64 + n * 16 + fr)) * MTOT + rb + m * 16 + fq * 4) = v;
      }
    if (!lat) {
      float* dst = p.out + (cidx < 8 ? OUT_AV : OUT_BV);
      const int h = cidx & 1;
#pragma unroll
      for (int m = 0; m < MB; ++m)
#pragma unroll
        for (int n = 0; n < 4; ++n)
#pragma unroll
          for (int j = 0; j < 4; ++j) {
            const int row = rb + m * 16 + fq * 4 + j, b = row >> 8, t = row & 255;
            dst[((((size_t)b * 2 + l) * 256 + t) * 2 + h) * 64 + n * 16 + fr] = acc[m][n][j];
          }
    }
  }
}

__device__ __forceinline__ void gemm64_tile(const Params& p, int l, const bf16_t* __restrict__ A, int lda,
                                            const bf16_t* __restrict__ Bt, int ldb, int K, int brow, int bcol, unsigned char* smem) {
  const int tid = opq_tid(), lane = tid & 63, wid = tid >> 6, fr = lane & 15, fq = lane >> 4;
  const int sw = (fr >> 1) & 7;
  const int nk = K / 64;
  const int lrow = lane >> 3;
  f32x4 acc[1][4];
#pragma unroll
  for (int n = 0; n < 4; ++n) acc[0][n] = (f32x4){0.f, 0.f, 0.f, 0.f};
  const bf16_t* ga = A + (size_t)(brow + wid * 16 + lrow) * lda;
  const bf16_t* gb = Bt + (size_t)(bcol + wid * 16 + lrow) * ldb;
#define GEMM64_STAGE(bufi, kt_)                                                                                   \
  {                                                                                                               \
    unsigned char* sb_ = smem + (bufi) * 16384 + wid * 2048 + lane * 16;                                          \
    _Pragma("unroll") for (int i_ = 0; i_ < 2; ++i_) {                                                            \
      const int c_ = (lane & 7) ^ (((wid * 16 + i_ * 8 + lrow) >> 1) & 7);                                        \
      __builtin_amdgcn_global_load_lds((const unsigned*)(ga + (size_t)(i_ * 8) * lda + (kt_) * 64 + c_ * 8),      \
                                       (unsigned*)(sb_ + i_ * 1024), 16, 0, 0);                                   \
      __builtin_amdgcn_global_load_lds((const unsigned*)(gb + (size_t)(i_ * 8) * ldb + (kt_) * 64 + c_ * 8),      \
                                       (unsigned*)(sb_ + 8192 + i_ * 1024), 16, 0, 0);                            \
    }                                                                                                             \
  }
  __syncthreads();
  GEMM64_STAGE(0, 0);
  for (int kt = 0; kt < nk; ++kt) {
    asm volatile("s_waitcnt vmcnt(0)" ::: "memory");
    __syncthreads();
    if (kt + 1 < nk) GEMM64_STAGE((kt + 1) & 1, kt + 1);
    const unsigned char* sA = smem + (kt & 1) * 16384;
    const unsigned char* sB = sA + 8192;
#pragma unroll
    for (int s = 0; s < 2; ++s) {
      const int co = ((s * 4 + fq) ^ sw) << 4;
      const bf16x8 a = *(const bf16x8*)(sA + (wid * 16 + fr) * 128 + co);
#pragma unroll
      for (int n = 0; n < 4; ++n) {
        const bf16x8 b = *(const bf16x8*)(sB + (n * 16 + fr) * 128 + co);
        acc[0][n] = mfma16(a, b, acc[0][n]);
      }
    }
  }
  epi_in<1>(p, l, acc, brow + wid * 16, bcol, lane);
}

template <int EPI>
__device__ __forceinline__ void gemm_phase(const Params& p, int l, const bf16_t* __restrict__ A, int lda,
                                           const bf16_t* __restrict__ Bt, int ldb, int N, int K, unsigned char* smem) {
  const int tid = opq_tid(), lane = tid & 63, wid = tid >> 6, wr = wid >> 1, wc = wid & 1, fr = lane & 15, fq = lane >> 4;
  const int bid = opq_bid();
  const int nN = N / 128, ntiles = (MTOT / 128) * nN;
  const int G = gridDim.x, per = G >> 3;
  const int srow = wid * 32 + (lane >> 3);
  const int sw = (fr >> 1) & 7;
  const int nk = K / 64;
  for (int base = 0; base < ntiles; base += G) {
    const int tile = base + (bid & 7) * per + (bid >> 3);
    if (EPI == 0 && base + G > ntiles && (ntiles - base) * 4 <= G) {
      const int sub = tile - base, nsub = (ntiles - base) * 4;
      if (sub < nsub) {
        const int t128 = base + (sub >> 2), q = sub & 3;
        const int patch = t128 >> 5, within = t128 & 31, nPN = nN >> 2;
        const int mt = (patch / nPN) * 8 + (within >> 2), nt = (patch % nPN) * 4 + (within & 3);
        gemm64_tile(p, l, A, lda, Bt, ldb, K, mt * 128 + (q >> 1) * 64, nt * 128 + (q & 1) * 64, smem);
      }
      if (l == 0) {
        const int nidle = G - nsub;
        if (nidle == 0) { for (int it = sub; it < WL_TOTAL; it += G) weight_item(p, 1, it, (float*)smem); }
        else if (sub >= nsub) { for (int it = sub - nsub; it < WL_TOTAL; it += nidle) weight_item(p, 1, it, (float*)smem); }
      }
      continue;
    }
    if (tile >= ntiles) {
      if (EPI == 0 && l == 0) {
        const int nidle = base + G - ntiles;
        for (int it = tile - ntiles; it < WL_TOTAL; it += nidle) weight_item(p, 1, it, (float*)smem);
      }
      continue;
    }
    const int patch = tile >> 5, within = tile & 31, nPN = nN >> 2;
    const int mt = (patch / nPN) * 8 + (within >> 2), nt = (patch % nPN) * 4 + (within & 3);
    const int brow = mt * 128, bcol = nt * 128;
    f32x4 acc[4][4];
#pragma unroll
    for (int m = 0; m < 4; ++m)
#pragma unroll
      for (int n = 0; n < 4; ++n) acc[m][n] = (f32x4){0.f, 0.f, 0.f, 0.f};
    const bf16_t* ga = A + (size_t)(brow + srow) * lda;
    const bf16_t* gb = Bt + (size_t)(bcol + srow) * ldb;
#define GEMM_STAGE(bufi, kt_)                                                                                     \
  {                                                                                                               \
    unsigned char* sa_ = smem + (bufi) * 32768 + wid * 4096 + lane * 16;                                          \
    _Pragma("unroll") for (int i_ = 0; i_ < 4; ++i_) {                                                            \
      const int c_ = (lane & 7) ^ (((srow + i_ * 8) >> 1) & 7);                                                   \
      __builtin_amdgcn_global_load_lds((const unsigned*)(ga + (size_t)(i_ * 8) * lda + (kt_) * 64 + c_ * 8),      \
                                       (unsigned*)(sa_ + i_ * 1024), 16, 0, 0);                                   \
      __builtin_amdgcn_global_load_lds((const unsigned*)(gb + (size_t)(i_ * 8) * ldb + (kt_) * 64 + c_ * 8),      \
                                       (unsigned*)(sa_ + 16384 + i_ * 1024), 16, 0, 0);                           \
    }                                                                                                             \
  }
    __syncthreads();
    GEMM_STAGE(0, 0);
    for (int kt = 0; kt < nk; ++kt) {
      asm volatile("s_waitcnt vmcnt(0)" ::: "memory");
      __syncthreads();
      if (kt + 1 < nk) GEMM_STAGE((kt + 1) & 1, kt + 1);
      const unsigned char* sA = smem + (kt & 1) * 32768;
      const unsigned char* sB = sA + 16384;
#pragma unroll
      for (int s = 0; s < 2; ++s) {
        bf16x8 a[4], b[4];
        const int co = ((s * 4 + fq) ^ sw) << 4;
#pragma unroll
        for (int m = 0; m < 4; ++m) a[m] = *(const bf16x8*)(sA + (wr * 64 + m * 16 + fr) * 128 + co);
#pragma unroll
        for (int n = 0; n < 4; ++n) b[n] = *(const bf16x8*)(sB + (wc * 64 + n * 16 + fr) * 128 + co);
        __builtin_amdgcn_s_setprio(1);
#pragma unroll
        for (int m = 0; m < 4; ++m)
#pragma unroll
          for (int n = 0; n < 4; ++n) acc[m][n] = mfma16(a[m], b[n], acc[m][n]);
        __builtin_amdgcn_s_setprio(0);
      }
    }
    const int rb = brow + wr * 64, cb = bcol + wc * 64;
    if constexpr (EPI == 0) epi_in<4>(p, l, acc, rb, cb, lane);
    else if constexpr (EPI == 1) epi_f32(p, acc, rb, cb, lane);
    else epi_gu(p, acc, rb, cb, lane);
  }
}

constexpr int G160_BUF = 36864;
__device__ __forceinline__ void gemm160_phase(const Params& p, const bf16_t* __restrict__ A, int lda,
                                              const bf16_t* __restrict__ Bt, int ldb, int K, unsigned char* smem) {
  const int tid = opq_tid(), lane = tid & 63, wid = tid >> 6, wr = wid >> 1, wc = wid & 1, fr = lane & 15, fq = lane >> 4;
  const int bid = opq_bid();
  constexpr int nN = 8, ntiles = 64 * nN;
  const int G = gridDim.x, per = G >> 3;
  const int sw = (fr >> 1) & 7;
  const int nk = K / 64;
  const int lrow = lane >> 3;
  bf16_t* O = (bf16_t*)(p.ws + WS_DEC);
  for (int base = 0; base < ntiles; base += G) {
    const int tile = base + (bid & 7) * per + (bid >> 3);
    if (tile >= ntiles) continue;
    const int mt = tile / nN, nt = tile % nN;
    const int brow = mt * 160, bcol = nt * 128;
    f32x4 acc[5][4];
#pragma unroll
    for (int m = 0; m < 5; ++m)
#pragma unroll
      for (int n = 0; n < 4; ++n) acc[m][n] = (f32x4){0.f, 0.f, 0.f, 0.f};
    const bf16_t* ga = A + (size_t)(brow + lrow) * lda;
    const bf16_t* gb = Bt + (size_t)(bcol + wid * 32 + lrow) * ldb;
#define GEMM160_STAGE(bufi, kt_)                                                                                  \
  {                                                                                                               \
    unsigned char* sb_ = smem + (bufi) * G160_BUF;                                                                \
    _Pragma("unroll") for (int i_ = 0; i_ < 5; ++i_) {                                                            \
      const int pc_ = wid + i_ * 4;                                                                               \
      const int c_ = (lane & 7) ^ (((pc_ * 8 + lrow) >> 1) & 7);                                                  \
      __builtin_amdgcn_global_load_lds((const unsigned*)(ga + (size_t)(pc_ * 8) * lda + (kt_) * 64 + c_ * 8),     \
                                       (unsigned*)(sb_ + pc_ * 1024 + lane * 16), 16, 0, 0);                      \
    }                                                                                                             \
    _Pragma("unroll") for (int i_ = 0; i_ < 4; ++i_) {                                                            \
      const int c_ = (lane & 7) ^ (((wid * 32 + i_ * 8 + lrow) >> 1) & 7);                                        \
      __builtin_amdgcn_global_load_lds((const unsigned*)(gb + (size_t)(i_ * 8) * ldb + (kt_) * 64 + c_ * 8),      \
                                       (unsigned*)(sb_ + 20480 + wid * 4096 + i_ * 1024 + lane * 16), 16, 0, 0);  \
    }                                                                                                             \
  }
    __syncthreads();
    GEMM160_STAGE(0, 0);
    for (int kt = 0; kt < nk; ++kt) {
      asm volatile("s_waitcnt vmcnt(0)" ::: "memory");
      __syncthreads();
      if (kt + 1 < nk) GEMM160_STAGE((kt + 1) & 1, kt + 1);
      const unsigned char* sA = smem + (kt & 1) * G160_BUF;
      const unsigned char* sB = sA + 20480;
#pragma unroll
      for (int s = 0; s < 2; ++s) {
        bf16x8 a[5], b[4];
        const int co = ((s * 4 + fq) ^ sw) << 4;
#pragma unroll
        for (int m = 0; m < 5; ++m) a[m] = *(const bf16x8*)(sA + (wr * 80 + m * 16 + fr) * 128 + co);
#pragma unroll
        for (int n = 0; n < 4; ++n) b[n] = *(const bf16x8*)(sB + (wc * 64 + n * 16 + fr) * 128 + co);
        __builtin_amdgcn_s_setprio(1);
#pragma unroll
        for (int m = 0; m < 5; ++m)
#pragma unroll
          for (int n = 0; n < 4; ++n) acc[m][n] = mfma16(a[m], b[n], acc[m][n]);
        __builtin_amdgcn_s_setprio(0);
      }
    }
#pragma unroll
    for (int m = 0; m < 5; ++m)
#pragma unroll
      for (int n = 0; n < 4; ++n)
#pragma unroll
        for (int j = 0; j < 4; ++j)
          O[(size_t)(brow + wr * 80 + m * 16 + fq * 4 + j) * D + bcol + wc * 64 + n * 16 + fr] = f2bf(acc[m][n][j]);
  }
}

template <int FN>
__device__ __forceinline__ bf16x8 ld_frag_f32(const float* src) {
  const float4 u = *(const float4*)src, v = *(const float4*)(src + 4);
  union { uint4 u4; bf16x8 v8; } r;
  r.u4.x = pk_bf16(xform<FN>(u.x), xform<FN>(u.y));
  r.u4.y = pk_bf16(xform<FN>(u.z), xform<FN>(u.w));
  r.u4.z = pk_bf16(xform<FN>(v.x), xform<FN>(v.y));
  r.u4.w = pk_bf16(xform<FN>(v.z), xform<FN>(v.w));
  return r.v8;
}

__device__ __forceinline__ void prep_phase(const Params& p, int l, unsigned char* smem) {
  const int tid = opq_tid(), lane = tid & 63, wid = tid >> 6, fr = lane & 15, fq = lane >> 4;
  const float* CZ = (const float*)(p.ws + WS_CZ);
  float* DEC = (float*)(p.ws + WS_DEC);
  bf16_t* KT = (bf16_t*)(p.ws + WS_KT);
  bf16_t* BB = (bf16_t*)(p.ws + WS_BB);
  bf16_t* KK = (bf16_t*)(p.ws + WS_KK);
  bf16_t* Gb = (bf16_t*)(p.ws + WS_G);
  float* BON = (float*)(p.ws + WS_BON);
  const bf16_t* WUPT = (const bf16_t*)(p.ws + WS_WUPT);
  const bf16_t* AUPT = (const bf16_t*)(p.ws + WS_AUPT);
  const bf16_t* GUPT = (const bf16_t*)(p.ws + WS_GUPT);
  const bf16_t* PA = (const bf16_t*)(p.ws + WS_PA);
  const int swz = (fr >> 1) & 7;
  for (int u = opq_bid(); u < 80 * 6; u += gridDim.x) {
    const int tile = u / 6, h = u % 6;
    __syncthreads();
    {
      uint4 tw_[4], tg_[4];
#pragma unroll
      for (int i = 0; i < 4; ++i) {
        const bf16_t* src = (i < 2 ? WUPT : AUPT) + ((unsigned)(l * 2 + (i & 1)) * 384 + h * 64) * 64;
        const int pc0 = tid, pc1 = tid + 256;
        const uint4 v0 = *(const uint4*)(src + (pc0 >> 3) * 64 + (pc0 & 7) * 8);
        const uint4 v1 = *(const uint4*)(src + (pc1 >> 3) * 64 + (pc1 & 7) * 8);
        tw_[i] = v0; tg_[i] = v1;
      }
#pragma unroll
      for (int i = 0; i < 4; ++i) {
        const int pc0 = tid, pc1 = tid + 256;
        *(uint4*)(smem + i * 8192 + (pc0 >> 3) * 128 + (((pc0 & 7) ^ (((pc0 >> 3) >> 1) & 7)) << 4)) = tw_[i];
        *(uint4*)(smem + i * 8192 + (pc1 >> 3) * 128 + (((pc1 & 7) ^ (((pc1 >> 3) >> 1) & 7)) << 4)) = tg_[i];
      }
#pragma unroll
      for (int i = 0; i < 4; ++i) {
        const int pc = tid + i * 256, col = pc >> 4, chn = pc & 15;
        const uint4 v = *(const uint4*)(GUPT + ((unsigned)l * 384 + h * 64 + col) * 128 + chn * 8);
        *(uint4*)(smem + 32768 + col * 256 + ((chn ^ (col & 15)) << 4)) = v;
      }
    }
    __syncthreads();
#pragma unroll
    for (int mb = 0; mb < 2; ++mb) {
      const int rb = tile * 128 + wid * 32 + mb * 16;
      const int arow = rb + fr;
      bf16x8 ftw[2], fxa[2];
#pragma unroll
      for (int ks = 0; ks < 2; ++ks) {
        ftw[ks] = *(const bf16x8*)(PA + (unsigned)arow * 256 + ks * 32 + fq * 8);
        fxa[ks] = *(const bf16x8*)(PA + (unsigned)arow * 256 + 64 + ks * 32 + fq * 8);
      }
      float kv[4][4], rv[4][4], kkn[4][4], bon[4];
      float kkw[4], kaw[4], rkw[4];
#pragma unroll
      for (int n = 0; n < 4; ++n) {
        kkw[n] = p.c_k_k[l * 384 + h * 64 + n * 16 + fr];
        kaw[n] = p.c_k_a[l * 384 + h * 64 + n * 16 + fr];
        rkw[n] = p.c_r_k[l * 384 + h * 64 + n * 16 + fr];
      }
#pragma unroll
      for (int j = 0; j < 4; ++j) {
        const int row = rb + fq * 4 + j;
        float ss = 0.f;
#pragma unroll
        for (int n = 0; n < 4; ++n) {
          kv[n][j] = CZ[(unsigned)row * 1408 + 384 + h * 64 + n * 16 + fr];
          rv[n][j] = CZ[(unsigned)row * 1408 + h * 64 + n * 16 + fr];
          kkn[n][j] = kv[n][j] * kkw[n];
          ss += kkn[n][j] * kkn[n][j];
        }
        ss = row16_sum(ss);
        const float rs = __builtin_amdgcn_rsqf(ss + 1e-12f);
#pragma unroll
        for (int n = 0; n < 4; ++n) {
          kkn[n][j] *= rs;
          KK[(unsigned)row * 384 + h * 64 + n * 16 + fr] = f2bf(kkn[n][j]);
        }
        bon[j] = 0.f;
      }
#pragma unroll
      for (int d = 0; d < 2; ++d) {
        f32x4 aw[4], aa[4];
#pragma unroll
        for (int n = 0; n < 4; ++n) {
          aw[n] = (f32x4){0.f, 0.f, 0.f, 0.f};
          aa[n] = (f32x4){0.f, 0.f, 0.f, 0.f};
          const int col = h * 64 + n * 16 + fr;
#pragma unroll
          for (int ks = 0; ks < 2; ++ks) {
            const bf16x8 bw = *(const bf16x8*)(smem + d * 8192 + (n * 16 + fr) * 128 + (((ks * 4 + fq) ^ swz) << 4));
            const bf16x8 ba = *(const bf16x8*)(smem + 16384 + d * 8192 + (n * 16 + fr) * 128 + (((ks * 4 + fq) ^ swz) << 4));
            aw[n] = mfma16(ftw[ks], bw, aw[n]);
            aa[n] = mfma16(fxa[ks], ba, aa[n]);
          }
        }
#pragma unroll
        for (int n = 0; n < 4; ++n) {
          const int col = h * 64 + n * 16 + fr;
          const float w0 = p.c_w0[(l * 2 + d) * 384 + col], a0 = p.c_a0[(l * 2 + d) * 384 + col];
#pragma unroll
          for (int j = 0; j < 4; ++j) {
            const int row = rb + fq * 4 + j;
            const float dec = __expf(-0.6065306597126334f * sigmoidf_(aw[n][j] + w0));
            const float a = sigmoidf_(aa[n][j] + a0);
            const float kt = kv[n][j] * (1.f + (a - 1.f) * kaw[n]);
            DEC[((unsigned)d * MTOT + row) * 384 + col] = dec;
            KT[((unsigned)d * MTOT + row) * 384 + col] = f2bf(kt);
            BB[((unsigned)d * MTOT + row) * 384 + col] = f2bf(kkn[n][j] * a);
            bon[j] += rv[n][j] * kt * rkw[n];
          }
        }
      }
#pragma unroll
      for (int j = 0; j < 4; ++j) {
        const float b = row16_sum(bon[j]);
        if (fr == 0) BON[(unsigned)(rb + fq * 4 + j) * 8 + h] = b;
      }
      f32x4 ag[4];
#pragma unroll
      for (int n = 0; n < 4; ++n) ag[n] = (f32x4){0.f, 0.f, 0.f, 0.f};
#pragma unroll
      for (int ks = 0; ks < 4; ++ks) {
        const bf16x8 fa = *(const bf16x8*)(PA + (unsigned)arow * 256 + 128 + ks * 32 + fq * 8);
#pragma unroll
        for (int n = 0; n < 4; ++n) {
          const int col = h * 64 + n * 16 + fr;
          const bf16x8 bg = *(const bf16x8*)(smem + 32768 + (n * 16 + fr) * 256 + (((ks * 4 + fq) ^ fr) << 4));
          ag[n] = mfma16(fa, bg, ag[n]);
        }
      }
#pragma unroll
      for (int n = 0; n < 4; ++n)
#pragma unroll
        for (int j = 0; j < 4; ++j) Gb[(unsigned)(rb + fq * 4 + j) * 384 + h * 64 + n * 16 + fr] = f2bf(ag[n][j]);
    }
  }
}


typedef float f32x2 __attribute__((ext_vector_type(2)));
__device__ __forceinline__ f32x2 fma2(f32x2 a, f32x2 b, f32x2 c) { return __builtin_elementwise_fma(a, b, c); }

struct ScanSrc { const float* DEC; const bf16_t* KT; const bf16_t* BB; const bf16_t* KK; const float* CZ; int row0, T, d, hoff, ls, lc; };
#define SCAN_DECL(P) float4 P##w, P##r, P##v; uint2 P##kt, P##kk, P##b;
#define SCAN_GLOAD(P, chunk)                                                         \
  {                                                                                  \
    int t_ = (chunk) * 16 + sc.ls;                                                   \
    if (sc.d) t_ = sc.T - 1 - t_;                                                    \
    const unsigned row_ = (unsigned)(sc.row0 + t_);                                  \
    P##w = *(const float4*)(sc.DEC + row_ * 384u + sc.hoff + sc.lc);                 \
    P##kt = *(const uint2*)(sc.KT + row_ * 384u + sc.hoff + sc.lc);                  \
    P##kk = *(const uint2*)(sc.KK + row_ * 384u + sc.hoff + sc.lc);                  \
    P##b = *(const uint2*)(sc.BB + row_ * 384u + sc.hoff + sc.lc);                   \
    P##r = *(const float4*)(sc.CZ + row_ * 1408u + sc.hoff + sc.lc);                 \
    P##v = *(const float4*)(sc.CZ + row_ * 1408u + 768 + sc.hoff + sc.lc);           \
  }
#define SCAN_LSTORE(P, b_)                                                           \
  {                                                                                  \
    float* dst_ = buf + (((b_) * 16 + sc.ls) * 6) * 64 + sc.lc;                      \
    const float4 kk_ = cvt4(P##kk);                                                  \
    *(float4*)(dst_) = P##w;                                                         \
    *(float4*)(dst_ + 64) = cvt4(P##kt);                                             \
    *(float4*)(dst_ + 128) = make_float4(-kk_.x, -kk_.y, -kk_.z, -kk_.w);           \
    *(float4*)(dst_ + 192) = cvt4(P##b);                                             \
    *(float4*)(dst_ + 256) = P##r;                                                   \
    *(float4*)(dst_ + 320) = P##v;                                                   \
  }

template <int R>
__device__ __forceinline__ void scan_chunk(f32x2 (&S)[R][2], const float* cbuf, int k0, int v0, int kq,
                                           bf16_t* Yhv, int row0, int T, int d, int ch) {
  const float* sb = cbuf + k0;
  const float* vb = cbuf + 320 + v0;
  float ykeep[R];
#pragma unroll
  for (int j = 0; j < R; ++j) ykeep[j] = 0.f;
  f32x4 cw, ckt, ca, cbv, cr;
  float cvv[R];
  cw = *(const f32x4*)(sb);
  ckt = *(const f32x4*)(sb + 64);
  ca = *(const f32x4*)(sb + 128);
  cbv = *(const f32x4*)(sb + 192);
  cr = *(const f32x4*)(sb + 256);
  if constexpr (R == 4) { const f32x4 t = *(const f32x4*)vb; cvv[0] = t.x; cvv[1] = t.y; cvv[2] = t.z; cvv[3] = t.w; }
  else {
#pragma unroll
    for (int j = 0; j < R; ++j) cvv[j] = vb[j];
  }
#pragma unroll
  for (int s = 0; s < 16; ++s) {
    f32x4 nw, nkt, na, nbv, nr;
    float nvv[R];
    if (s < 15) {
      nw = *(const f32x4*)(sb + (s + 1) * 384);
      nkt = *(const f32x4*)(sb + (s + 1) * 384 + 64);
      na = *(const f32x4*)(sb + (s + 1) * 384 + 128);
      nbv = *(const f32x4*)(sb + (s + 1) * 384 + 192);
      nr = *(const f32x4*)(sb + (s + 1) * 384 + 256);
      if constexpr (R == 4) { const f32x4 t = *(const f32x4*)(vb + (s + 1) * 384); nvv[0] = t.x; nvv[1] = t.y; nvv[2] = t.z; nvv[3] = t.w; }
      else {
#pragma unroll
        for (int j = 0; j < R; ++j) nvv[j] = vb[(s + 1) * 384 + j];
      }
    }
#pragma unroll
    for (int j = 0; j < R; ++j) {
      f32x2 acc = S[j][0] * ca.xy;
      acc = fma2(S[j][1], ca.zw, acc);
      float sa = acc.x + acc.y;
      sa += dppf<DPP_XOR1>(sa);
      sa += dppf<DPP_XOR2>(sa);
      sa += dppf<DPP_ROR4>(sa);
      sa += dppf<DPP_ROR8>(sa);
      const f32x2 sa2 = {sa, sa}, vv2 = {cvv[j], cvv[j]};
      S[j][0] = fma2(S[j][0], cw.xy, fma2(sa2, cbv.xy, vv2 * ckt.xy));
      S[j][1] = fma2(S[j][1], cw.zw, fma2(sa2, cbv.zw, vv2 * ckt.zw));
      f32x2 yacc = S[j][0] * cr.xy;
      yacc = fma2(S[j][1], cr.zw, yacc);
      float y = yacc.x + yacc.y;
      y += dppf<DPP_XOR1>(y);
      y += dppf<DPP_XOR2>(y);
      y += dppf<DPP_ROR4>(y);
      y += dppf<DPP_ROR8>(y);
      ykeep[j] = (kq == s) ? y : ykeep[j];
    }
    if (s < 15) {
      cw = nw; ckt = nkt; ca = na; cbv = nbv; cr = nr;
#pragma unroll
      for (int j = 0; j < R; ++j) cvv[j] = nvv[j];
    }
  }
  int t = ch * 16 + kq;
  if (d) t = T - 1 - t;
#pragma unroll
  for (int j = 0; j < R; ++j) Yhv[(unsigned)(row0 + t) * 384u + j] = f2bf(ykeep[j]);
}

constexpr int DPP_HMIRROR = 0x141;
__device__ __forceinline__ void scan_chunk8(f32x2 (&S)[2][4], const float* cbuf, int k0, int v0, int kq,
                                            bf16_t* Yhv, int row0, int T, int d, int ch) {
  const float* sb = cbuf + k0;
  const float* vb = cbuf + 320 + v0;
  float ykeep[2][2];
#pragma unroll
  for (int j = 0; j < 2; ++j) { ykeep[j][0] = 0.f; ykeep[j][1] = 0.f; }
  f32x4 cw[2], ckt[2], ca[2], cbv[2], cr[2];
  f32x2 cvv;
#pragma unroll
  for (int q = 0; q < 2; ++q) {
    cw[q] = *(const f32x4*)(sb + q * 4);
    ckt[q] = *(const f32x4*)(sb + 64 + q * 4);
    ca[q] = *(const f32x4*)(sb + 128 + q * 4);
    cbv[q] = *(const f32x4*)(sb + 192 + q * 4);
    cr[q] = *(const f32x4*)(sb + 256 + q * 4);
  }
  cvv = *(const f32x2*)vb;
#pragma unroll
  for (int s = 0; s < 16; ++s) {
    f32x4 nw[2], nkt[2], na[2], nbv[2], nr[2];
    f32x2 nvv = {0.f, 0.f};
    if (s < 15) {
#pragma unroll
      for (int q = 0; q < 2; ++q) {
        nw[q] = *(const f32x4*)(sb + (s + 1) * 384 + q * 4);
        nkt[q] = *(const f32x4*)(sb + (s + 1) * 384 + 64 + q * 4);
        na[q] = *(const f32x4*)(sb + (s + 1) * 384 + 128 + q * 4);
        nbv[q] = *(const f32x4*)(sb + (s + 1) * 384 + 192 + q * 4);
        nr[q] = *(const f32x4*)(sb + (s + 1) * 384 + 256 + q * 4);
      }
      nvv = *(const f32x2*)(vb + (s + 1) * 384);
    }
#pragma unroll
    for (int j = 0; j < 2; ++j) {
      f32x2 acc = S[j][0] * ca[0].xy;
      acc = fma2(S[j][1], ca[0].zw, acc);
      acc = fma2(S[j][2], ca[1].xy, acc);
      acc = fma2(S[j][3], ca[1].zw, acc);
      float sa = acc.x + acc.y;
      sa += dppf<DPP_XOR1>(sa);
      sa += dppf<DPP_XOR2>(sa);
      sa += dppf<DPP_HMIRROR>(sa);
      const float vj = j ? cvv.y : cvv.x;
      const f32x2 sa2 = {sa, sa}, vv2 = {vj, vj};
      S[j][0] = fma2(S[j][0], cw[0].xy, fma2(sa2, cbv[0].xy, vv2 * ckt[0].xy));
      S[j][1] = fma2(S[j][1], cw[0].zw, fma2(sa2, cbv[0].zw, vv2 * ckt[0].zw));
      S[j][2] = fma2(S[j][2], cw[1].xy, fma2(sa2, cbv[1].xy, vv2 * ckt[1].xy));
      S[j][3] = fma2(S[j][3], cw[1].zw, fma2(sa2, cbv[1].zw, vv2 * ckt[1].zw));
      f32x2 yacc = S[j][0] * cr[0].xy;
      yacc = fma2(S[j][1], cr[0].zw, yacc);
      yacc = fma2(S[j][2], cr[1].xy, yacc);
      yacc = fma2(S[j][3], cr[1].zw, yacc);
      float y = yacc.x + yacc.y;
      y += dppf<DPP_XOR1>(y);
      y += dppf<DPP_XOR2>(y);
      y += dppf<DPP_HMIRROR>(y);
      ykeep[j][s >> 3] = (kq == (s & 7)) ? y : ykeep[j][s >> 3];
    }
    if (s < 15) {
#pragma unroll
      for (int q = 0; q < 2; ++q) { cw[q] = nw[q]; ckt[q] = nkt[q]; ca[q] = na[q]; cbv[q] = nbv[q]; cr[q] = nr[q]; }
      cvv = nvv;
    }
  }
#pragma unroll
  for (int hs = 0; hs < 2; ++hs) {
    int t = ch * 16 + hs * 8 + kq;
    if (d) t = T - 1 - t;
#pragma unroll
    for (int j = 0; j < 2; ++j) Yhv[(unsigned)(row0 + t) * 384u + j] = f2bf(ykeep[j][hs]);
  }
}

__device__ __forceinline__ void scan_unit8(const Params& p, int l, int row0, int T, int h, int d, float* fin, unsigned char* smem) {
  const int tid = opq_tid();
  const int v0 = (tid >> 3) * 2, kq = tid & 7, k0 = kq * 8;
  f32x2 S[2][4];
#pragma unroll
  for (int j = 0; j < 2; ++j)
#pragma unroll
    for (int i = 0; i < 4; ++i) S[j][i] = (f32x2){0.f, 0.f};
  float* buf = (float*)smem;
  ScanSrc sc;
  sc.DEC = (const float*)(p.ws + WS_DEC) + (size_t)d * MTOT * 384;
  sc.KT = (const bf16_t*)(p.ws + WS_KT) + (size_t)d * MTOT * 384;
  sc.BB = (const bf16_t*)(p.ws + WS_BB) + (size_t)d * MTOT * 384;
  sc.KK = (const bf16_t*)(p.ws + WS_KK);
  sc.CZ = (const float*)(p.ws + WS_CZ);
  sc.row0 = row0; sc.T = T; sc.d = d; sc.hoff = h * 64; sc.ls = tid >> 4; sc.lc = (tid & 15) * 4;
  bf16_t* Yhv = (bf16_t*)(p.ws + WS_Y) + (size_t)d * MTOT * 384 + h * 64 + v0;
  const int nch = T / 16;
  float* buf0 = buf;
  float* buf1 = buf + 16 * 384;
  __syncthreads();
  SCAN_DECL(A)
  SCAN_GLOAD(A, 0);
  SCAN_LSTORE(A, 0);
  __syncthreads();
  for (int ch = 0; ch < nch; ++ch) {
    if (ch + 1 < nch) SCAN_GLOAD(A, ch + 1);
    scan_chunk8(S, (ch & 1) ? buf1 : buf0, k0, v0, kq, Yhv, row0, T, d, ch);
    if (ch + 1 < nch) SCAN_LSTORE(A, (ch + 1) & 1);
    __syncthreads();
  }
#pragma unroll
  for (int j = 0; j < 2; ++j) {
    float4 t0, t1;
    t0.x = S[j][0].x; t0.y = S[j][0].y; t0.z = S[j][1].x; t0.w = S[j][1].y;
    t1.x = S[j][2].x; t1.y = S[j][2].y; t1.z = S[j][3].x; t1.w = S[j][3].y;
    *(float4*)(fin + (v0 + j) * 64 + k0) = t0;
    *(float4*)(fin + (v0 + j) * 64 + k0 + 4) = t1;
  }
}

template <int R>
__device__ __forceinline__ void scan_unit(const Params& p, int l, int row0, int T, int h, int d, int vbase,
                                          const float* init, float* fin, unsigned char* smem) {
  const int tid = opq_tid();
  const int v0 = vbase + (tid >> 4) * R, kq = tid & 15, k0 = kq * 4;
  f32x2 S[R][2];
#pragma unroll
  for (int j = 0; j < R; ++j) {
    if (init) {
      const float4 t = *(const float4*)(init + (v0 + j) * 64 + k0);
      S[j][0].x = t.x; S[j][0].y = t.y; S[j][1].x = t.z; S[j][1].y = t.w;
    } else {
      S[j][0] = (f32x2){0.f, 0.f}; S[j][1] = (f32x2){0.f, 0.f};
    }
  }
  float* buf = (float*)smem;
  ScanSrc sc;
  sc.DEC = (const float*)(p.ws + WS_DEC) + (size_t)d * MTOT * 384;
  sc.KT = (const bf16_t*)(p.ws + WS_KT) + (size_t)d * MTOT * 384;
  sc.BB = (const bf16_t*)(p.ws + WS_BB) + (size_t)d * MTOT * 384;
  sc.KK = (const bf16_t*)(p.ws + WS_KK);
  sc.CZ = (const float*)(p.ws + WS_CZ);
  sc.row0 = row0; sc.T = T; sc.d = d; sc.hoff = h * 64; sc.ls = tid >> 4; sc.lc = (tid & 15) * 4;
  bf16_t* Yhv = (bf16_t*)(p.ws + WS_Y) + (size_t)d * MTOT * 384 + h * 64 + v0;
  const int nch = T / 16;
  float* buf0 = buf;
  float* buf1 = buf + 16 * 384;
  __syncthreads();
  if constexpr (R == 1) {
    __builtin_amdgcn_s_setprio(3);
    SCAN_DECL(A) SCAN_DECL(B) SCAN_DECL(C) SCAN_DECL(Dd)
    SCAN_GLOAD(A, 0);
    SCAN_LSTORE(A, 0);
    SCAN_GLOAD(A, 1);
    SCAN_GLOAD(B, 2);
    SCAN_GLOAD(C, 3);
    __syncthreads();
    for (int ch = 0; ch < nch; ch += 4) {
      if (ch + 4 < nch) SCAN_GLOAD(Dd, ch + 4);
      scan_chunk<R>(S, buf0, k0, v0, kq, Yhv, row0, T, d, ch);
      SCAN_LSTORE(A, 1);
      __syncthreads();
      if (ch + 5 < nch) SCAN_GLOAD(A, ch + 5);
      scan_chunk<R>(S, buf1, k0, v0, kq, Yhv, row0, T, d, ch + 1);
      SCAN_LSTORE(B, 0);
      __syncthreads();
      if (ch + 6 < nch) SCAN_GLOAD(B, ch + 6);
      scan_chunk<R>(S, buf0, k0, v0, kq, Yhv, row0, T, d, ch + 2);
      SCAN_LSTORE(C, 1);
      __syncthreads();
      if (ch + 7 < nch) SCAN_GLOAD(C, ch + 7);
      scan_chunk<R>(S, buf1, k0, v0, kq, Yhv, row0, T, d, ch + 3);
      if (ch + 4 < nch) SCAN_LSTORE(Dd, 0);
      __syncthreads();
    }
    __builtin_amdgcn_s_setprio(0);
  } else {
    SCAN_DECL(A)
    SCAN_GLOAD(A, 0);
    SCAN_LSTORE(A, 0);
    __syncthreads();
    for (int ch = 0; ch < nch; ++ch) {
      if (ch + 1 < nch) SCAN_GLOAD(A, ch + 1);
      scan_chunk<R>(S, (ch & 1) ? buf1 : buf0, k0, v0, kq, Yhv, row0, T, d, ch);
      if (ch + 1 < nch) SCAN_LSTORE(A, (ch + 1) & 1);
      __syncthreads();
    }
  }
  if (fin) {
#pragma unroll
    for (int j = 0; j < R; ++j) {
      float4 t;
      t.x = S[j][0].x; t.y = S[j][0].y; t.z = S[j][1].x; t.w = S[j][1].y;
      *(float4*)(fin + (v0 + j) * 64 + k0) = t;
    }
  }
}

struct AttnDesc {
  const bf16_t* q;
  const bf16_t* kloc;
  const bf16_t* vloc;
  const bf16_t* kctx;
  const bf16_t* vctx;
  bf16_t* o;
  int qpos0;
  int lo, hi;
  int window;
  float sink; int has_sink;
};

__device__ __forceinline__ void attn_unit(const AttnDesc& a, unsigned char* smem) {
  const int tid = opq_tid(), lane = tid & 63, wid = tid >> 6, fr = lane & 15, fq = lane >> 4;
  unsigned char* sK = smem;
  unsigned char* sV = smem + 8192;
  bf16x8 qf[2];
  {
    const bf16_t* qp = a.q + (size_t)(wid * 16 + fr) * 896 + fq * 8;
    qf[0] = *(const bf16x8*)(qp);
    qf[1] = *(const bf16x8*)(qp + 32);
  }
  f32x4 o[4];
#pragma unroll
  for (int i = 0; i < 4; ++i) o[i] = (f32x4){0.f, 0.f, 0.f, 0.f};
  float mrun = -1e30f, lsum = 0.f;
  const int nctx = a.kctx ? 4 : 0;
  const int ntl = nctx + (a.hi - a.lo + 1);
  const int sw = (fr >> 1) & 7;
  const int qpos = a.qpos0 + wid * 16 + fr;
  const int r0_ = tid >> 3, chn = tid & 7, r1_ = r0_ + 32;
  const int rho0 = (r0_ & 32) | (((r0_ >> 2) & 1) << 4) | (((r0_ >> 3) & 3) << 2) | (r0_ & 3);
  const int rho1 = rho0 + 32;
  uint4 rk0, rk1, rv0, rv1;
#define ATTN_TLOAD(it_)                                                                          \
  {                                                                                              \
    const bool ic_ = (it_) < nctx;                                                               \
    const int kt_ = ic_ ? (it_) : a.lo + ((it_) - nctx);                                         \
    const bf16_t* kb_ = ic_ ? a.kctx + (size_t)kt_ * 64 * 64 : a.kloc + (size_t)kt_ * 64 * 896;  \
    const int kstr_ = ic_ ? 64 : 896;                                                            \
    const bf16_t* vb_ = ic_ ? a.vctx + kt_ * 64 : a.vloc + kt_ * 64;                             \
    const int vstr_ = ic_ ? 256 : MTOT;                                                          \
    rk0 = *(const uint4*)(kb_ + (size_t)r0_ * kstr_ + chn * 8);                                  \
    rk1 = *(const uint4*)(kb_ + (size_t)r1_ * kstr_ + chn * 8);                                  \
    rv0 = *(const uint4*)(vb_ + (size_t)r0_ * vstr_ + chn * 8);                                  \
    rv1 = *(const uint4*)(vb_ + (size_t)r1_ * vstr_ + chn * 8);                                  \
  }
  ATTN_TLOAD(0);
  for (int it = 0; it < ntl; ++it) {
    const bool isctx = it < nctx;
    const int kt = isctx ? it : a.lo + (it - nctx);
    __syncthreads();
    *(uint4*)(sK + rho0 * 128 + ((chn ^ ((rho0 >> 1) & 7)) << 4)) = rk0;
    *(uint4*)(sK + rho1 * 128 + ((chn ^ ((rho1 >> 1) & 7)) << 4)) = rk1;
    *(uint4*)(sV + r0_ * 128 + ((chn ^ ((r0_ >> 1) & 7)) << 4)) = rv0;
    *(uint4*)(sV + r1_ * 128 + ((chn ^ ((r1_ >> 1) & 7)) << 4)) = rv1;
    __syncthreads();
    if (it + 1 < ntl) ATTN_TLOAD(it + 1);
    f32x4 st[4];
#pragma unroll
    for (int kb4 = 0; kb4 < 4; ++kb4) {
      st[kb4] = (f32x4){0.f, 0.f, 0.f, 0.f};
#pragma unroll
      for (int ks = 0; ks < 2; ++ks) {
        const bf16x8 af = *(const bf16x8*)(sK + (kb4 * 16 + fr) * 128 + (((ks * 4 + fq) ^ sw) << 4));
        st[kb4] = mfma16(af, qf[ks], st[kb4]);
      }
    }
    float mt = -1e30f;
#pragma unroll
    for (int kb4 = 0; kb4 < 4; ++kb4)
#pragma unroll
      for (int jj = 0; jj < 4; ++jj) {
        float s = st[kb4][jj] * 0.125f;
        if (a.window && !isctx) {
          const int key = (kb4 >> 1) * 32 + fq * 8 + (kb4 & 1) * 4 + jj;
          const int dlt = kt * 64 + key - qpos;
          if (dlt > 128 || dlt < -128) s = -1e30f;
        }
        st[kb4][jj] = s;
        mt = fmaxf(mt, s);
      }
    mt = fmaxf(mt, __shfl_xor(mt, 16));
    mt = fmaxf(mt, __shfl_xor(mt, 32));
    const float mnew = fmaxf(mrun, mt);
    const float alpha = __expf(mrun - mnew);
    mrun = mnew;
    float ps = 0.f;
#pragma unroll
    for (int kb4 = 0; kb4 < 4; ++kb4)
#pragma unroll
      for (int jj = 0; jj < 4; ++jj) {
        const float pv = __expf(st[kb4][jj] - mnew);
        st[kb4][jj] = pv;
        ps += pv;
      }
    lsum = lsum * alpha + ps;
#pragma unroll
    for (int i = 0; i < 4; ++i) o[i] *= alpha;
    bf16x8 pb[2];
#pragma unroll
    for (int kg = 0; kg < 2; ++kg) {
      union { uint4 u4; bf16x8 v8; } r;
      r.u4.x = pk_bf16(st[2 * kg][0], st[2 * kg][1]);
      r.u4.y = pk_bf16(st[2 * kg][2], st[2 * kg][3]);
      r.u4.z = pk_bf16(st[2 * kg + 1][0], st[2 * kg + 1][1]);
      r.u4.w = pk_bf16(st[2 * kg + 1][2], st[2 * kg + 1][3]);
      pb[kg] = r.v8;
    }
#pragma unroll
    for (int db = 0; db < 4; ++db)
#pragma unroll
      for (int kg = 0; kg < 2; ++kg) {
        const bf16x8 vf = *(const bf16x8*)(sV + (db * 16 + fr) * 128 + (((kg * 4 + fq) ^ sw) << 4));
        o[db] = mfma16(vf, pb[kg], o[db]);
      }
  }
  lsum += __shfl_xor(lsum, 16);
  lsum += __shfl_xor(lsum, 32);
  if (a.has_sink) lsum += __expf(a.sink - mrun);
  const float inv = frcp(lsum);
  bf16_t* op = a.o + (size_t)(wid * 16 + fr) * 1024 + fq * 4;
#pragma unroll
  for (int db = 0; db < 4; ++db) {
    uint2 v;
    v.x = pk_bf16(o[db][0] * inv, o[db][1] * inv);
    v.y = pk_bf16(o[db][2] * inv, o[db][3] * inv);
    *(uint2*)(op + db * 16) = v;
  }
}

constexpr int U_LSCAN = 96, U_CSCAN = 384, U_LATB = 192, U_LATA = 128, U_CTX = 1280;
constexpr int U_TOTAL = U_LSCAN + U_CSCAN + U_LATB + U_LATA + U_CTX;

__device__ __forceinline__ void mix_phase(const Params& p, int slot, int l, unsigned char* smem, int ulo = 0, int uhi = U_TOTAL) {
  unsigned* cnt = (unsigned*)(p.ws + WS_CNT) + slot * 8;
  int* s_u = (int*)(smem + SMEM_CTL);
  const bf16_t* QK = (const bf16_t*)(p.ws + WS_QK);
  const bf16_t* VT = (const bf16_t*)(p.ws + WS_VT);
  bf16_t* MIX = (bf16_t*)(p.ws + WS_H);
  for (;;) {
    __syncthreads();
    if (opq_tid() == 0) *s_u = (int)atomicAdd(cnt, 1u);
    __syncthreads();
    int u = *s_u + ulo;
    if (u >= uhi) break;
    if (u < U_LSCAN) {
      const int chain = u >> 2, part = u & 3;
      const int b = chain / 12, h = (chain % 12) >> 1, d = chain & 1;
      const float* init = p.state_c + ((((size_t)b * 2 + l) * 2 + d) * 6 + h) * 4096;
      scan_unit<1>(p, l, M_CTX + b * 1024, 1024, h, d, part * 16, init, nullptr, smem);
      continue;
    }
    u -= U_LSCAN;
    if (u < U_CSCAN) {
      const int b = u / 12, h = (u % 12) >> 1, d = u & 1;
      float* fin = p.out + OUT_ST + ((((size_t)b * 2 + l) * 2 + d) * 6 + h) * 4096;
      scan_unit8(p, l, b * 256, 256, h, d, fin, smem);
      continue;
    }
    u -= U_CSCAN;
    AttnDesc a;
    if (u < U_LATB) {
      const int b = u / 96, h = (u % 96) >> 4, qb = u & 15, kvh = h / 3;
      const int r0 = M_CTX + b * 1024;
      a.q = QK + (size_t)(r0 + qb * 64) * 896 + 384 + h * 64;
      a.kloc = QK + (size_t)r0 * 896 + 768 + kvh * 64;
      a.vloc = VT + (size_t)((2 + kvh) * 64) * MTOT + r0;
      a.kctx = (const bf16_t*)(p.ws + WS_CKB) + (size_t)((b * 2 + l) * 2 + kvh) * 16384;
      a.vctx = (const bf16_t*)(p.ws + WS_CVTB) + (size_t)((b * 2 + l) * 2 + kvh) * 16384;
      a.o = MIX + (size_t)(r0 + qb * 64) * 1024 + 256 + h * 64;
      a.qpos0 = qb * 64; a.lo = 0; a.hi = 15; a.window = 0; a.sink = 0.f; a.has_sink = 0;
    } else if (u < U_LATB + U_LATA) {
      u -= U_LATB;
      const int b = u >> 6, h = (u & 63) >> 4, qb = u & 15, kvh = h >> 1;
      const int r0 = M_CTX + b * 1024;
      a.q = QK + (size_t)(r0 + qb * 64) * 896 + h * 64;
      a.kloc = QK + (size_t)r0 * 896 + 256 + kvh * 64;
      a.vloc = VT + (size_t)(kvh * 64) * MTOT + r0;
      a.kctx = (const bf16_t*)(p.ws + WS_CKA) + (size_t)((b * 2 + l) * 2 + kvh) * 16384;
      a.vctx = (const bf16_t*)(p.ws + WS_CVTA) + (size_t)((b * 2 + l) * 2 + kvh) * 16384;
      a.o = MIX + (size_t)(r0 + qb * 64) * 1024 + h * 64;
      a.qpos0 = qb * 64; a.lo = qb - 2 < 0 ? 0 : qb - 2; a.hi = qb + 2 > 15 ? 15 : qb + 2; a.window = 1;
      a.sink = p.a_sink[l * 4 + h]; a.has_sink = 1;
    } else {
      u -= U_LATB + U_LATA;
      const int b = u / 40, rem = u % 40, hh = rem >> 2, qb = rem & 3;
      const int r0 = b * 256;
      a.kctx = nullptr; a.vctx = nullptr;
      a.qpos0 = qb * 64; a.lo = 0; a.hi = 3; a.window = 0;
      if (hh < 4) {
        const int h = hh, kvh = h >> 1;
        a.q = QK + (size_t)(r0 + qb * 64) * 896 + h * 64;
        a.kloc = QK + (size_t)r0 * 896 + 256 + kvh * 64;
        a.vloc = VT + (size_t)(kvh * 64) * MTOT + r0;
        a.o = MIX + (size_t)(r0 + qb * 64) * 1024 + h * 64;
        a.sink = p.a_sink[l * 4 + h]; a.has_sink = 1;
      } else {
        const int h = hh - 4, kvh = h / 3;
        a.q = QK + (size_t)(r0 + qb * 64) * 896 + 384 + h * 64;
        a.kloc = QK + (size_t)r0 * 896 + 768 + kvh * 64;
        a.vloc = VT + (size_t)((2 + kvh) * 64) * MTOT + r0;
        a.o = MIX + (size_t)(r0 + qb * 64) * 1024 + 256 + h * 64;
        a.sink = 0.f; a.has_sink = 0;
      }
    }
    attn_unit(a, smem);
  }
}

__device__ __forceinline__ void post_phase(const Params& p, int l) {
  const int tid_ = opq_tid(); const int lane = tid_ & 63, wave = tid_ >> 6;
  const bf16_t* Y = (const bf16_t*)(p.ws + WS_Y);
  const bf16_t* Gb = (const bf16_t*)(p.ws + WS_G);
  const float* BON = (const float*)(p.ws + WS_BON);
  const float* CZ = (const float*)(p.ws + WS_CZ);
  bf16_t* MIX = (bf16_t*)(p.ws + WS_H);
  for (int row = opq_bid() * 4 + wave; row < MTOT; row += gridDim.x * 4) {
#pragma unroll
    for (int h = 0; h < 6; ++h) {
      const int col = h * 64 + lane;
      const float y = bf2f(Y[(size_t)row * 384 + col]) + bf2f(Y[((size_t)MTOT + row) * 384 + col]);
      const float mu = wave_sum(y) * (1.f / 64.f);
      const float dv = y - mu;
      const float var = wave_sum(dv * dv) * (1.f / 64.f);
      const float yn = dv * __builtin_amdgcn_rsqf(var + 64e-5f);
      const float vv = CZ[(size_t)row * 1408 + 768 + col];
      const float o = (yn * p.c_ln_w[l * 384 + col] + p.c_ln_b[l * 384 + col] + BON[(size_t)row * 8 + h] * vv) *
                      bf2f(Gb[(size_t)row * 384 + col]);
      MIX[(size_t)row * 1024 + 640 + col] = f2bf(o);
    }
  }
}


#define XB_TMO      128
#define XB_XCNT(j)  (256  + 64 * (j))
#define XB_XSUB(j)  (1280 + 64 * (j))
#define XB_XGEN(j)  (2304 + 64 * (j))
#define XB_TOP      3328
#define XB_TOPGEN   3392
#define XCD_BAR_WORDS 3456
#define XB_SPIN_CAP (1u << 22)
#define LAS __attribute__((address_space(3)))
__device__ __forceinline__ unsigned xb_ld(unsigned* p)              { return __hip_atomic_load(p, __ATOMIC_RELAXED, __HIP_MEMORY_SCOPE_AGENT); }
__device__ __forceinline__ unsigned xb_add(unsigned* p, unsigned v) { return __hip_atomic_fetch_add(p, v, __ATOMIC_RELAXED, __HIP_MEMORY_SCOPE_AGENT); }
__device__ __forceinline__ unsigned xb_xcc_id() { return (unsigned)__builtin_amdgcn_s_getreg((3 << 11) | 20) & 0xFu; }
#define XB_SPIN(cond, bar) do { unsigned _sp = 0; while (cond) { __builtin_amdgcn_s_sleep(1); \
    if ((++_sp & 255u) == 0u) { if (xb_ld(&(bar)[XB_TMO])) break; if (_sp > XB_SPIN_CAP) { atomicAdd(&(bar)[XB_TMO], 1u); break; } } } } while (0)
struct XcdBarrier { unsigned* bar; unsigned x; volatile LAS unsigned* st; };
__device__ __forceinline__ XcdBarrier xcd_barrier_post(unsigned* bar, volatile LAS unsigned* st) {
  XcdBarrier b; b.bar = bar; b.x = xb_xcc_id(); b.st = st;
  if (threadIdx.x == 0) (void)xb_add(&bar[XB_XCNT(b.x)], 1u);
  return b;
}
__device__ __forceinline__ void xcd_barrier_complete(unsigned* bar, unsigned x, unsigned& nloc, unsigned& nx) {
  const unsigned G = gridDim.x * gridDim.y * gridDim.z;
  unsigned sum, cnt, mine, sp = 0u;
  for (;;) {
    sum = 0u; cnt = 0u; mine = 0u;
#pragma unroll
    for (unsigned j = 0; j < 16; ++j) { const unsigned c = xb_ld(&bar[XB_XCNT(j)]); sum += c; cnt += (c > 0u) ? 1u : 0u; mine = (j == x) ? c : mine; }
    if (sum == G) break;
    __builtin_amdgcn_s_sleep(1);
    if ((++sp & 255u) == 0u) { if (xb_ld(&bar[XB_TMO])) break; if (sp > XB_SPIN_CAP) { atomicAdd(&bar[XB_TMO], 1u); break; } }
  }
  nloc = mine > 0u ? mine : 1u; nx = cnt > 0u ? cnt : 1u;
}
__device__ __forceinline__ void xcd_barrier(const XcdBarrier& b) {
  asm volatile("s_waitcnt vmcnt(0)" ::: "memory");
  __syncthreads();
  if (threadIdx.x == 0) {
    unsigned* bar = b.bar;
    __builtin_amdgcn_s_waitcnt(0);
    unsigned nloc = b.st[0], nx = b.st[1];
    if (nloc == 0u) { xcd_barrier_complete(bar, b.x, nloc, nx); b.st[0] = nloc; b.st[1] = nx; }
    const unsigned old = xb_add(&bar[XB_XSUB(b.x)], 1u);
    const unsigned gen = old / nloc;
    if (old + 1u == (gen + 1u) * nloc) {
      __builtin_amdgcn_fence(__ATOMIC_RELEASE, "agent");
      asm volatile("s_waitcnt vmcnt(0)" ::: "memory");
      const unsigned og = xb_add(&bar[XB_TOP], 1u);
      const unsigned tg = og / nx;
      if (og + 1u == (tg + 1u) * nx) xb_add(&bar[XB_TOPGEN], 1u);
      else XB_SPIN(xb_ld(&bar[XB_TOPGEN]) == tg, bar);
      __builtin_amdgcn_fence(__ATOMIC_ACQUIRE, "agent");
      xb_add(&bar[XB_XGEN(b.x)], 1u);
      asm volatile("s_waitcnt vmcnt(0)" ::: "memory");
    } else {
      XB_SPIN(xb_ld(&bar[XB_XGEN(b.x)]) == gen, bar);
      __builtin_amdgcn_fence(__ATOMIC_ACQUIRE, "agent");
      asm volatile("s_waitcnt vmcnt(0)" ::: "memory");
    }
  }
  __syncthreads();
}

__device__ __forceinline__ void run_phase(const Params& p, int ph, unsigned char* smem) {
  if (ph == 0) { phase0(p, smem); return; }
  if (ph == NPHASE - 1) { rpass(p, 2, 1); return; }
  const int l = (ph - 1) / 9, s = (ph - 1) % 9;
  const bf16_t* H = (const bf16_t*)(p.ws + WS_H);
  switch (s) {
    case 0: if (l == 0) rpass(p, 0, 0); else rpass(p, 2, 0); break;
    case 1: gemm_phase<0>(p, l, H, D, (const bf16_t*)(p.ws + WS_WT_IN) + (size_t)l * IN_COLS * D, D, IN_COLS, D, smem); break;
    case 2: prep_phase(p, l, smem); break;
    case 3: mix_phase(p, l * 2, l, smem); break;
    case 4: post_phase(p, l); break;
    case 5: gemm_phase<1>(p, l, H, D, (const bf16_t*)(p.ws + WS_WT_OUT) + (size_t)l * D * D, D, D, D, smem); break;
    case 6: rpass(p, 1, l); break;
    case 7: gemm_phase<2>(p, l, H, D, (const bf16_t*)(p.ws + WS_WT_GU) + (size_t)l * GU * D, D, GU, D, smem); break;
    case 8: gemm_phase<1>(p, l, (const bf16_t*)(p.ws + WS_CZ), FF, (const bf16_t*)(p.ws + WS_WT_DN) + (size_t)l * D * FF, FF, D, FF, smem); break;
  }
}

#if N_LAUNCH_MODE == 0
__global__ void __launch_bounds__(256, 2) fwd_phases(Params p) {
  extern __shared__ __attribute__((aligned(16))) unsigned char smem[];
  run_phase(p, p.ph_lo, smem);
}
#define FWD_KERNEL fwd_phases
#else
template <int L>
__device__ __forceinline__ void layer_phases(const Params& p, unsigned char* smem, const XcdBarrier& xb) {
  const bf16_t* H = (const bf16_t*)(p.ws + WS_H);
  if (L == 0) {
#pragma unroll
    for (int rep = 0; rep < REP_R0; ++rep) rpass(p, 0, 0);
  } else rpass(p, 2, 0);
  xcd_barrier(xb);
#pragma unroll
  for (int rep = 0; rep < REP_GEMM; ++rep) {
    gemm_phase<0>(p, L, H, D, (const bf16_t*)(p.ws + WS_WT_IN) + (size_t)L * IN_COLS * D, D, IN_COLS, D, smem);
    xcd_barrier(xb);
  }
#pragma unroll
  for (int rep = 0; rep < REP_OTHER * REP_PREP; ++rep) {
    prep_phase(p, L, smem);
    xcd_barrier(xb);
  }
#if MIX_SPLIT
#pragma unroll
  for (int rep = 0; rep < REP_MA; ++rep) { mix_phase(p, L * 4 + 0 + 0 * rep, L, smem, 0, U_LSCAN); xcd_barrier(xb); if (rep + 1 < REP_MA) { if (threadIdx.x == 0 && blockIdx.x == 0) ((unsigned*)(p.ws + WS_CNT))[(L * 4 + 0) * 8] = 0u; xcd_barrier(xb); } }
#pragma unroll
  for (int rep = 0; rep < REP_MB; ++rep) { mix_phase(p, L * 4 + 1, L, smem, U_LSCAN, U_LSCAN + U_CSCAN); xcd_barrier(xb); if (rep + 1 < REP_MB) { if (threadIdx.x == 0 && blockIdx.x == 0) ((unsigned*)(p.ws + WS_CNT))[(L * 4 + 1) * 8] = 0u; xcd_barrier(xb); } }
#pragma unroll
  for (int rep = 0; rep < REP_MC; ++rep) { mix_phase(p, L * 4 + 2, L, smem, U_LSCAN + U_CSCAN, U_TOTAL); xcd_barrier(xb); if (rep + 1 < REP_MC) { if (threadIdx.x == 0 && blockIdx.x == 0) ((unsigned*)(p.ws + WS_CNT))[(L * 4 + 2) * 8] = 0u; xcd_barrier(xb); } }
#else
#pragma unroll
  for (int rep = 0; rep < REP_MIX; ++rep) {
    mix_phase(p, L * 2 + rep, L, smem);
    xcd_barrier(xb);
  }
#endif
#pragma unroll
  for (int rep = 0; rep < REP_OTHER; ++rep) {
    post_phase(p, L);
    xcd_barrier(xb);
  }
#pragma unroll
  for (int rep = 0; rep < REP_GEMM; ++rep) {
    gemm160_phase(p, H, D, (const bf16_t*)(p.ws + WS_WT_OUT) + (size_t)L * D * D, D, D, smem);
    xcd_barrier(xb);
  }
  rpass(p, 1, L);
  xcd_barrier(xb);
#pragma unroll
  for (int rep = 0; rep < REP_GEMM; ++rep) {
    gemm_phase<2>(p, L, H, D, (const bf16_t*)(p.ws + WS_WT_GU) + (size_t)L * GU * D, D, GU, D, smem);
    xcd_barrier(xb);
  }
#pragma unroll
  for (int rep = 0; rep < REP_GEMM; ++rep) {
    gemm160_phase(p, (const bf16_t*)(p.ws + WS_CZ), FF, (const bf16_t*)(p.ws + WS_WT_DN) + (size_t)L * D * FF, FF, FF, smem);
    xcd_barrier(xb);
  }
}
__global__ void __launch_bounds__(256, 2) fwd_mega(Params p) {
  extern __shared__ __attribute__((aligned(16))) unsigned char smem[];
  if (threadIdx.x == 0) { *(unsigned*)(smem + SMEM_CTL + 8) = 0u; *(unsigned*)(smem + SMEM_CTL + 12) = 0u; }
  __syncthreads();
  XcdBarrier xb = xcd_barrier_post((unsigned*)(p.ws + WS_BAR), (volatile LAS unsigned*)(smem + SMEM_CTL + 8));
#pragma unroll
  for (int rep = 0; rep < REP_P0; ++rep) phase0(p, smem);
#pragma unroll
  for (int rep = 0; rep < REP_BAR; ++rep) xcd_barrier(xb);
#if USE_CG_SYNC
  cg::this_grid().sync();
#else
  if (p.ph_hi < 0) cg::this_grid().sync();
  xcd_barrier(xb);
#endif
  layer_phases<0>(p, smem, xb);
  layer_phases<1>(p, smem, xb);
  rpass(p, 2, 1);
}
#define FWD_KERNEL fwd_mega
#endif

extern "C" void kernel_launch(void* const* d_in, const int* in_sizes, int n_in, void* d_out, int out_size, void* d_ws,
                              size_t ws_size, hipStream_t stream) {
  static int grid_blocks = 0;
  if (!grid_blocks) {
    int dev = 0, cus = 0, per_cu = 0;
    (void)hipGetDevice(&dev);
    (void)hipDeviceGetAttribute(&cus, hipDeviceAttributeMultiprocessorCount, dev);
    (void)hipFuncSetAttribute((const void*)FWD_KERNEL, hipFuncAttributeMaxDynamicSharedMemorySize, SMEM_BYTES);
    (void)hipOccupancyMaxActiveBlocksPerMultiprocessor(&per_cu, (const void*)FWD_KERNEL, 256, SMEM_BYTES);
    if (per_cu > 2) per_cu = 2;
    if (per_cu < 1) per_cu = 1;
    grid_blocks = cus * per_cu;
    if (n_in != 32 || ws_size < WS_END) {
      fprintf(stderr, "kernel_launch: unexpected n_in %d or ws_size %zu (< %zu)\n", n_in, ws_size, (size_t)WS_END);
      grid_blocks = -1;
    }
  }
  if (grid_blocks < 0) return;
  Params p{};
  const float** pp = (const float**)&p;
  for (int i = 0; i < 32; ++i) pp[i] = (const float*)d_in[i];
  p.out = (float*)d_out;
  p.ws = (unsigned char*)d_ws;
#if N_LAUNCH_MODE
  p.ph_lo = 0; p.ph_hi = NPHASE;
  (void)hipMemsetAsync((unsigned char*)d_ws + WS_BAR, 0, 16384, stream);
  void* args[] = {&p};
  hipError_t e = hipLaunchCooperativeKernel((const void*)fwd_mega, dim3(grid_blocks), dim3(256), args, SMEM_BYTES, stream);
  if (e != hipSuccess) fprintf(stderr, "cooperative launch failed: %s (grid %d)\n", hipGetErrorString(e), grid_blocks);
#else
  for (int ph = 0; ph < NPHASE; ++ph) {
    p.ph_lo = ph; p.ph_hi = ph + 1;
    hipLaunchKernelGGL(fwd_phases, dim3(grid_blocks), dim3(256), SMEM_BYTES, stream, p);
  }
#endif
}
```

```cpp
#include <hip/hip_runtime.h>
#include <hip/hip_bf16.h>
#include <hip/hip_cooperative_groups.h>
#include <cstdio>
#include <cstdint>
namespace cg = cooperative_groups;

typedef unsigned short bf16_t;
using bf16x8 = __attribute__((ext_vector_type(8))) short;
using f32x4 = __attribute__((ext_vector_type(4))) float;

#ifndef REP_GEMM
#define REP_GEMM 1
#endif
#ifndef REP_MIX
#define REP_MIX 1
#endif
#ifndef REP_P0
#define REP_P0 1
#endif
#ifndef REP_R0
#define REP_R0 1
#endif
#ifndef REP_BAR
#define REP_BAR 0
#endif
#ifndef REP_PREP
#define REP_PREP 1
#endif
#ifndef MIX_SPLIT
#define MIX_SPLIT 0
#endif
#ifndef REP_MA
#define REP_MA 1
#endif
#ifndef REP_MB
#define REP_MB 1
#endif
#ifndef REP_MC
#define REP_MC 1
#endif
#ifndef REP_OTHER
#define REP_OTHER 1
#endif
#ifndef USE_CG_SYNC
#define USE_CG_SYNC 0
#endif
#ifndef N_LAUNCH_MODE
#define N_LAUNCH_MODE 1
#endif

constexpr int D = 1024, M_CTX = 8192, M_LAT = 2048, MTOT = 10240;
constexpr int IN_COLS = 2560, FF = 2816, GU = 5632;
constexpr int NPHASE = 20;
constexpr int SMEM_CTL = 73728;
constexpr int SMEM_BYTES = SMEM_CTL + 64;

constexpr size_t al256(size_t x) { return (x + 255) & ~(size_t)255; }
constexpr size_t WS_WT_IN = 0;
constexpr size_t WS_WT_OUT = WS_WT_IN + (size_t)2 * IN_COLS * D * 2;
constexpr size_t WS_WT_GU = WS_WT_OUT + (size_t)2 * D * D * 2;
constexpr size_t WS_WT_DN = WS_WT_GU + (size_t)2 * GU * D * 2;
constexpr size_t WS_WUPT = WS_WT_DN + (size_t)2 * D * FF * 2;
constexpr size_t WS_AUPT = WS_WUPT + (size_t)4 * 384 * 64 * 2;
constexpr size_t WS_GUPT = WS_AUPT + (size_t)4 * 384 * 64 * 2;
constexpr size_t WS_MOD = WS_GUPT + (size_t)2 * 384 * 128 * 2;
constexpr size_t WS_ROPE = WS_MOD + (size_t)2 * 3 * 6144 * 4;
constexpr size_t WS_CKA = WS_ROPE + (size_t)1024 * 32 * 2 * 4;
constexpr size_t WS_CVTA = WS_CKA + (size_t)131072 * 2;
constexpr size_t WS_CKB = WS_CVTA + (size_t)131072 * 2;
constexpr size_t WS_CVTB = WS_CKB + (size_t)131072 * 2;
constexpr size_t WS_CNT = WS_CVTB + (size_t)131072 * 2;
constexpr size_t WS_BAR = WS_CNT + 256;
constexpr size_t WS_H = WS_BAR + 16384;
constexpr size_t WS_QK = WS_H + (size_t)MTOT * D * 2;
constexpr size_t WS_VT = WS_QK + (size_t)MTOT * 896 * 2;
constexpr size_t WS_CZ = WS_VT + (size_t)4 * 64 * MTOT * 2;
constexpr size_t WS_DEC = WS_CZ + (size_t)MTOT * 1408 * 4;
constexpr size_t WS_KT = WS_DEC + (size_t)2 * MTOT * 384 * 4;
constexpr size_t WS_BB = WS_KT + (size_t)2 * MTOT * 384 * 2;
constexpr size_t WS_KK = WS_BB + (size_t)2 * MTOT * 384 * 2;
constexpr size_t WS_G = WS_KK + (size_t)MTOT * 384 * 2;
constexpr size_t WS_BON = WS_G + (size_t)MTOT * 384 * 2;
constexpr size_t WS_Y = WS_BON + (size_t)MTOT * 8 * 4;
constexpr size_t WS_PA = WS_Y + (size_t)2 * MTOT * 384 * 2;
constexpr size_t WS_END = WS_PA + (size_t)MTOT * 256 * 2;
static_assert((size_t)MTOT * D * 4 <= (WS_BB - WS_DEC), "O alias");
static_assert(WS_END <= (size_t)256 * 1024 * 1024, "workspace too big");

constexpr size_t OUT_X = 0;
constexpr size_t OUT_AK = (size_t)MTOT * D;
constexpr size_t OUT_AV = OUT_AK + 2097152;
constexpr size_t OUT_BK = OUT_AV + 2097152;
constexpr size_t OUT_BV = OUT_BK + 2097152;
constexpr size_t OUT_ST = OUT_BV + 2097152;

struct Params {
  const float *x_prompt, *x_sample, *cache_a_k, *cache_a_v, *cache_b_k, *cache_b_v, *state_c, *c, *c_ctx,
      *w_mod, *b_mod, *norm_mix_pre, *norm_mix_post, *norm_ffn_pre, *norm_ffn_post, *w_in, *w_out, *a_sink,
      *b_q_norm, *b_k_norm, *c_w0, *c_w_up, *c_a0, *c_a_up, *c_g_up, *c_k_k, *c_k_a, *c_r_k, *c_ln_w, *c_ln_b,
      *w_gu, *w_down;
  float* out;
  unsigned char* ws;
  int ph_lo, ph_hi;
};

typedef __bf16 bf16x2_t __attribute__((ext_vector_type(2)));
typedef float f32x2_t __attribute__((ext_vector_type(2)));
__device__ __forceinline__ unsigned pk_bf16(float lo, float hi) {
  f32x2_t f = {lo, hi};
  bf16x2_t b = __builtin_convertvector(f, bf16x2_t);
  return __builtin_bit_cast(unsigned, b);
}
__device__ __forceinline__ bf16_t f2bf(float f) { return (bf16_t)(pk_bf16(f, 0.f) & 0xffffu); }
__device__ __forceinline__ float bf2f(bf16_t b) { return __uint_as_float(((unsigned)b) << 16); }
__device__ __forceinline__ float bflo(unsigned u) { return __uint_as_float(u << 16); }
__device__ __forceinline__ float bfhi(unsigned u) { return __uint_as_float(u & 0xffff0000u); }
__device__ __forceinline__ int opq_tid() { int x = threadIdx.x; asm volatile("" : "+v"(x)); return x; }
__device__ __forceinline__ int opq_bid() { int x = blockIdx.x; asm volatile("" : "+s"(x)); return x; }
__device__ __forceinline__ float4 cvt4(uint2 u) { return make_float4(bflo(u.x), bfhi(u.x), bflo(u.y), bfhi(u.y)); }
__device__ __forceinline__ float frcp(float x) { return __builtin_amdgcn_rcpf(x); }
__device__ __forceinline__ float sigmoidf_(float x) { return frcp(1.f + __expf(-x)); }
__device__ __forceinline__ float wave_sum(float v) {
#pragma unroll
  for (int o = 1; o < 64; o <<= 1) v += __shfl_xor(v, o);
  return v;
}
template <int CTRL>
__device__ __forceinline__ float dppf(float x) {
  return __builtin_bit_cast(float, __builtin_amdgcn_mov_dpp(__builtin_bit_cast(int, x), CTRL, 0xf, 0xf, true));
}
constexpr int DPP_XOR1 = 0xB1, DPP_XOR2 = 0x4E, DPP_ROR4 = 0x124, DPP_ROR8 = 0x128;
__device__ __forceinline__ float row16_sum(float v) {
  v += dppf<DPP_XOR1>(v);
  v += dppf<DPP_XOR2>(v);
  v += dppf<DPP_ROR4>(v);
  v += dppf<DPP_ROR8>(v);
  return v;
}
__device__ __forceinline__ f32x4 mfma16(bf16x8 a, bf16x8 b, f32x4 c) {
  return __builtin_amdgcn_mfma_f32_16x16x32_bf16(a, b, c, 0, 0, 0);
}

__device__ __forceinline__ void transpose_tile(const float* __restrict__ src, int K, int N, bf16_t* __restrict__ dst,
                                               int tile, bool perm, float* lds) {
  const int nkt = K / 64, nnt = N / 64, per = nkt * nnt;
  const int lyr = tile / per, r = tile % per, kt = r / nnt, nt = r % nnt;
  src += (size_t)lyr * K * N;
  dst += (size_t)lyr * K * N;
  const int tid = opq_tid();
#pragma unroll
  for (int i = 0; i < 16; ++i) {
    const int row = (tid >> 6) + 4 * i;
    lds[row * 65 + (tid & 63)] = src[(size_t)(kt * 64 + row) * N + nt * 64 + (tid & 63)];
  }
  __syncthreads();
#pragma unroll
  for (int it = 0; it < 2; ++it) {
    const int idx = tid + it * 256, n = idx >> 3, kc = idx & 7;
    uint4 v;
    v.x = pk_bf16(lds[(kc * 8 + 0) * 65 + n], lds[(kc * 8 + 1) * 65 + n]);
    v.y = pk_bf16(lds[(kc * 8 + 2) * 65 + n], lds[(kc * 8 + 3) * 65 + n]);
    v.z = pk_bf16(lds[(kc * 8 + 4) * 65 + n], lds[(kc * 8 + 5) * 65 + n]);
    v.w = pk_bf16(lds[(kc * 8 + 6) * 65 + n], lds[(kc * 8 + 7) * 65 + n]);
    const int col = nt * 64 + n;
    int prow = col;
    if (perm) {
      if (col < FF) prow = (col >> 5) * 64 + (col & 31);
      else { const int c2 = col - FF; prow = (c2 >> 5) * 64 + 32 + (c2 & 31); }
    }
    *(uint4*)(dst + (size_t)prow * K + kt * 64 + kc * 8) = v;
  }
  __syncthreads();
}

__device__ __forceinline__ void gemv_item(const Params& p, int item, float* lds) {
  const int l = item / 192, n0 = (item % 192) * 32;
  const int tid = opq_tid();
  float* s_c = lds;
  float* red = lds + 3072;
  for (int i = tid; i < 3072; i += 256) {
    const int ci = i >> 10, k = i & 1023;
    const float x = (ci == 0) ? p.c_ctx[k] : p.c[(ci - 1) * 1024 + k];
    s_c[i] = x * sigmoidf_(x);
  }
  __syncthreads();
  const int kg = tid >> 5, col = tid & 31;
  const float* w = p.w_mod + (size_t)l * 1024 * 6144 + (size_t)(kg * 128) * 6144 + n0 + col;
  float a0 = 0.f, a1 = 0.f, a2 = 0.f;
#pragma unroll 32
  for (int k = 0; k < 128; ++k) {
    const float wv = __builtin_nontemporal_load(w + (size_t)k * 6144);
    a0 += s_c[kg * 128 + k] * wv;
    a1 += s_c[1024 + kg * 128 + k] * wv;
    a2 += s_c[2048 + kg * 128 + k] * wv;
  }
  red[(kg * 3 + 0) * 32 + col] = a0;
  red[(kg * 3 + 1) * 32 + col] = a1;
  red[(kg * 3 + 2) * 32 + col] = a2;
  __syncthreads();
  if (tid < 96) {
    const int ci = tid >> 5, cc = tid & 31;
    float sum = p.b_mod[l * 6144 + n0 + cc];
#pragma unroll
    for (int g = 0; g < 8; ++g) sum += red[(g * 3 + ci) * 32 + cc];
    ((float*)(p.ws + WS_MOD))[(l * 3 + ci) * 6144 + n0 + cc] = sum;
  }
  __syncthreads();
}

constexpr int WL_IN = 16 * 40, WL_OUT = 16 * 16, WL_GU = 16 * 88, WL_DN = 44 * 16, WL_UP = 2 * 6, WL_G = 2 * 6;
constexpr int WL_TOTAL = WL_IN + WL_OUT + WL_GU + WL_DN + 2 * WL_UP + WL_G;
__device__ __forceinline__ void weight_item(const Params& p, int layer, int r, float* lds) {
  if (r < WL_IN) { transpose_tile(p.w_in, 1024, IN_COLS, (bf16_t*)(p.ws + WS_WT_IN), layer * WL_IN + r, false, lds); return; }
  r -= WL_IN;
  if (r < WL_OUT) { transpose_tile(p.w_out, 1024, 1024, (bf16_t*)(p.ws + WS_WT_OUT), layer * WL_OUT + r, false, lds); return; }
  r -= WL_OUT;
  if (r < WL_GU) { transpose_tile(p.w_gu, 1024, GU, (bf16_t*)(p.ws + WS_WT_GU), layer * WL_GU + r, true, lds); return; }
  r -= WL_GU;
  if (r < WL_DN) { transpose_tile(p.w_down, FF, 1024, (bf16_t*)(p.ws + WS_WT_DN), layer * WL_DN + r, false, lds); return; }
  r -= WL_DN;
  if (r < WL_UP) { transpose_tile(p.c_w_up, 64, 384, (bf16_t*)(p.ws + WS_WUPT), layer * WL_UP + r, false, lds); return; }
  r -= WL_UP;
  if (r < WL_UP) { transpose_tile(p.c_a_up, 64, 384, (bf16_t*)(p.ws + WS_AUPT), layer * WL_UP + r, false, lds); return; }
  r -= WL_UP;
  transpose_tile(p.c_g_up, 128, 384, (bf16_t*)(p.ws + WS_GUPT), layer * WL_G + r, false, lds);
}

constexpr int P0_GEMV = 384;
constexpr int P0_ROPE = 128, P0_CACHE = 256;
constexpr int P0_TOTAL = P0_GEMV + WL_TOTAL + P0_ROPE + P0_CACHE;

__device__ __forceinline__ void phase0(const Params& p, unsigned char* smem) {
  float* lds = (float*)smem;
  const int tid = opq_tid();
  const int bid = opq_bid();
  if (bid == 0 && tid < 64) ((unsigned*)(p.ws + WS_CNT))[tid] = 0u;
  for (int it = bid; it < P0_TOTAL; it += gridDim.x) {
    int r = it;
    if (r < P0_GEMV) { gemv_item(p, r, lds); continue; }
    r -= P0_GEMV;
    if (r < WL_TOTAL) { weight_item(p, 0, r, lds); continue; }
    r -= WL_TOTAL;
    if (r < P0_ROPE) {
      const int idx = r * 256 + tid, t = idx >> 5, i = idx & 31, fi = i & 15;
      const float pos = (i < 16) ? (float)(t >> 6) : (float)(t & 63);
      const float freq = exp2f(-(float)fi * (13.287712379549449f / 16.f));
      float rev = pos * freq * 0.15915494309189535f;
      rev -= floorf(rev);
      float2 cs;
      cs.x = __builtin_amdgcn_cosf(rev);
      cs.y = __builtin_amdgcn_sinf(rev);
      ((float2*)(p.ws + WS_ROPE))[idx] = cs;
      continue;
    }
    r -= P0_ROPE;
    {
#pragma unroll
      for (int j = 0; j < 8; ++j) {
        const int idx = r * 2048 + j * 256 + tid;
        const int tensor = idx >> 17, e = idx & 131071;
        const float* src = tensor == 0 ? p.cache_a_k : tensor == 1 ? p.cache_a_v : tensor == 2 ? p.cache_b_k : p.cache_b_v;
        bf16_t* dst = (bf16_t*)(p.ws + (tensor == 0 ? WS_CKA : tensor == 1 ? WS_CVTA : tensor == 2 ? WS_CKB : WS_CVTB));
        int b, l, h, t, d;
        if ((tensor & 1) == 0) { d = e & 63; t = (e >> 6) & 255; h = (e >> 14) & 1; l = (e >> 15) & 1; b = e >> 16; }
        else { t = e & 255; d = (e >> 8) & 63; h = (e >> 14) & 1; l = (e >> 15) & 1; b = e >> 16; }
        dst[e] = f2bf(src[((((size_t)b * 2 + l) * 256 + t) * 2 + h) * 64 + d]);
      }
    }
  }
}

__device__ __forceinline__ void rpass(const Params& p, int mode, int l) {
  const int tid_ = opq_tid(); const int lane = tid_ & 63, wave = tid_ >> 6;
  const float* MOD = (const float*)(p.ws + WS_MOD);
  const bf16_t* O = (const bf16_t*)(p.ws + WS_DEC);
  float* X = p.out + OUT_X;
  bf16_t* H = (bf16_t*)(p.ws + WS_H);
  const int nwaves = gridDim.x * 4, rpw = (MTOT + nwaves - 1) / nwaves;
  const int gw_ = opq_bid() * 4 + wave;
  const int rbeg = gw_ * rpw, rend = (rbeg + rpw < MTOT) ? rbeg + rpw : MTOT;
  const bool has_next = !(mode == 2 && l == 1);
  const int nl = (mode == 2) ? l + 1 : l;
  float4 vgw[4], vgs[4], vsh[4];
  int ci_cur = -1;
  for (int row = rbeg; row < rend; ++row) {
    const int ci = row < M_CTX ? 0 : 1 + ((row - M_CTX) >> 10);
    if (ci != ci_cur) {
      ci_cur = ci;
      if (mode != 0) {
        const float* gate = MOD + (l * 3 + ci) * 6144 + (mode == 1 ? 2 : 5) * 1024;
        const float* gp = (mode == 1 ? p.norm_mix_post : p.norm_ffn_post) + l * D;
#pragma unroll
        for (int j = 0; j < 4; ++j) {
          const float4 g = *(const float4*)(gate + j * 256 + lane * 4);
          const float4 w = *(const float4*)(gp + j * 256 + lane * 4);
          vgw[j] = make_float4(g.x * w.x, g.y * w.y, g.z * w.z, g.w * w.w);
        }
      }
      if (has_next) {
        const float* gpre = (mode == 1 ? p.norm_ffn_pre : p.norm_mix_pre) + nl * D;
        const float* sc = MOD + (nl * 3 + ci) * 6144 + (mode == 1 ? 4 : 1) * 1024;
        const float* sh = MOD + (nl * 3 + ci) * 6144 + (mode == 1 ? 3 : 0) * 1024;
#pragma unroll
        for (int j = 0; j < 4; ++j) {
          const float4 g = *(const float4*)(gpre + j * 256 + lane * 4);
          const float4 s = *(const float4*)(sc + j * 256 + lane * 4);
          vgs[j] = make_float4(g.x * (1.f + s.x), g.y * (1.f + s.y), g.z * (1.f + s.z), g.w * (1.f + s.w));
          vsh[j] = *(const float4*)(sh + j * 256 + lane * 4);
        }
      }
    }
    const float* xs;
    if (mode == 0 || (mode == 1 && l == 0)) xs = row < M_CTX ? p.x_prompt + (size_t)row * D : p.x_sample + (size_t)(row - M_CTX) * D;
    else xs = X + (size_t)row * D;
    float4 x[4];
#pragma unroll
    for (int j = 0; j < 4; ++j) x[j] = *(const float4*)(xs + j * 256 + lane * 4);
    if (mode != 0) {
      float4 o[4];
      float ss = 0.f;
#pragma unroll
      for (int j = 0; j < 4; ++j) {
        o[j] = cvt4(*(const uint2*)(O + (size_t)row * D + j * 256 + lane * 4));
        ss += o[j].x * o[j].x + o[j].y * o[j].y + o[j].z * o[j].z + o[j].w * o[j].w;
      }
      ss = wave_sum(ss);
      const float rs = __builtin_amdgcn_rsqf(ss * (1.f / D) + 1e-6f);
#pragma unroll
      for (int j = 0; j < 4; ++j) {
        x[j].x += vgw[j].x * (o[j].x * rs);
        x[j].y += vgw[j].y * (o[j].y * rs);
        x[j].z += vgw[j].z * (o[j].z * rs);
        x[j].w += vgw[j].w * (o[j].w * rs);
        *(float4*)(X + (size_t)row * D + j * 256 + lane * 4) = x[j];
      }
    }
    if (!has_next) continue;
    float ss2 = 0.f;
#pragma unroll
    for (int j = 0; j < 4; ++j) ss2 += x[j].x * x[j].x + x[j].y * x[j].y + x[j].z * x[j].z + x[j].w * x[j].w;
    ss2 = wave_sum(ss2);
    const float rs2 = __builtin_amdgcn_rsqf(ss2 * (1.f / D) + 1e-6f);
#pragma unroll
    for (int j = 0; j < 4; ++j) {
      const float h0 = x[j].x * rs2 * vgs[j].x + vsh[j].x;
      const float h1 = x[j].y * rs2 * vgs[j].y + vsh[j].y;
      const float h2 = x[j].z * rs2 * vgs[j].z + vsh[j].z;
      const float h3 = x[j].w * rs2 * vgs[j].w + vsh[j].w;
      uint2 v;
      v.x = pk_bf16(h0, h1);
      v.y = pk_bf16(h2, h3);
      *(uint2*)(H + (size_t)row * D + j * 256 + lane * 4) = v;
    }
  }
}

template <int FN>
__device__ __forceinline__ float xform(float t) {
  if (FN == 1) { const float e = __expf(2.f * t); return 1.f - 2.f * frcp(e + 1.f); }
  if (FN == 2) return sigmoidf_(t);
  return t;
}
__device__ __forceinline__ void epi_f32(const Params& p, f32x4 (&acc)[4][4], int rb, int cb, int lane) {
  const int fr = lane & 15, fq = lane >> 4;
  float* O = (float*)(p.ws + WS_DEC);
#pragma unroll
  for (int m = 0; m < 4; ++m)
#pragma unroll
    for (int n = 0; n < 4; ++n)
#pragma unroll
      for (int j = 0; j < 4; ++j) O[(size_t)(rb + m * 16 + fq * 4 + j) * D + cb + n * 16 + fr] = acc[m][n][j];
}

__device__ __forceinline__ void epi_gu(const Params& p, f32x4 (&acc)[4][4], int rb, int cb, int lane) {
  const int fr = lane & 15, fq = lane >> 4;
  bf16_t* ACT = (bf16_t*)(p.ws + WS_CZ);
  const int chunk = cb >> 6;
#pragma unroll
  for (int m = 0; m < 4; ++m)
#pragma unroll
    for (int n = 0; n < 2; ++n)
#pragma unroll
      for (int j = 0; j < 4; ++j) {
        const float g = acc[m][n][j], u = acc[m][n + 2][j];
        const float a = g * sigmoidf_(g) * u;
        ACT[(size_t)(rb + m * 16 + fq * 4 + j) * FF + chunk * 32 + n * 16 + fr] = f2bf(a);
      }
}

template <int MB>
__device__ __forceinline__ void epi_in(const Params& p, int l, f32x4 (&acc)[MB][4], int rb, int cb, int lane) {
  const int fr = lane & 15, fq = lane >> 4;
  const int cidx = cb >> 6;
  const bool lat = rb >= M_CTX;
  if (cidx >= 36) {
    bf16_t* PA = (bf16_t*)(p.ws + WS_PA);
    const int pc = cb - 2304;
#pragma unroll
    for (int m = 0; m < MB; ++m)
#pragma unroll
      for (int n = 0; n < 4; ++n)
#pragma unroll
        for (int j = 0; j < 4; ++j) {
          float t = acc[m][n][j];
          if (cidx == 36) t = xform<1>(t); else if (cidx >= 38) t = xform<2>(t);
          PA[(size_t)(rb + m * 16 + fq * 4 + j) * 256 + pc + n * 16 + fr] = f2bf(t);
        }
    return;
  }
  if (cidx >= 18) {
    float* CZ = (float*)(p.ws + WS_CZ);
    const int cc = cb - 1152;
#pragma unroll
    for (int m = 0; m < MB; ++m)
#pragma unroll
      for (int n = 0; n < 4; ++n)
#pragma unroll
        for (int j = 0; j < 4; ++j) CZ[(size_t)(rb + m * 16 + fq * 4 + j) * 1408 + cc + n * 16 + fr] = acc[m][n][j];
    return;
  }
  if (cidx >= 8 && cidx < 16) {
    const float* gw = (cidx < 14 ? p.b_q_norm : p.b_k_norm) + l * 64;
    float g[4];
#pragma unroll
    for (int n = 0; n < 4; ++n) g[n] = gw[n * 16 + fr];
#pragma unroll
    for (int m = 0; m < MB; ++m)
#pragma unroll
      for (int j = 0; j < 4; ++j) {
        float ss = 0.f;
#pragma unroll
        for (int n = 0; n < 4; ++n) ss += acc[m][n][j] * acc[m][n][j];
        ss = row16_sum(ss);
        const float rs = __builtin_amdgcn_rsqf(ss * (1.f / 64.f) + 1e-6f);
#pragma unroll
        for (int n = 0; n < 4; ++n) acc[m][n][j] *= rs * g[n];
      }
  }
  const bool isv = (cidx == 6 || cidx == 7 || cidx == 16 || cidx == 17);
  if (lat && !isv) {
    const float2* ROPE = (const float2*)(p.ws + WS_ROPE);
#pragma unroll
    for (int m = 0; m < MB; ++m)
#pragma unroll
      for (int j = 0; j < 4; ++j) {
        const int t = (rb + m * 16 + fq * 4 + j - M_CTX) & 1023;
        const float2 a0 = ROPE[t * 32 + fr], a1 = ROPE[t * 32 + 16 + fr];
        float x1 = acc[m][0][j], x2 = acc[m][2][j];
        acc[m][0][j] = x1 * a0.x - x2 * a0.y;
        acc[m][2][j] = x1 * a0.y + x2 * a0.x;
        x1 = acc[m][1][j]; x2 = acc[m][3][j];
        acc[m][1][j] = x1 * a1.x - x2 * a1.y;
        acc[m][3][j] = x1 * a1.y + x2 * a1.x;
      }
  }
  if (!isv) {
    bf16_t* QK = (bf16_t*)(p.ws + WS_QK);
    const int qc = (cidx < 6) ? cb : cb - 128;
#pragma unroll
    for (int m = 0; m < MB; ++m)
#pragma unroll
      for (int n = 0; n < 4; ++n)
#pragma unroll
        for (int j = 0; j < 4; ++j) QK[(size_t)(rb + m * 16 + fq * 4 + j) * 896 + qc + n * 16 + fr] = f2bf(acc[m][n][j]);
    if (!lat && (cidx == 4 || cidx == 5 || cidx == 14 || cidx == 15)) {
      float* dst = p.out + (cidx < 6 ? OUT_AK : OUT_BK);
      const int h = cidx & 1;
#pragma unroll
      for (int m = 0; m < MB; ++m)
#pragma unroll
        for (int n = 0; n < 4; ++n)
#pragma unroll
          for (int j = 0; j < 4; ++j) {
            const int row = rb + m * 16 + fq * 4 + j, b = row >> 8, t = row & 255;
            dst[((((size_t)b * 2 + l) * 256 + t) * 2 + h) * 64 + n * 16 + fr] = acc[m][n][j];
          }
    }
  } else {
    bf16_t* VT = (bf16_t*)(p.ws + WS_VT);
    const int vh = (cidx < 8) ? cidx - 6 : 2 + cidx - 16;
#pragma unroll
    for (int m = 0; m < MB; ++m)
#pragma unroll
      for (int n = 0; n < 4; ++n) {
        uint2 v;
        v.x = pk_bf16(acc[m][n][0], acc[m][n][1]);
        v.y = pk_bf16(acc[m][n][2], acc[m][n][3]);
        *(uint2*)(VT + ((size_t)(vh * 64 + n * 16 + fr)) * MTOT + rb + m * 16 + fq * 4) = v;
      }
    if (!lat) {
      float* dst = p.out + (cidx < 8 ? OUT_AV : OUT_BV);
      const int h = cidx & 1;
#pragma unroll
      for (int m = 0; m < MB; ++m)
#pragma unroll
        for (int n = 0; n < 4; ++n)
#pragma unroll
          for (int j = 0; j < 4; ++j) {
            const int row = rb + m * 16 + fq * 4 + j, b = row >> 8, t = row & 255;
            dst[((((size_t)b * 2 + l) * 256 + t) * 2 + h) * 64 + n * 16 + fr] = acc[m][n][j];
          }
    }
  }
}

__device__ __forceinline__ void gemm64_tile(const Params& p, int l, const bf16_t* __restrict__ A, int lda,
                                            const bf16_t* __restrict__ Bt, int ldb, int K, int brow, int bcol, unsigned char* smem) {
  const int tid = opq_tid(), lane = tid & 63, wid = tid >> 6, fr = lane & 15, fq = lane >> 4;
  const int sw = (fr >> 1) & 7;
  const int nk = K / 64;
  const int lrow = lane >> 3;
  f32x4 acc[1][4];
#pragma unroll
  for (int n = 0; n < 4; ++n) acc[0][n] = (f32x4){0.f, 0.f, 0.f, 0.f};
  const bf16_t* ga = A + (size_t)(brow + wid * 16 + lrow) * lda;
  const bf16_t* gb = Bt + (size_t)(bcol + wid * 16 + lrow) * ldb;
#define GEMM64_STAGE(bufi, kt_)                                                                                   \
  {                                                                                                               \
    unsigned char* sb_ = smem + (bufi) * 16384 + wid * 2048 + lane * 16;                                          \
    _Pragma("unroll") for (int i_ = 0; i_ < 2; ++i_) {                                                            \
      const int c_ = (lane & 7) ^ (((wid * 16 + i_ * 8 + lrow) >> 1) & 7);                                        \
      __builtin_amdgcn_global_load_lds((const unsigned*)(ga + (size_t)(i_ * 8) * lda + (kt_) * 64 + c_ * 8),      \
                                       (unsigned*)(sb_ + i_ * 1024), 16, 0, 0);                                   \
      __builtin_amdgcn_global_load_lds((const unsigned*)(gb + (size_t)(i_ * 8) * ldb + (kt_) * 64 + c_ * 8),      \
                                       (unsigned*)(sb_ + 8192 + i_ * 1024), 16, 0, 0);                            \
    }                                                                                                             \
  }
  __syncthreads();
  GEMM64_STAGE(0, 0);
  for (int kt = 0; kt < nk; ++kt) {
    asm volatile("s_waitcnt vmcnt(0)" ::: "memory");
    __syncthreads();
    if (kt + 1 < nk) GEMM64_STAGE((kt + 1) & 1, kt + 1);
    const unsigned char* sA = smem + (kt & 1) * 16384;
    const unsigned char* sB = sA + 8192;
#pragma unroll
    for (int s = 0; s < 2; ++s) {
      const int co = ((s * 4 + fq) ^ sw) << 4;
      const bf16x8 a = *(const bf16x8*)(sA + (wid * 16 + fr) * 128 + co);
#pragma unroll
      for (int n = 0; n < 4; ++n) {
        const bf16x8 b = *(const bf16x8*)(sB + (n * 16 + fr) * 128 + co);
        acc[0][n] = mfma16(a, b, acc[0][n]);
      }
    }
  }
  epi_in<1>(p, l, acc, brow + wid * 16, bcol, lane);
}

template <int EPI>
__device__ __forceinline__ void gemm_phase(const Params& p, int l, const bf16_t* __restrict__ A, int lda,
                                           const bf16_t* __restrict__ Bt, int ldb, int N, int K, unsigned char* smem) {
  const int tid = opq_tid(), lane = tid & 63, wid = tid >> 6, wr = wid >> 1, wc = wid & 1, fr = lane & 15, fq = lane >> 4;
  const int bid = opq_bid();
  const int nN = N / 128, ntiles = (MTOT / 128) * nN;
  const int G = gridDim.x, per = G >> 3;
  const int srow = wid * 32 + (lane >> 3);
  const int sw = (fr >> 1) & 7;
  const int nk = K / 64;
  for (int base = 0; base < ntiles; base += G) {
    const int tile = base + (bid & 7) * per + (bid >> 3);
    if (EPI == 0 && base + G > ntiles && (ntiles - base) * 4 <= G) {
      const int sub = tile - base, nsub = (ntiles - base) * 4;
      if (sub < nsub) {
        const int t128 = base + (sub >> 2), q = sub & 3;
        const int patch = t128 >> 5, within = t128 & 31, nPN = nN >> 2;
        const int mt = (patch / nPN) * 8 + (within >> 2), nt = (patch % nPN) * 4 + (within & 3);
        gemm64_tile(p, l, A, lda, Bt, ldb, K, mt * 128 + (q >> 1) * 64, nt * 128 + (q & 1) * 64, smem);
      }
      if (l == 0) {
        const int nidle = G - nsub;
        if (nidle == 0) { for (int it = sub; it < WL_TOTAL; it += G) weight_item(p, 1, it, (float*)smem); }
        else if (sub >= nsub) { for (int it = sub - nsub; it < WL_TOTAL; it += nidle) weight_item(p, 1, it, (float*)smem); }
      }
      continue;
    }
    if (tile >= ntiles) {
      if (EPI == 0 && l == 0) {
        const int nidle = base + G - ntiles;
        for (int it = tile - ntiles; it < WL_TOTAL; it += nidle) weight_item(p, 1, it, (float*)smem);
      }
      continue;
    }
    const int patch = tile >> 5, within = tile & 31, nPN = nN >> 2;
    const int mt = (patch / nPN) * 8 + (within >> 2), nt = (patch % nPN) * 4 + (within & 3);
    const int brow = mt * 128, bcol = nt * 128;
    f32x4 acc[4][4];
#pragma unroll
    for (int m = 0; m < 4; ++m)
#pragma unroll
      for (int n = 0; n < 4; ++n) acc[m][n] = (f32x4){0.f, 0.f, 0.f, 0.f};
    const bf16_t* ga = A + (size_t)(brow + srow) * lda;
    const bf16_t* gb = Bt + (size_t)(bcol + srow) * ldb;
#define GEMM_STAGE(bufi, kt_)                                                                                     \
  {                                                                                                               \
    unsigned char* sa_ = smem + (bufi) * 32768 + wid * 4096 + lane * 16;                                          \
    _Pragma("unroll") for (int i_ = 0; i_ < 4; ++i_) {                                                            \
      const int c_ = (lane & 7) ^ (((srow + i_ * 8) >> 1) & 7);                                                   \
      __builtin_amdgcn_global_load_lds((const unsigned*)(ga + (size_t)(i_ * 8) * lda + (kt_) * 64 + c_ * 8),      \
                                       (unsigned*)(sa_ + i_ * 1024), 16, 0, 0);                                   \
      __builtin_amdgcn_global_load_lds((const unsigned*)(gb + (size_t)(i_ * 8) * ldb + (kt_) * 64 + c_ * 8),      \
                                       (unsigned*)(sa_ + 16384 + i_ * 1024), 16, 0, 0);                           \
    }                                                                                                             \
  }
    __syncthreads();
    GEMM_STAGE(0, 0);
#define GEMM_STAGE1(bufi, kt_, i_)                                                                                \
  {                                                                                                               \
    unsigned char* sa_ = smem + (bufi) * 32768 + wid * 4096 + lane * 16;                                          \
    const int c_ = (lane & 7) ^ (((srow + (i_) * 8) >> 1) & 7);                                                   \
    __builtin_amdgcn_global_load_lds((const unsigned*)(ga + (size_t)((i_) * 8) * lda + (kt_) * 64 + c_ * 8),      \
                                     (unsigned*)(sa_ + (i_) * 1024), 16, 0, 0);                                   \
    __builtin_amdgcn_global_load_lds((const unsigned*)(gb + (size_t)((i_) * 8) * ldb + (kt_) * 64 + c_ * 8),      \
                                     (unsigned*)(sa_ + 16384 + (i_) * 1024), 16, 0, 0);                           \
  }
    for (int kt = 0; kt < nk; ++kt) {
      asm volatile("s_waitcnt vmcnt(0)" ::: "memory");
      __syncthreads();
      const bool more = kt + 1 < nk;
      const unsigned char* sA = smem + (kt & 1) * 32768;
      const unsigned char* sB = sA + 16384;
      bf16x8 a[4], b[4];
      {
        const int co = (fq ^ sw) << 4;
#pragma unroll
        for (int m = 0; m < 4; ++m) a[m] = *(const bf16x8*)(sA + (wr * 64 + m * 16 + fr) * 128 + co);
#pragma unroll
        for (int n = 0; n < 4; ++n) b[n] = *(const bf16x8*)(sB + (wc * 64 + n * 16 + fr) * 128 + co);
      }
      __builtin_amdgcn_sched_barrier(0);
#pragma unroll
      for (int m = 0; m < 4; ++m) {
        if (more) GEMM_STAGE1((kt + 1) & 1, kt + 1, m);
#pragma unroll
        for (int n = 0; n < 4; ++n) acc[m][n] = mfma16(a[m], b[n], acc[m][n]);
        __builtin_amdgcn_sched_barrier(0);
      }
      {
        const int co = ((4 + fq) ^ sw) << 4;
#pragma unroll
        for (int m = 0; m < 4; ++m) a[m] = *(const bf16x8*)(sA + (wr * 64 + m * 16 + fr) * 128 + co);
#pragma unroll
        for (int n = 0; n < 4; ++n) b[n] = *(const bf16x8*)(sB + (wc * 64 + n * 16 + fr) * 128 + co);
      }
#pragma unroll
      for (int m = 0; m < 4; ++m)
#pragma unroll
        for (int n = 0; n < 4; ++n) acc[m][n] = mfma16(a[m], b[n], acc[m][n]);
    }
    const int rb = brow + wr * 64, cb = bcol + wc * 64;
    if constexpr (EPI == 0) epi_in<4>(p, l, acc, rb, cb, lane);
    else if constexpr (EPI == 1) epi_f32(p, acc, rb, cb, lane);
    else epi_gu(p, acc, rb, cb, lane);
  }
}

constexpr int G160_BUF = 36864;
__device__ __forceinline__ void gemm160_phase(const Params& p, const bf16_t* __restrict__ A, int lda,
                                              const bf16_t* __restrict__ Bt, int ldb, int K, unsigned char* smem) {
  const int tid = opq_tid(), lane = tid & 63, wid = tid >> 6, wr = wid >> 1, wc = wid & 1, fr = lane & 15, fq = lane >> 4;
  const int bid = opq_bid();
  constexpr int nN = 8, ntiles = 64 * nN;
  const int G = gridDim.x, per = G >> 3;
  const int sw = (fr >> 1) & 7;
  const int nk = K / 64;
  const int lrow = lane >> 3;
  bf16_t* O = (bf16_t*)(p.ws + WS_DEC);
  for (int base = 0; base < ntiles; base += G) {
    const int tile = base + (bid & 7) * per + (bid >> 3);
    if (tile >= ntiles) continue;
    const int mt = tile / nN, nt = tile % nN;
    const int brow = mt * 160, bcol = nt * 128;
    f32x4 acc[5][4];
#pragma unroll
    for (int m = 0; m < 5; ++m)
#pragma unroll
      for (int n = 0; n < 4; ++n) acc[m][n] = (f32x4){0.f, 0.f, 0.f, 0.f};
    const bf16_t* ga = A + (size_t)(brow + lrow) * lda;
    const bf16_t* gb = Bt + (size_t)(bcol + wid * 32 + lrow) * ldb;
#define GEMM160_STAGE(bufi, kt_)                                                                                  \
  {                                                                                                               \
    unsigned char* sb_ = smem + (bufi) * G160_BUF;                                                                \
    _Pragma("unroll") for (int i_ = 0; i_ < 5; ++i_) {                                                            \
      const int pc_ = wid + i_ * 4;                                                                               \
      const int c_ = (lane & 7) ^ (((pc_ * 8 + lrow) >> 1) & 7);                                                  \
      __builtin_amdgcn_global_load_lds((const unsigned*)(ga + (size_t)(pc_ * 8) * lda + (kt_) * 64 + c_ * 8),     \
                                       (unsigned*)(sb_ + pc_ * 1024 + lane * 16), 16, 0, 0);                      \
    }                                                                                                             \
    _Pragma("unroll") for (int i_ = 0; i_ < 4; ++i_) {                                                            \
      const int c_ = (lane & 7) ^ (((wid * 32 + i_ * 8 + lrow) >> 1) & 7);                                        \
      __builtin_amdgcn_global_load_lds((const unsigned*)(gb + (size_t)(i_ * 8) * ldb + (kt_) * 64 + c_ * 8),      \
                                       (unsigned*)(sb_ + 20480 + wid * 4096 + i_ * 1024 + lane * 16), 16, 0, 0);  \
    }                                                                                                             \
  }
    __syncthreads();
    GEMM160_STAGE(0, 0);
    for (int kt = 0; kt < nk; ++kt) {
      asm volatile("s_waitcnt vmcnt(0)" ::: "memory");
      __syncthreads();
      if (kt + 1 < nk) GEMM160_STAGE((kt + 1) & 1, kt + 1);
      const unsigned char* sA = smem + (kt & 1) * G160_BUF;
      const unsigned char* sB = sA + 20480;
#pragma unroll
      for (int s = 0; s < 2; ++s) {
        bf16x8 a[5], b[4];
        const int co = ((s * 4 + fq) ^ sw) << 4;
#pragma unroll
        for (int m = 0; m < 5; ++m) a[m] = *(const bf16x8*)(sA + (wr * 80 + m * 16 + fr) * 128 + co);
#pragma unroll
        for (int n = 0; n < 4; ++n) b[n] = *(const bf16x8*)(sB + (wc * 64 + n * 16 + fr) * 128 + co);
        __builtin_amdgcn_s_setprio(1);
#pragma unroll
        for (int m = 0; m < 5; ++m)
#pragma unroll
          for (int n = 0; n < 4; ++n) acc[m][n] = mfma16(a[m], b[n], acc[m][n]);
        __builtin_amdgcn_s_setprio(0);
      }
    }
#pragma unroll
    for (int m = 0; m < 5; ++m)
#pragma unroll
      for (int n = 0; n < 4; ++n)
#pragma unroll
        for (int j = 0; j < 4; ++j)
          O[(size_t)(brow + wr * 80 + m * 16 + fq * 4 + j) * D + bcol + wc * 64 + n * 16 + fr] = f2bf(acc[m][n][j]);
  }
}

template <int FN>
__device__ __forceinline__ bf16x8 ld_frag_f32(const float* src) {
  const float4 u = *(const float4*)src, v = *(const float4*)(src + 4);
  union { uint4 u4; bf16x8 v8; } r;
  r.u4.x = pk_bf16(xform<FN>(u.x), xform<FN>(u.y));
  r.u4.y = pk_bf16(xform<FN>(u.z), xform<FN>(u.w));
  r.u4.z = pk_bf16(xform<FN>(v.x), xform<FN>(v.y));
  r.u4.w = pk_bf16(xform<FN>(v.z), xform<FN>(v.w));
  return r.v8;
}

__device__ __forceinline__ void prep_phase(const Params& p, int l, unsigned char* smem) {
  const int tid = opq_tid(), lane = tid & 63, wid = tid >> 6, fr = lane & 15, fq = lane >> 4;
  const float* CZ = (const float*)(p.ws + WS_CZ);
  float* DEC = (float*)(p.ws + WS_DEC);
  bf16_t* KT = (bf16_t*)(p.ws + WS_KT);
  bf16_t* BB = (bf16_t*)(p.ws + WS_BB);
  bf16_t* KK = (bf16_t*)(p.ws + WS_KK);
  bf16_t* Gb = (bf16_t*)(p.ws + WS_G);
  float* BON = (float*)(p.ws + WS_BON);
  const bf16_t* WUPT = (const bf16_t*)(p.ws + WS_WUPT);
  const bf16_t* AUPT = (const bf16_t*)(p.ws + WS_AUPT);
  const bf16_t* GUPT = (const bf16_t*)(p.ws + WS_GUPT);
  const bf16_t* PA = (const bf16_t*)(p.ws + WS_PA);
  const int swz = (fr >> 1) & 7;
  for (int u = opq_bid(); u < 80 * 6; u += gridDim.x) {
    const int tile = u / 6, h = u % 6;
    __syncthreads();
    {
      uint4 tw_[4], tg_[4];
#pragma unroll
      for (int i = 0; i < 4; ++i) {
        const bf16_t* src = (i < 2 ? WUPT : AUPT) + ((unsigned)(l * 2 + (i & 1)) * 384 + h * 64) * 64;
        const int pc0 = tid, pc1 = tid + 256;
        const uint4 v0 = *(const uint4*)(src + (pc0 >> 3) * 64 + (pc0 & 7) * 8);
        const uint4 v1 = *(const uint4*)(src + (pc1 >> 3) * 64 + (pc1 & 7) * 8);
        tw_[i] = v0; tg_[i] = v1;
      }
#pragma unroll
      for (int i = 0; i < 4; ++i) {
        const int pc0 = tid, pc1 = tid + 256;
        *(uint4*)(smem + i * 8192 + (pc0 >> 3) * 128 + (((pc0 & 7) ^ (((pc0 >> 3) >> 1) & 7)) << 4)) = tw_[i];
        *(uint4*)(smem + i * 8192 + (pc1 >> 3) * 128 + (((pc1 & 7) ^ (((pc1 >> 3) >> 1) & 7)) << 4)) = tg_[i];
      }
#pragma unroll
      for (int i = 0; i < 4; ++i) {
        const int pc = tid + i * 256, col = pc >> 4, chn = pc & 15;
        const uint4 v = *(const uint4*)(GUPT + ((unsigned)l * 384 + h * 64 + col) * 128 + chn * 8);
        *(uint4*)(smem + 32768 + col * 256 + ((chn ^ (col & 15)) << 4)) = v;
      }
    }
    __syncthreads();
#pragma unroll
    for (int mb = 0; mb < 2; ++mb) {
      const int rb = tile * 128 + wid * 32 + mb * 16;
      const int arow = rb + fr;
      bf16x8 ftw[2], fxa[2];
#pragma unroll
      for (int ks = 0; ks < 2; ++ks) {
        ftw[ks] = *(const bf16x8*)(PA + (unsigned)arow * 256 + ks * 32 + fq * 8);
        fxa[ks] = *(const bf16x8*)(PA + (unsigned)arow * 256 + 64 + ks * 32 + fq * 8);
      }
      float kv[4][4], rv[4][4], kkn[4][4], bon[4];
      float kkw[4], kaw[4], rkw[4];
#pragma unroll
      for (int n = 0; n < 4; ++n) {
        kkw[n] = p.c_k_k[l * 384 + h * 64 + n * 16 + fr];
        kaw[n] = p.c_k_a[l * 384 + h * 64 + n * 16 + fr];
        rkw[n] = p.c_r_k[l * 384 + h * 64 + n * 16 + fr];
      }
#pragma unroll
      for (int j = 0; j < 4; ++j) {
        const int row = rb + fq * 4 + j;
        float ss = 0.f;
#pragma unroll
        for (int n = 0; n < 4; ++n) {
          kv[n][j] = CZ[(unsigned)row * 1408 + 384 + h * 64 + n * 16 + fr];
          rv[n][j] = CZ[(unsigned)row * 1408 + h * 64 + n * 16 + fr];
          kkn[n][j] = kv[n][j] * kkw[n];
          ss += kkn[n][j] * kkn[n][j];
        }
        ss = row16_sum(ss);
        const float rs = __builtin_amdgcn_rsqf(ss + 1e-12f);
#pragma unroll
        for (int n = 0; n < 4; ++n) {
          kkn[n][j] *= rs;
          KK[(unsigned)row * 384 + h * 64 + n * 16 + fr] = f2bf(kkn[n][j]);
        }
        bon[j] = 0.f;
      }
#pragma unroll
      for (int d = 0; d < 2; ++d) {
        f32x4 aw[4], aa[4];
#pragma unroll
        for (int n = 0; n < 4; ++n) {
          aw[n] = (f32x4){0.f, 0.f, 0.f, 0.f};
          aa[n] = (f32x4){0.f, 0.f, 0.f, 0.f};
          const int col = h * 64 + n * 16 + fr;
#pragma unroll
          for (int ks = 0; ks < 2; ++ks) {
            const bf16x8 bw = *(const bf16x8*)(smem + d * 8192 + (n * 16 + fr) * 128 + (((ks * 4 + fq) ^ swz) << 4));
            const bf16x8 ba = *(const bf16x8*)(smem + 16384 + d * 8192 + (n * 16 + fr) * 128 + (((ks * 4 + fq) ^ swz) << 4));
            aw[n] = mfma16(ftw[ks], bw, aw[n]);
            aa[n] = mfma16(fxa[ks], ba, aa[n]);
          }
        }
#pragma unroll
        for (int n = 0; n < 4; ++n) {
          const int col = h * 64 + n * 16 + fr;
          const float w0 = p.c_w0[(l * 2 + d) * 384 + col], a0 = p.c_a0[(l * 2 + d) * 384 + col];
#pragma unroll
          for (int j = 0; j < 4; ++j) {
            const int row = rb + fq * 4 + j;
            const float dec = __expf(-0.6065306597126334f * sigmoidf_(aw[n][j] + w0));
            const float a = sigmoidf_(aa[n][j] + a0);
            const float kt = kv[n][j] * (1.f + (a - 1.f) * kaw[n]);
            DEC[((unsigned)d * MTOT + row) * 384 + col] = dec;
            KT[((unsigned)d * MTOT + row) * 384 + col] = f2bf(kt);
            BB[((unsigned)d * MTOT + row) * 384 + col] = f2bf(kkn[n][j] * a);
            bon[j] += rv[n][j] * kt * rkw[n];
          }
        }
      }
#pragma unroll
      for (int j = 0; j < 4; ++j) {
        const float b = row16_sum(bon[j]);
        if (fr == 0) BON[(unsigned)(rb + fq * 4 + j) * 8 + h] = b;
      }
      f32x4 ag[4];
#pragma unroll
      for (int n = 0; n < 4; ++n) ag[n] = (f32x4){0.f, 0.f, 0.f, 0.f};
#pragma unroll
      for (int ks = 0; ks < 4; ++ks) {
        const bf16x8 fa = *(const bf16x8*)(PA + (unsigned)arow * 256 + 128 + ks * 32 + fq * 8);
#pragma unroll
        for (int n = 0; n < 4; ++n) {
          const int col = h * 64 + n * 16 + fr;
          const bf16x8 bg = *(const bf16x8*)(smem + 32768 + (n * 16 + fr) * 256 + (((ks * 4 + fq) ^ fr) << 4));
          ag[n] = mfma16(fa, bg, ag[n]);
        }
      }
#pragma unroll
      for (int n = 0; n < 4; ++n)
#pragma unroll
        for (int j = 0; j < 4; ++j) Gb[(unsigned)(rb + fq * 4 + j) * 384 + h * 64 + n * 16 + fr] = f2bf(ag[n][j]);
    }
  }
}


typedef float f32x2 __attribute__((ext_vector_type(2)));
__device__ __forceinline__ f32x2 fma2(f32x2 a, f32x2 b, f32x2 c) { return __builtin_elementwise_fma(a, b, c); }

struct ScanSrc { const float* DEC; const bf16_t* KT; const bf16_t* BB; const bf16_t* KK; const float* CZ; int row0, T, d, hoff, ls, lc; };
#define SCAN_DECL(P) float4 P##w, P##r, P##v; uint2 P##kt, P##kk, P##b;
#define SCAN_GLOAD(P, chunk)                                                         \
  {                                                                                  \
    int t_ = (chunk) * 16 + sc.ls;                                                   \
    if (sc.d) t_ = sc.T - 1 - t_;                                                    \
    const unsigned row_ = (unsigned)(sc.row0 + t_);                                  \
    P##w = *(const float4*)(sc.DEC + row_ * 384u + sc.hoff + sc.lc);                 \
    P##kt = *(const uint2*)(sc.KT + row_ * 384u + sc.hoff + sc.lc);                  \
    P##kk = *(const uint2*)(sc.KK + row_ * 384u + sc.hoff + sc.lc);                  \
    P##b = *(const uint2*)(sc.BB + row_ * 384u + sc.hoff + sc.lc);                   \
    P##r = *(const float4*)(sc.CZ + row_ * 1408u + sc.hoff + sc.lc);                 \
    P##v = *(const float4*)(sc.CZ + row_ * 1408u + 768 + sc.hoff + sc.lc);           \
  }
#define SCAN_LSTORE(P, b_)                                                           \
  {                                                                                  \
    float* dst_ = buf + (((b_) * 16 + sc.ls) * 6) * 64 + sc.lc;                      \
    const float4 kk_ = cvt4(P##kk);                                                  \
    *(float4*)(dst_) = P##w;                                                         \
    *(float4*)(dst_ + 64) = cvt4(P##kt);                                             \
    *(float4*)(dst_ + 128) = make_float4(-kk_.x, -kk_.y, -kk_.z, -kk_.w);           \
    *(float4*)(dst_ + 192) = cvt4(P##b);                                             \
    *(float4*)(dst_ + 256) = P##r;                                                   \
    *(float4*)(dst_ + 320) = P##v;                                                   \
  }

template <int R>
__device__ __forceinline__ void scan_chunk(f32x2 (&S)[R][2], const float* cbuf, int k0, int v0, int kq,
                                           bf16_t* Yhv, int row0, int T, int d, int ch) {
  const float* sb = cbuf + k0;
  const float* vb = cbuf + 320 + v0;
  float ykeep[R];
#pragma unroll
  for (int j = 0; j < R; ++j) ykeep[j] = 0.f;
  f32x4 cw, ckt, ca, cbv, cr;
  float cvv[R];
  cw = *(const f32x4*)(sb);
  ckt = *(const f32x4*)(sb + 64);
  ca = *(const f32x4*)(sb + 128);
  cbv = *(const f32x4*)(sb + 192);
  cr = *(const f32x4*)(sb + 256);
  if constexpr (R == 4) { const f32x4 t = *(const f32x4*)vb; cvv[0] = t.x; cvv[1] = t.y; cvv[2] = t.z; cvv[3] = t.w; }
  else {
#pragma unroll
    for (int j = 0; j < R; ++j) cvv[j] = vb[j];
  }
#pragma unroll
  for (int s = 0; s < 16; ++s) {
    f32x4 nw, nkt, na, nbv, nr;
    float nvv[R];
    if (s < 15) {
      nw = *(const f32x4*)(sb + (s + 1) * 384);
      nkt = *(const f32x4*)(sb + (s + 1) * 384 + 64);
      na = *(const f32x4*)(sb + (s + 1) * 384 + 128);
      nbv = *(const f32x4*)(sb + (s + 1) * 384 + 192);
      nr = *(const f32x4*)(sb + (s + 1) * 384 + 256);
      if constexpr (R == 4) { const f32x4 t = *(const f32x4*)(vb + (s + 1) * 384); nvv[0] = t.x; nvv[1] = t.y; nvv[2] = t.z; nvv[3] = t.w; }
      else {
#pragma unroll
        for (int j = 0; j < R; ++j) nvv[j] = vb[(s + 1) * 384 + j];
      }
    }
#pragma unroll
    for (int j = 0; j < R; ++j) {
      f32x2 acc = S[j][0] * ca.xy;
      acc = fma2(S[j][1], ca.zw, acc);
      float sa = acc.x + acc.y;
      sa += dppf<DPP_XOR1>(sa);
      sa += dppf<DPP_XOR2>(sa);
      sa += dppf<DPP_ROR4>(sa);
      sa += dppf<DPP_ROR8>(sa);
      const f32x2 sa2 = {sa, sa}, vv2 = {cvv[j], cvv[j]};
      S[j][0] = fma2(S[j][0], cw.xy, fma2(sa2, cbv.xy, vv2 * ckt.xy));
      S[j][1] = fma2(S[j][1], cw.zw, fma2(sa2, cbv.zw, vv2 * ckt.zw));
      f32x2 yacc = S[j][0] * cr.xy;
      yacc = fma2(S[j][1], cr.zw, yacc);
      float y = yacc.x + yacc.y;
      y += dppf<DPP_XOR1>(y);
      y += dppf<DPP_XOR2>(y);
      y += dppf<DPP_ROR4>(y);
      y += dppf<DPP_ROR8>(y);
      ykeep[j] = (kq == s) ? y : ykeep[j];
    }
    if (s < 15) {
      cw = nw; ckt = nkt; ca = na; cbv = nbv; cr = nr;
#pragma unroll
      for (int j = 0; j < R; ++j) cvv[j] = nvv[j];
    }
  }
  int t = ch * 16 + kq;
  if (d) t = T - 1 - t;
#pragma unroll
  for (int j = 0; j < R; ++j) Yhv[(unsigned)(row0 + t) * 384u + j] = f2bf(ykeep[j]);
}

constexpr int DPP_HMIRROR = 0x141;
__device__ __forceinline__ void scan_chunk8(f32x2 (&S)[2][4], const float* cbuf, int k0, int v0, int kq,
                                            bf16_t* Yhv, int row0, int T, int d, int ch) {
  const float* sb = cbuf + k0;
  const float* vb = cbuf + 320 + v0;
  float ykeep[2][2];
#pragma unroll
  for (int j = 0; j < 2; ++j) { ykeep[j][0] = 0.f; ykeep[j][1] = 0.f; }
  f32x4 cw[2], ckt[2], ca[2], cbv[2], cr[2];
  f32x2 cvv;
#pragma unroll
  for (int q = 0; q < 2; ++q) {
    cw[q] = *(const f32x4*)(sb + q * 4);
    ckt[q] = *(const f32x4*)(sb + 64 + q * 4);
    ca[q] = *(const f32x4*)(sb + 128 + q * 4);
    cbv[q] = *(const f32x4*)(sb + 192 + q * 4);
    cr[q] = *(const f32x4*)(sb + 256 + q * 4);
  }
  cvv = *(const f32x2*)vb;
#pragma unroll
  for (int s = 0; s < 16; ++s) {
    f32x4 nw[2], nkt[2], na[2], nbv[2], nr[2];
    f32x2 nvv = {0.f, 0.f};
    if (s < 15) {
#pragma unroll
      for (int q = 0; q < 2; ++q) {
        nw[q] = *(const f32x4*)(sb + (s + 1) * 384 + q * 4);
        nkt[q] = *(const f32x4*)(sb + (s + 1) * 384 + 64 + q * 4);
        na[q] = *(const f32x4*)(sb + (s + 1) * 384 + 128 + q * 4);
        nbv[q] = *(const f32x4*)(sb + (s + 1) * 384 + 192 + q * 4);
        nr[q] = *(const f32x4*)(sb + (s + 1) * 384 + 256 + q * 4);
      }
      nvv = *(const f32x2*)(vb + (s + 1) * 384);
    }
#pragma unroll
    for (int j = 0; j < 2; ++j) {
      f32x2 acc = S[j][0] * ca[0].xy;
      acc = fma2(S[j][1], ca[0].zw, acc);
      acc = fma2(S[j][2], ca[1].xy, acc);
      acc = fma2(S[j][3], ca[1].zw, acc);
      float sa = acc.x + acc.y;
      sa += dppf<DPP_XOR1>(sa);
      sa += dppf<DPP_XOR2>(sa);
      sa += dppf<DPP_HMIRROR>(sa);
      const float vj = j ? cvv.y : cvv.x;
      const f32x2 sa2 = {sa, sa}, vv2 = {vj, vj};
      S[j][0] = fma2(S[j][0], cw[0].xy, fma2(sa2, cbv[0].xy, vv2 * ckt[0].xy));
      S[j][1] = fma2(S[j][1], cw[0].zw, fma2(sa2, cbv[0].zw, vv2 * ckt[0].zw));
      S[j][2] = fma2(S[j][2], cw[1].xy, fma2(sa2, cbv[1].xy, vv2 * ckt[1].xy));
      S[j][3] = fma2(S[j][3], cw[1].zw, fma2(sa2, cbv[1].zw, vv2 * ckt[1].zw));
      f32x2 yacc = S[j][0] * cr[0].xy;
      yacc = fma2(S[j][1], cr[0].zw, yacc);
      yacc = fma2(S[j][2], cr[1].xy, yacc);
      yacc = fma2(S[j][3], cr[1].zw, yacc);
      float y = yacc.x + yacc.y;
      y += dppf<DPP_XOR1>(y);
      y += dppf<DPP_XOR2>(y);
      y += dppf<DPP_HMIRROR>(y);
      ykeep[j][s >> 3] = (kq == (s & 7)) ? y : ykeep[j][s >> 3];
    }
    if (s < 15) {
#pragma unroll
      for (int q = 0; q < 2; ++q) { cw[q] = nw[q]; ckt[q] = nkt[q]; ca[q] = na[q]; cbv[q] = nbv[q]; cr[q] = nr[q]; }
      cvv = nvv;
    }
  }
#pragma unroll
  for (int hs = 0; hs < 2; ++hs) {
    int t = ch * 16 + hs * 8 + kq;
    if (d) t = T - 1 - t;
#pragma unroll
    for (int j = 0; j < 2; ++j) Yhv[(unsigned)(row0 + t) * 384u + j] = f2bf(ykeep[j][hs]);
  }
}

__device__ __forceinline__ void scan_unit8(const Params& p, int l, int row0, int T, int h, int d, float* fin, unsigned char* smem) {
  const int tid = opq_tid();
  const int v0 = (tid >> 3) * 2, kq = tid & 7, k0 = kq * 8;
  f32x2 S[2][4];
#pragma unroll
  for (int j = 0; j < 2; ++j)
#pragma unroll
    for (int i = 0; i < 4; ++i) S[j][i] = (f32x2){0.f, 0.f};
  float* buf = (float*)smem;
  ScanSrc sc;
  sc.DEC = (const float*)(p.ws + WS_DEC) + (size_t)d * MTOT * 384;
  sc.KT = (const bf16_t*)(p.ws + WS_KT) + (size_t)d * MTOT * 384;
  sc.BB = (const bf16_t*)(p.ws + WS_BB) + (size_t)d * MTOT * 384;
  sc.KK = (const bf16_t*)(p.ws + WS_KK);
  sc.CZ = (const float*)(p.ws + WS_CZ);
  sc.row0 = row0; sc.T = T; sc.d = d; sc.hoff = h * 64; sc.ls = tid >> 4; sc.lc = (tid & 15) * 4;
  bf16_t* Yhv = (bf16_t*)(p.ws + WS_Y) + (size_t)d * MTOT * 384 + h * 64 + v0;
  const int nch = T / 16;
  float* buf0 = buf;
  float* buf1 = buf + 16 * 384;
  __syncthreads();
  SCAN_DECL(A)
  SCAN_GLOAD(A, 0);
  SCAN_LSTORE(A, 0);
  __syncthreads();
  for (int ch = 0; ch < nch; ++ch) {
    if (ch + 1 < nch) SCAN_GLOAD(A, ch + 1);
    scan_chunk8(S, (ch & 1) ? buf1 : buf0, k0, v0, kq, Yhv, row0, T, d, ch);
    if (ch + 1 < nch) SCAN_LSTORE(A, (ch + 1) & 1);
    __syncthreads();
  }
#pragma unroll
  for (int j = 0; j < 2; ++j) {
    float4 t0, t1;
    t0.x = S[j][0].x; t0.y = S[j][0].y; t0.z = S[j][1].x; t0.w = S[j][1].y;
    t1.x = S[j][2].x; t1.y = S[j][2].y; t1.z = S[j][3].x; t1.w = S[j][3].y;
    *(float4*)(fin + (v0 + j) * 64 + k0) = t0;
    *(float4*)(fin + (v0 + j) * 64 + k0 + 4) = t1;
  }
}

template <int R>
__device__ __forceinline__ void scan_unit(const Params& p, int l, int row0, int T, int h, int d, int vbase,
                                          const float* init, float* fin, unsigned char* smem) {
  const int tid = opq_tid();
  const int v0 = vbase + (tid >> 4) * R, kq = tid & 15, k0 = kq * 4;
  f32x2 S[R][2];
#pragma unroll
  for (int j = 0; j < R; ++j) {
    if (init) {
      const float4 t = *(const float4*)(init + (v0 + j) * 64 + k0);
      S[j][0].x = t.x; S[j][0].y = t.y; S[j][1].x = t.z; S[j][1].y = t.w;
    } else {
      S[j][0] = (f32x2){0.f, 0.f}; S[j][1] = (f32x2){0.f, 0.f};
    }
  }
  float* buf = (float*)smem;
  ScanSrc sc;
  sc.DEC = (const float*)(p.ws + WS_DEC) + (size_t)d * MTOT * 384;
  sc.KT = (const bf16_t*)(p.ws + WS_KT) + (size_t)d * MTOT * 384;
  sc.BB = (const bf16_t*)(p.ws + WS_BB) + (size_t)d * MTOT * 384;
  sc.KK = (const bf16_t*)(p.ws + WS_KK);
  sc.CZ = (const float*)(p.ws + WS_CZ);
  sc.row0 = row0; sc.T = T; sc.d = d; sc.hoff = h * 64; sc.ls = tid >> 4; sc.lc = (tid & 15) * 4;
  bf16_t* Yhv = (bf16_t*)(p.ws + WS_Y) + (size_t)d * MTOT * 384 + h * 64 + v0;
  const int nch = T / 16;
  float* buf0 = buf;
  float* buf1 = buf + 16 * 384;
  __syncthreads();
  if constexpr (R == 1) {
    __builtin_amdgcn_s_setprio(3);
    SCAN_DECL(A) SCAN_DECL(B) SCAN_DECL(C) SCAN_DECL(Dd)
    SCAN_GLOAD(A, 0);
    SCAN_LSTORE(A, 0);
    SCAN_GLOAD(A, 1);
    SCAN_GLOAD(B, 2);
    SCAN_GLOAD(C, 3);
    __syncthreads();
    for (int ch = 0; ch < nch; ch += 4) {
      if (ch + 4 < nch) SCAN_GLOAD(Dd, ch + 4);
      scan_chunk<R>(S, buf0, k0, v0, kq, Yhv, row0, T, d, ch);
      SCAN_LSTORE(A, 1);
      __syncthreads();
      if (ch + 5 < nch) SCAN_GLOAD(A, ch + 5);
      scan_chunk<R>(S, buf1, k0, v0, kq, Yhv, row0, T, d, ch + 1);
      SCAN_LSTORE(B, 0);
      __syncthreads();
      if (ch + 6 < nch) SCAN_GLOAD(B, ch + 6);
      scan_chunk<R>(S, buf0, k0, v0, kq, Yhv, row0, T, d, ch + 2);
      SCAN_LSTORE(C, 1);
      __syncthreads();
      if (ch + 7 < nch) SCAN_GLOAD(C, ch + 7);
      scan_chunk<R>(S, buf1, k0, v0, kq, Yhv, row0, T, d, ch + 3);
      if (ch + 4 < nch) SCAN_LSTORE(Dd, 0);
      __syncthreads();
    }
    __builtin_amdgcn_s_setprio(0);
  } else {
    SCAN_DECL(A)
    SCAN_GLOAD(A, 0);
    SCAN_LSTORE(A, 0);
    __syncthreads();
    for (int ch = 0; ch < nch; ++ch) {
      if (ch + 1 < nch) SCAN_GLOAD(A, ch + 1);
      scan_chunk<R>(S, (ch & 1) ? buf1 : buf0, k0, v0, kq, Yhv, row0, T, d, ch);
      if (ch + 1 < nch) SCAN_LSTORE(A, (ch + 1) & 1);
      __syncthreads();
    }
  }
  if (fin) {
#pragma unroll
    for (int j = 0; j < R; ++j) {
      float4 t;
      t.x = S[j][0].x; t.y = S[j][0].y; t.z = S[j][1].x; t.w = S[j][1].y;
      *(float4*)(fin + (v0 + j) * 64 + k0) = t;
    }
  }
}

struct AttnDesc {
  const bf16_t* q;
  const bf16_t* kloc;
  const bf16_t* vloc;
  const bf16_t* kctx;
  const bf16_t* vctx;
  bf16_t* o;
  int qpos0;
  int lo, hi;
  int window;
  float sink; int has_sink;
};

__device__ __forceinline__ void attn_unit(const AttnDesc& a, unsigned char* smem) {
  const int tid = opq_tid(), lane = tid & 63, wid = tid >> 6, fr = lane & 15, fq = lane >> 4;
  unsigned char* sK = smem;
  unsigned char* sV = smem + 8192;
  bf16x8 qf[2];
  {
    const bf16_t* qp = a.q + (size_t)(wid * 16 + fr) * 896 + fq * 8;
    qf[0] = *(const bf16x8*)(qp);
    qf[1] = *(const bf16x8*)(qp + 32);
  }
  f32x4 o[4];
#pragma unroll
  for (int i = 0; i < 4; ++i) o[i] = (f32x4){0.f, 0.f, 0.f, 0.f};
  float mrun = -1e30f, lsum = 0.f;
  const int nctx = a.kctx ? 4 : 0;
  const int ntl = nctx + (a.hi - a.lo + 1);
  const int sw = (fr >> 1) & 7;
  const int qpos = a.qpos0 + wid * 16 + fr;
  const int r0_ = tid >> 3, chn = tid & 7, r1_ = r0_ + 32;
  const int rho0 = (r0_ & 32) | (((r0_ >> 2) & 1) << 4) | (((r0_ >> 3) & 3) << 2) | (r0_ & 3);
  const int rho1 = rho0 + 32;
  uint4 rk0, rk1, rv0, rv1;
#define ATTN_TLOAD(it_)                                                                          \
  {                                                                                              \
    const bool ic_ = (it_) < nctx;                                                               \
    const int kt_ = ic_ ? (it_) : a.lo + ((it_) - nctx);                                         \
    const bf16_t* kb_ = ic_ ? a.kctx + (size_t)kt_ * 64 * 64 : a.kloc + (size_t)kt_ * 64 * 896;  \
    const int kstr_ = ic_ ? 64 : 896;                                                            \
    const bf16_t* vb_ = ic_ ? a.vctx + kt_ * 64 : a.vloc + kt_ * 64;                             \
    const int vstr_ = ic_ ? 256 : MTOT;                                                          \
    rk0 = *(const uint4*)(kb_ + (size_t)r0_ * kstr_ + chn * 8);                                  \
    rk1 = *(const uint4*)(kb_ + (size_t)r1_ * kstr_ + chn * 8);                                  \
    rv0 = *(const uint4*)(vb_ + (size_t)r0_ * vstr_ + chn * 8);                                  \
    rv1 = *(const uint4*)(vb_ + (size_t)r1_ * vstr_ + chn * 8);                                  \
  }
  ATTN_TLOAD(0);
  for (int it = 0; it < ntl; ++it) {
    const bool isctx = it < nctx;
    const int kt = isctx ? it : a.lo + (it - nctx);
    __syncthreads();
    *(uint4*)(sK + rho0 * 128 + ((chn ^ ((rho0 >> 1) & 7)) << 4)) = rk0;
    *(uint4*)(sK + rho1 * 128 + ((chn ^ ((rho1 >> 1) & 7)) << 4)) = rk1;
    *(uint4*)(sV + r0_ * 128 + ((chn ^ ((r0_ >> 1) & 7)) << 4)) = rv0;
    *(uint4*)(sV + r1_ * 128 + ((chn ^ ((r1_ >> 1) & 7)) << 4)) = rv1;
    __syncthreads();
    if (it + 1 < ntl) ATTN_TLOAD(it + 1);
    f32x4 st[4];
#pragma unroll
    for (int kb4 = 0; kb4 < 4; ++kb4) {
      st[kb4] = (f32x4){0.f, 0.f, 0.f, 0.f};
#pragma unroll
      for (int ks = 0; ks < 2; ++ks) {
        const bf16x8 af = *(const bf16x8*)(sK + (kb4 * 16 + fr) * 128 + (((ks * 4 + fq) ^ sw) << 4));
        st[kb4] = mfma16(af, qf[ks], st[kb4]);
      }
    }
    float mt = -1e30f;
#pragma unroll
    for (int kb4 = 0; kb4 < 4; ++kb4)
#pragma unroll
      for (int jj = 0; jj < 4; ++jj) {
        float s = st[kb4][jj] * 0.125f;
        if (a.window && !isctx) {
          const int key = (kb4 >> 1) * 32 + fq * 8 + (kb4 & 1) * 4 + jj;
          const int dlt = kt * 64 + key - qpos;
          if (dlt > 128 || dlt < -128) s = -1e30f;
        }
        st[kb4][jj] = s;
        mt = fmaxf(mt, s);
      }
    mt = fmaxf(mt, __shfl_xor(mt, 16));
    mt = fmaxf(mt, __shfl_xor(mt, 32));
    const float mnew = fmaxf(mrun, mt);
    const float alpha = __expf(mrun - mnew);
    mrun = mnew;
    float ps = 0.f;
#pragma unroll
    for (int kb4 = 0; kb4 < 4; ++kb4)
#pragma unroll
      for (int jj = 0; jj < 4; ++jj) {
        const float pv = __expf(st[kb4][jj] - mnew);
        st[kb4][jj] = pv;
        ps += pv;
      }
    lsum = lsum * alpha + ps;
#pragma unroll
    for (int i = 0; i < 4; ++i) o[i] *= alpha;
    bf16x8 pb[2];
#pragma unroll
    for (int kg = 0; kg < 2; ++kg) {
      union { uint4 u4; bf16x8 v8; } r;
      r.u4.x = pk_bf16(st[2 * kg][0], st[2 * kg][1]);
      r.u4.y = pk_bf16(st[2 * kg][2], st[2 * kg][3]);
      r.u4.z = pk_bf16(st[2 * kg + 1][0], st[2 * kg + 1][1]);
      r.u4.w = pk_bf16(st[2 * kg + 1][2], st[2 * kg + 1][3]);
      pb[kg] = r.v8;
    }
#pragma unroll
    for (int db = 0; db < 4; ++db)
#pragma unroll
      for (int kg = 0; kg < 2; ++kg) {
        const bf16x8 vf = *(const bf16x8*)(sV + (db * 16 + fr) * 128 + (((kg * 4 + fq) ^ sw) << 4));
        o[db] = mfma16(vf, pb[kg], o[db]);
      }
  }
  lsum += __shfl_xor(lsum, 16);
  lsum += __shfl_xor(lsum, 32);
  if (a.has_sink) lsum += __expf(a.sink - mrun);
  const float inv = frcp(lsum);
  bf16_t* op = a.o + (size_t)(wid * 16 + fr) * 1024 + fq * 4;
#pragma unroll
  for (int db = 0; db < 4; ++db) {
    uint2 v;
    v.x = pk_bf16(o[db][0] * inv, o[db][1] * inv);
    v.y = pk_bf16(o[db][2] * inv, o[db][3] * inv);
    *(uint2*)(op + db * 16) = v;
  }
}

constexpr int U_LSCAN = 96, U_CSCAN = 384, U_LATB = 192, U_LATA = 128, U_CTX = 1280;
constexpr int U_TOTAL = U_LSCAN + U_CSCAN + U_LATB + U_LATA + U_CTX;

__device__ __forceinline__ void mix_phase(const Params& p, int slot, int l, unsigned char* smem, int ulo = 0, int uhi = U_TOTAL) {
  unsigned* cnt = (unsigned*)(p.ws + WS_CNT) + slot * 8;
  int* s_u = (int*)(smem + SMEM_CTL);
  const bf16_t* QK = (const bf16_t*)(p.ws + WS_QK);
  const bf16_t* VT = (const bf16_t*)(p.ws + WS_VT);
  bf16_t* MIX = (bf16_t*)(p.ws + WS_H);
  for (;;) {
    __syncthreads();
    if (opq_tid() == 0) *s_u = (int)atomicAdd(cnt, 1u);
    __syncthreads();
    int u = *s_u + ulo;
    if (u >= uhi) break;
    if (u < U_LSCAN) {
      const int chain = u >> 2, part = u & 3;
      const int b = chain / 12, h = (chain % 12) >> 1, d = chain & 1;
      const float* init = p.state_c + ((((size_t)b * 2 + l) * 2 + d) * 6 + h) * 4096;
      scan_unit<1>(p, l, M_CTX + b * 1024, 1024, h, d, part * 16, init, nullptr, smem);
      continue;
    }
    u -= U_LSCAN;
    if (u < U_CSCAN) {
      const int b = u / 12, h = (u % 12) >> 1, d = u & 1;
      float* fin = p.out + OUT_ST + ((((size_t)b * 2 + l) * 2 + d) * 6 + h) * 4096;
      scan_unit8(p, l, b * 256, 256, h, d, fin, smem);
      continue;
    }
    u -= U_CSCAN;
    AttnDesc a;
    if (u < U_LATB) {
      const int b = u / 96, h = (u % 96) >> 4, qb = u & 15, kvh = h / 3;
      const int r0 = M_CTX + b * 1024;
      a.q = QK + (size_t)(r0 + qb * 64) * 896 + 384 + h * 64;
      a.kloc = QK + (size_t)r0 * 896 + 768 + kvh * 64;
      a.vloc = VT + (size_t)((2 + kvh) * 64) * MTOT + r0;
      a.kctx = (const bf16_t*)(p.ws + WS_CKB) + (size_t)((b * 2 + l) * 2 + kvh) * 16384;
      a.vctx = (const bf16_t*)(p.ws + WS_CVTB) + (size_t)((b * 2 + l) * 2 + kvh) * 16384;
      a.o = MIX + (size_t)(r0 + qb * 64) * 1024 + 256 + h * 64;
      a.qpos0 = qb * 64; a.lo = 0; a.hi = 15; a.window = 0; a.sink = 0.f; a.has_sink = 0;
    } else if (u < U_LATB + U_LATA) {
      u -= U_LATB;
      const int b = u >> 6, h = (u & 63) >> 4, qb = u & 15, kvh = h >> 1;
      const int r0 = M_CTX + b * 1024;
      a.q = QK + (size_t)(r0 + qb * 64) * 896 + h * 64;
      a.kloc = QK + (size_t)r0 * 896 + 256 + kvh * 64;
      a.vloc = VT + (size_t)(kvh * 64) * MTOT + r0;
      a.kctx = (const bf16_t*)(p.ws + WS_CKA) + (size_t)((b * 2 + l) * 2 + kvh) * 16384;
      a.vctx = (const bf16_t*)(p.ws + WS_CVTA) + (size_t)((b * 2 + l) * 2 + kvh) * 16384;
      a.o = MIX + (size_t)(r0 + qb * 64) * 1024 + h * 64;
      a.qpos0 = qb * 64; a.lo = qb - 2 < 0 ? 0 : qb - 2; a.hi = qb + 2 > 15 ? 15 : qb + 2; a.window = 1;
      a.sink = p.a_sink[l * 4 + h]; a.has_sink = 1;
    } else {
      u -= U_LATB + U_LATA;
      const int b = u / 40, rem = u % 40, hh = rem >> 2, qb = rem & 3;
      const int r0 = b * 256;
      a.kctx = nullptr; a.vctx = nullptr;
      a.qpos0 = qb * 64; a.lo = 0; a.hi = 3; a.window = 0;
      if (hh < 4) {
        const int h = hh, kvh = h >> 1;
        a.q = QK + (size_t)(r0 + qb * 64) * 896 + h * 64;
        a.kloc = QK + (size_t)r0 * 896 + 256 + kvh * 64;
        a.vloc = VT + (size_t)(kvh * 64) * MTOT + r0;
        a.o = MIX + (size_t)(r0 + qb * 64) * 1024 + h * 64;
        a.sink = p.a_sink[l * 4 + h]; a.has_sink = 1;
      } else {
        const int h = hh - 4, kvh = h / 3;
        a.q = QK + (size_t)(r0 + qb * 64) * 896 + 384 + h * 64;
        a.kloc = QK + (size_t)r0 * 896 + 768 + kvh * 64;
        a.vloc = VT + (size_t)((2 + kvh) * 64) * MTOT + r0;
        a.o = MIX + (size_t)(r0 + qb * 64) * 1024 + 256 + h * 64;
        a.sink = 0.f; a.has_sink = 0;
      }
    }
    attn_unit(a, smem);
  }
}

__device__ __forceinline__ void post_phase(const Params& p, int l) {
  const int tid_ = opq_tid(); const int lane = tid_ & 63, wave = tid_ >> 6;
  const bf16_t* Y = (const bf16_t*)(p.ws + WS_Y);
  const bf16_t* Gb = (const bf16_t*)(p.ws + WS_G);
  const float* BON = (const float*)(p.ws + WS_BON);
  const float* CZ = (const float*)(p.ws + WS_CZ);
  bf16_t* MIX = (bf16_t*)(p.ws + WS_H);
  for (int row = opq_bid() * 4 + wave; row < MTOT; row += gridDim.x * 4) {
#pragma unroll
    for (int h = 0; h < 6; ++h) {
      const int col = h * 64 + lane;
      const float y = bf2f(Y[(size_t)row * 384 + col]) + bf2f(Y[((size_t)MTOT + row) * 384 + col]);
      const float mu = wave_sum(y) * (1.f / 64.f);
      const float dv = y - mu;
      const float var = wave_sum(dv * dv) * (1.f / 64.f);
      const float yn = dv * __builtin_amdgcn_rsqf(var + 64e-5f);
      const float vv = CZ[(size_t)row * 1408 + 768 + col];
      const float o = (yn * p.c_ln_w[l * 384 + col] + p.c_ln_b[l * 384 + col] + BON[(size_t)row * 8 + h] * vv) *
                      bf2f(Gb[(size_t)row * 384 + col]);
      MIX[(size_t)row * 1024 + 640 + col] = f2bf(o);
    }
  }
}


#define XB_TMO      128
#define XB_XCNT(j)  (256  + 64 * (j))
#define XB_XSUB(j)  (1280 + 64 * (j))
#define XB_XGEN(j)  (2304 + 64 * (j))
#define XB_TOP      3328
#define XB_TOPGEN   3392
#define XCD_BAR_WORDS 3456
#define XB_SPIN_CAP (1u << 22)
#define LAS __attribute__((address_space(3)))
__device__ __forceinline__ unsigned xb_ld(unsigned* p)              { return __hip_atomic_load(p, __ATOMIC_RELAXED, __HIP_MEMORY_SCOPE_AGENT); }
__device__ __forceinline__ unsigned xb_add(unsigned* p, unsigned v) { return __hip_atomic_fetch_add(p, v, __ATOMIC_RELAXED, __HIP_MEMORY_SCOPE_AGENT); }
__device__ __forceinline__ unsigned xb_xcc_id() { return (unsigned)__builtin_amdgcn_s_getreg((3 << 11) | 20) & 0xFu; }
#define XB_SPIN(cond, bar) do { unsigned _sp = 0; while (cond) { __builtin_amdgcn_s_sleep(1); \
    if ((++_sp & 255u) == 0u) { if (xb_ld(&(bar)[XB_TMO])) break; if (_sp > XB_SPIN_CAP) { atomicAdd(&(bar)[XB_TMO], 1u); break; } } } } while (0)
struct XcdBarrier { unsigned* bar; unsigned x; volatile LAS unsigned* st; };
__device__ __forceinline__ XcdBarrier xcd_barrier_post(unsigned* bar, volatile LAS unsigned* st) {
  XcdBarrier b; b.bar = bar; b.x = xb_xcc_id(); b.st = st;
  if (threadIdx.x == 0) (void)xb_add(&bar[XB_XCNT(b.x)], 1u);
  return b;
}
__device__ __forceinline__ void xcd_barrier_complete(unsigned* bar, unsigned x, unsigned& nloc, unsigned& nx) {
  const unsigned G = gridDim.x * gridDim.y * gridDim.z;
  unsigned sum, cnt, mine, sp = 0u;
  for (;;) {
    sum = 0u; cnt = 0u; mine = 0u;
#pragma unroll
    for (unsigned j = 0; j < 16; ++j) { const unsigned c = xb_ld(&bar[XB_XCNT(j)]); sum += c; cnt += (c > 0u) ? 1u : 0u; mine = (j == x) ? c : mine; }
    if (sum == G) break;
    __builtin_amdgcn_s_sleep(1);
    if ((++sp & 255u) == 0u) { if (xb_ld(&bar[XB_TMO])) break; if (sp > XB_SPIN_CAP) { atomicAdd(&bar[XB_TMO], 1u); break; } }
  }
  nloc = mine > 0u ? mine : 1u; nx = cnt > 0u ? cnt : 1u;
}
__device__ __forceinline__ void xcd_barrier(const XcdBarrier& b) {
  asm volatile("s_waitcnt vmcnt(0)" ::: "memory");
  __syncthreads();
  if (threadIdx.x == 0) {
    unsigned* bar = b.bar;
    __builtin_amdgcn_s_waitcnt(0);
    unsigned nloc = b.st[0], nx = b.st[1];
    if (nloc == 0u) { xcd_barrier_complete(bar, b.x, nloc, nx); b.st[0] = nloc; b.st[1] = nx; }
    const unsigned old = xb_add(&bar[XB_XSUB(b.x)], 1u);
    const unsigned gen = old / nloc;
    if (old + 1u == (gen + 1u) * nloc) {
      __builtin_amdgcn_fence(__ATOMIC_RELEASE, "agent");
      asm volatile("s_waitcnt vmcnt(0)" ::: "memory");
      const unsigned og = xb_add(&bar[XB_TOP], 1u);
      const unsigned tg = og / nx;
      if (og + 1u == (tg + 1u) * nx) xb_add(&bar[XB_TOPGEN], 1u);
      else XB_SPIN(xb_ld(&bar[XB_TOPGEN]) == tg, bar);
      __builtin_amdgcn_fence(__ATOMIC_ACQUIRE, "agent");
      xb_add(&bar[XB_XGEN(b.x)], 1u);
      asm volatile("s_waitcnt vmcnt(0)" ::: "memory");
    } else {
      XB_SPIN(xb_ld(&bar[XB_XGEN(b.x)]) == gen, bar);
      __builtin_amdgcn_fence(__ATOMIC_ACQUIRE, "agent");
      asm volatile("s_waitcnt vmcnt(0)" ::: "memory");
    }
  }
  __syncthreads();
}

__device__ __forceinline__ void run_phase(const Params& p, int ph, unsigned char* smem) {
  if (ph == 0) { phase0(p, smem); return; }
  if (ph == NPHASE - 1) { rpass(p, 2, 1); return; }
  const int l = (ph - 1) / 9, s = (ph - 1) % 9;
  const bf16_t* H = (const bf16_t*)(p.ws + WS_H);
  switch (s) {
    case 0: if (l == 0) rpass(p, 0, 0); else rpass(p, 2, 0); break;
    case 1: gemm_phase<0>(p, l, H, D, (const bf16_t*)(p.ws + WS_WT_IN) + (size_t)l * IN_COLS * D, D, IN_COLS, D, smem); break;
    case 2: prep_phase(p, l, smem); break;
    case 3: mix_phase(p, l * 2, l, smem); break;
    case 4: post_phase(p, l); break;
    case 5: gemm_phase<1>(p, l, H, D, (const bf16_t*)(p.ws + WS_WT_OUT) + (size_t)l * D * D, D, D, D, smem); break;
    case 6: rpass(p, 1, l); break;
    case 7: gemm_phase<2>(p, l, H, D, (const bf16_t*)(p.ws + WS_WT_GU) + (size_t)l * GU * D, D, GU, D, smem); break;
    case 8: gemm_phase<1>(p, l, (const bf16_t*)(p.ws + WS_CZ), FF, (const bf16_t*)(p.ws + WS_WT_DN) + (size_t)l * D * FF, FF, D, FF, smem); break;
  }
}

#if N_LAUNCH_MODE == 0
__global__ void __launch_bounds__(256, 2) fwd_phases(Params p) {
  extern __shared__ __attribute__((aligned(16))) unsigned char smem[];
  run_phase(p, p.ph_lo, smem);
}
#define FWD_KERNEL fwd_phases
#else
template <int L>
__device__ __forceinline__ void layer_phases(const Params& p, unsigned char* smem, const XcdBarrier& xb) {
  const bf16_t* H = (const bf16_t*)(p.ws + WS_H);
  if (L == 0) {
#pragma unroll
    for (int rep = 0; rep < REP_R0; ++rep) rpass(p, 0, 0);
  } else rpass(p, 2, 0);
  xcd_barrier(xb);
#pragma unroll
  for (int rep = 0; rep < REP_GEMM; ++rep) {
    gemm_phase<0>(p, L, H, D, (const bf16_t*)(p.ws + WS_WT_IN) + (size_t)L * IN_COLS * D, D, IN_COLS, D, smem);
    xcd_barrier(xb);
  }
#pragma unroll
  for (int rep = 0; rep < REP_OTHER * REP_PREP; ++rep) {
    prep_phase(p, L, smem);
    xcd_barrier(xb);
  }
#if MIX_SPLIT
#pragma unroll
  for (int rep = 0; rep < REP_MA; ++rep) { mix_phase(p, L * 4 + 0 + 0 * rep, L, smem, 0, U_LSCAN); xcd_barrier(xb); if (rep + 1 < REP_MA) { if (threadIdx.x == 0 && blockIdx.x == 0) ((unsigned*)(p.ws + WS_CNT))[(L * 4 + 0) * 8] = 0u; xcd_barrier(xb); } }
#pragma unroll
  for (int rep = 0; rep < REP_MB; ++rep) { mix_phase(p, L * 4 + 1, L, smem, U_LSCAN, U_LSCAN + U_CSCAN); xcd_barrier(xb); if (rep + 1 < REP_MB) { if (threadIdx.x == 0 && blockIdx.x == 0) ((unsigned*)(p.ws + WS_CNT))[(L * 4 + 1) * 8] = 0u; xcd_barrier(xb); } }
#pragma unroll
  for (int rep = 0; rep < REP_MC; ++rep) { mix_phase(p, L * 4 + 2, L, smem, U_LSCAN + U_CSCAN, U_TOTAL); xcd_barrier(xb); if (rep + 1 < REP_MC) { if (threadIdx.x == 0 && blockIdx.x == 0) ((unsigned*)(p.ws + WS_CNT))[(L * 4 + 2) * 8] = 0u; xcd_barrier(xb); } }
#else
#pragma unroll
  for (int rep = 0; rep < REP_MIX; ++rep) {
    mix_phase(p, L * 2 + rep, L, smem);
    xcd_barrier(xb);
  }
#endif
#pragma unroll
  for (int rep = 0; rep < REP_OTHER; ++rep) {
    post_phase(p, L);
    xcd_barrier(xb);
  }
#pragma unroll
  for (int rep = 0; rep < REP_GEMM; ++rep) {
    gemm160_phase(p, H, D, (const bf16_t*)(p.ws + WS_WT_OUT) + (size_t)L * D * D, D, D, smem);
    xcd_barrier(xb);
  }
  rpass(p, 1, L);
  xcd_barrier(xb);
#pragma unroll
  for (int rep = 0; rep < REP_GEMM; ++rep) {
    gemm_phase<2>(p, L, H, D, (const bf16_t*)(p.ws + WS_WT_GU) + (size_t)L * GU * D, D, GU, D, smem);
    xcd_barrier(xb);
  }
#pragma unroll
  for (int rep = 0; rep < REP_GEMM; ++rep) {
    gemm160_phase(p, (const bf16_t*)(p.ws + WS_CZ), FF, (const bf16_t*)(p.ws + WS_WT_DN) + (size_t)L * D * FF, FF, FF, smem);
    xcd_barrier(xb);
  }
}
__global__ void __launch_bounds__(256, 2) fwd_mega(Params p) {
  extern __shared__ __attribute__((aligned(16))) unsigned char smem[];
  if (threadIdx.x == 0) { *(unsigned*)(smem + SMEM_CTL + 8) = 0u; *(unsigned*)(smem + SMEM_CTL + 12) = 0u; }
  __syncthreads();
  XcdBarrier xb = xcd_barrier_post((unsigned*)(p.ws + WS_BAR), (volatile LAS unsigned*)(smem + SMEM_CTL + 8));
#pragma unroll
  for (int rep = 0; rep < REP_P0; ++rep) phase0(p, smem);
#pragma unroll
  for (int rep = 0; rep < REP_BAR; ++rep) xcd_barrier(xb);
#if USE_CG_SYNC
  cg::this_grid().sync();
#else
  if (p.ph_hi < 0) cg::this_grid().sync();
  xcd_barrier(xb);
#endif
  layer_phases<0>(p, smem, xb);
  layer_phases<1>(p, smem, xb);
  rpass(p, 2, 1);
}
#define FWD_KERNEL fwd_mega
#endif

extern "C" void kernel_launch(void* const* d_in, const int* in_sizes, int n_in, void* d_out, int out_size, void* d_ws,
                              size_t ws_size, hipStream_t stream) {
  static int grid_blocks = 0;
  if (!grid_blocks) {
    int dev = 0, cus = 0, per_cu = 0;
    (void)hipGetDevice(&dev);
    (void)hipDeviceGetAttribute(&cus, hipDeviceAttributeMultiprocessorCount, dev);
    (void)hipFuncSetAttribute((const void*)FWD_KERNEL, hipFuncAttributeMaxDynamicSharedMemorySize, SMEM_BYTES);
    (void)hipOccupancyMaxActiveBlocksPerMultiprocessor(&per_cu, (const void*)FWD_KERNEL, 256, SMEM_BYTES);
    if (per_cu > 2) per_cu = 2;
    if (per_cu < 1) per_cu = 1;
    grid_blocks = cus * per_cu;
    if (n_in != 32 || ws_size < WS_END) {
      fprintf(stderr, "kernel_launch: unexpected n_in %d or ws_size %zu (< %zu)\n", n_in, ws_size, (size_t)WS_END);
      grid_blocks = -1;
    }
  }
  if (grid_blocks < 0) return;
  Params p{};
  const float** pp = (const float**)&p;
  for (int i = 0; i < 32; ++i) pp[i] = (const float*)d_in[i];
  p.out = (float*)d_out;
  p.ws = (unsigned char*)d_ws;
#if N_LAUNCH_MODE
  p.ph_lo = 0; p.ph_hi = NPHASE;
  (void)hipMemsetAsync((unsigned char*)d_ws + WS_BAR, 0, 16384, stream);
  void* args[] = {&p};
  hipError_t e = hipLaunchCooperativeKernel((const void*)fwd_mega, dim3(grid_blocks), dim3(256), args, SMEM_BYTES, stream);
  if (e != hipSuccess) fprintf(stderr, "cooperative launch failed: %s (grid %d)\n", hipGetErrorString(e), grid_blocks);
#else
  for (int ph = 0; ph < NPHASE; ++ph) {
    p.ph_lo = ph; p.ph_hi = ph + 1;
    hipLaunchKernelGGL(fwd_phases, dim3(grid_blocks), dim3(256), SMEM_BYTES, stream, p);
  }
#endif
}
```

```cpp
#include <hip/hip_runtime.h>
#include <hip/hip_bf16.h>
#include <hip/hip_cooperative_groups.h>
#include <cstdio>
#include <cstdint>
namespace cg = cooperative_groups;

typedef unsigned short bf16_t;
using bf16x8 = __attribute__((ext_vector_type(8))) short;
using f32x4 = __attribute__((ext_vector_type(4))) float;

#ifndef REP_GEMM
#define REP_GEMM 1
#endif
#ifndef REP_MIX
#define REP_MIX 1
#endif
#ifndef REP_P0
#define REP_P0 1
#endif
#ifndef REP_R0
#define REP_R0 1
#endif
#ifndef REP_BAR
#define REP_BAR 0
#endif
#ifndef REP_PREP
#define REP_PREP 1
#endif
#ifndef MIX_SPLIT
#define MIX_SPLIT 0
#endif
#ifndef REP_MA
#define REP_MA 1
#endif
#ifndef REP_MB
#define REP_MB 1
#endif
#ifndef REP_MC
#define REP_MC 1
#endif
#ifndef REP_OTHER
#define REP_OTHER 1
#endif
#ifndef USE_CG_SYNC
#define USE_CG_SYNC 0
#endif
#ifndef N_LAUNCH_MODE
#define N_LAUNCH_MODE 1
#endif

constexpr int D = 1024, M_CTX = 8192, M_LAT = 2048, MTOT = 10240;
constexpr int IN_COLS = 2560, FF = 2816, GU = 5632;
constexpr int NPHASE = 20;
constexpr int SMEM_CTL = 73728;
constexpr int SMEM_BYTES = SMEM_CTL + 64;

constexpr size_t al256(size_t x) { return (x + 255) & ~(size_t)255; }
constexpr size_t WS_WT_IN = 0;
constexpr size_t WS_WT_OUT = WS_WT_IN + (size_t)2 * IN_COLS * D * 2;
constexpr size_t WS_WT_GU = WS_WT_OUT + (size_t)2 * D * D * 2;
constexpr size_t WS_WT_DN = WS_WT_GU + (size_t)2 * GU * D * 2;
constexpr size_t WS_WUPT = WS_WT_DN + (size_t)2 * D * FF * 2;
constexpr size_t WS_AUPT = WS_WUPT + (size_t)4 * 384 * 64 * 2;
constexpr size_t WS_GUPT = WS_AUPT + (size_t)4 * 384 * 64 * 2;
constexpr size_t WS_MOD = WS_GUPT + (size_t)2 * 384 * 128 * 2;
constexpr size_t WS_ROPE = WS_MOD + (size_t)2 * 3 * 6144 * 4;
constexpr size_t WS_CKA = WS_ROPE + (size_t)1024 * 32 * 2 * 4;
constexpr size_t WS_CVTA = WS_CKA + (size_t)131072 * 2;
constexpr size_t WS_CKB = WS_CVTA + (size_t)131072 * 2;
constexpr size_t WS_CVTB = WS_CKB + (size_t)131072 * 2;
constexpr size_t WS_CNT = WS_CVTB + (size_t)131072 * 2;
constexpr size_t WS_BAR = WS_CNT + 256;
constexpr size_t WS_H = WS_BAR + 16384;
constexpr size_t WS_QK = WS_H + (size_t)MTOT * D * 2;
constexpr size_t WS_VT = WS_QK + (size_t)MTOT * 896 * 2;
constexpr size_t WS_CZ = WS_VT + (size_t)4 * 64 * MTOT * 2;
constexpr size_t WS_DEC = WS_CZ + (size_t)MTOT * 1408 * 4;
constexpr size_t WS_KT = WS_DEC + (size_t)2 * MTOT * 384 * 4;
constexpr size_t WS_BB = WS_KT + (size_t)2 * MTOT * 384 * 2;
constexpr size_t WS_KK = WS_BB + (size_t)2 * MTOT * 384 * 2;
constexpr size_t WS_G = WS_KK + (size_t)MTOT * 384 * 2;
constexpr size_t WS_BON = WS_G + (size_t)MTOT * 384 * 2;
constexpr size_t WS_Y = WS_BON + (size_t)MTOT * 8 * 4;
constexpr size_t WS_PA = WS_Y + (size_t)2 * MTOT * 384 * 2;
constexpr size_t WS_END = WS_PA + (size_t)MTOT * 256 * 2;
static_assert((size_t)MTOT * D * 4 <= (WS_BB - WS_DEC), "O alias");
static_assert(WS_END <= (size_t)256 * 1024 * 1024, "workspace too big");

constexpr size_t OUT_X = 0;
constexpr size_t OUT_AK = (size_t)MTOT * D;
constexpr size_t OUT_AV = OUT_AK + 2097152;
constexpr size_t OUT_BK = OUT_AV + 2097152;
constexpr size_t OUT_BV = OUT_BK + 2097152;
constexpr size_t OUT_ST = OUT_BV + 2097152;

struct Params {
  const float *x_prompt, *x_sample, *cache_a_k, *cache_a_v, *cache_b_k, *cache_b_v, *state_c, *c, *c_ctx,
      *w_mod, *b_mod, *norm_mix_pre, *norm_mix_post, *norm_ffn_pre, *norm_ffn_post, *w_in, *w_out, *a_sink,
      *b_q_norm, *b_k_norm, *c_w0, *c_w_up, *c_a0, *c_a_up, *c_g_up, *c_k_k, *c_k_a, *c_r_k, *c_ln_w, *c_ln_b,
      *w_gu, *w_down;
  float* out;
  unsigned char* ws;
  int ph_lo, ph_hi;
};

typedef __bf16 bf16x2_t __attribute__((ext_vector_type(2)));
typedef float f32x2_t __attribute__((ext_vector_type(2)));
__device__ __forceinline__ unsigned pk_bf16(float lo, float hi) {
  f32x2_t f = {lo, hi};
  bf16x2_t b = __builtin_convertvector(f, bf16x2_t);
  return __builtin_bit_cast(unsigned, b);
}
__device__ __forceinline__ bf16_t f2bf(float f) { return (bf16_t)(pk_bf16(f, 0.f) & 0xffffu); }
__device__ __forceinline__ float bf2f(bf16_t b) { return __uint_as_float(((unsigned)b) << 16); }
__device__ __forceinline__ float bflo(unsigned u) { return __uint_as_float(u << 16); }
__device__ __forceinline__ float bfhi(unsigned u) { return __uint_as_float(u & 0xffff0000u); }
__device__ __forceinline__ int opq_tid() { int x = threadIdx.x; asm volatile("" : "+v"(x)); return x; }
__device__ __forceinline__ int opq_bid() { int x = blockIdx.x; asm volatile("" : "+s"(x)); return x; }
__device__ __forceinline__ float4 cvt4(uint2 u) { return make_float4(bflo(u.x), bfhi(u.x), bflo(u.y), bfhi(u.y)); }
__device__ __forceinline__ float frcp(float x) { return __builtin_amdgcn_rcpf(x); }
__device__ __forceinline__ float sigmoidf_(float x) { return frcp(1.f + __expf(-x)); }
__device__ __forceinline__ float wave_sum(float v) {
#pragma unroll
  for (int o = 1; o < 64; o <<= 1) v += __shfl_xor(v, o);
  return v;
}
template <int CTRL>
__device__ __forceinline__ float dppf(float x) {
  return __builtin_bit_cast(float, __builtin_amdgcn_mov_dpp(__builtin_bit_cast(int, x), CTRL, 0xf, 0xf, true));
}
constexpr int DPP_XOR1 = 0xB1, DPP_XOR2 = 0x4E, DPP_ROR4 = 0x124, DPP_ROR8 = 0x128;
__device__ __forceinline__ float row16_sum(float v) {
  v += dppf<DPP_XOR1>(v);
  v += dppf<DPP_XOR2>(v);
  v += dppf<DPP_ROR4>(v);
  v += dppf<DPP_ROR8>(v);
  return v;
}
__device__ __forceinline__ f32x4 mfma16(bf16x8 a, bf16x8 b, f32x4 c) {
  return __builtin_amdgcn_mfma_f32_16x16x32_bf16(a, b, c, 0, 0, 0);
}

__device__ __forceinline__ void transpose_tile(const float* __restrict__ src, int K, int N, bf16_t* __restrict__ dst,
                                               int tile, bool perm, float* lds) {
  const int nkt = K / 64, nnt = N / 64, per = nkt * nnt;
  const int lyr = tile / per, r = tile % per, kt = r / nnt, nt = r % nnt;
  src += (size_t)lyr * K * N;
  dst += (size_t)lyr * K * N;
  const int tid = opq_tid();
#pragma unroll
  for (int i = 0; i < 16; ++i) {
    const int row = (tid >> 6) + 4 * i;
    lds[row * 65 + (tid & 63)] = src[(size_t)(kt * 64 + row) * N + nt * 64 + (tid & 63)];
  }
  __syncthreads();
#pragma unroll
  for (int it = 0; it < 2; ++it) {
    const int idx = tid + it * 256, n = idx >> 3, kc = idx & 7;
    uint4 v;
    v.x = pk_bf16(lds[(kc * 8 + 0) * 65 + n], lds[(kc * 8 + 1) * 65 + n]);
    v.y = pk_bf16(lds[(kc * 8 + 2) * 65 + n], lds[(kc * 8 + 3) * 65 + n]);
    v.z = pk_bf16(lds[(kc * 8 + 4) * 65 + n], lds[(kc * 8 + 5) * 65 + n]);
    v.w = pk_bf16(lds[(kc * 8 + 6) * 65 + n], lds[(kc * 8 + 7) * 65 + n]);
    const int col = nt * 64 + n;
    int prow = col;
    if (perm) {
      if (col < FF) prow = (col >> 5) * 64 + (col & 31);
      else { const int c2 = col - FF; prow = (c2 >> 5) * 64 + 32 + (c2 & 31); }
    }
    *(uint4*)(dst + (size_t)prow * K + kt * 64 + kc * 8) = v;
  }
  __syncthreads();
}

__device__ __forceinline__ void gemv_item(const Params& p, int item, float* lds) {
  const int l = item / 192, n0 = (item % 192) * 32;
  const int tid = opq_tid();
  float* s_c = lds;
  float* red = lds + 3072;
  for (int i = tid; i < 3072; i += 256) {
    const int ci = i >> 10, k = i & 1023;
    const float x = (ci == 0) ? p.c_ctx[k] : p.c[(ci - 1) * 1024 + k];
    s_c[i] = x * sigmoidf_(x);
  }
  __syncthreads();
  const int kg = tid >> 5, col = tid & 31;
  const float* w = p.w_mod + (size_t)l * 1024 * 6144 + (size_t)(kg * 128) * 6144 + n0 + col;
  float a0 = 0.f, a1 = 0.f, a2 = 0.f;
#pragma unroll 32
  for (int k = 0; k < 128; ++k) {
    const float wv = __builtin_nontemporal_load(w + (size_t)k * 6144);
    a0 += s_c[kg * 128 + k] * wv;
    a1 += s_c[1024 + kg * 128 + k] * wv;
    a2 += s_c[2048 + kg * 128 + k] * wv;
  }
  red[(kg * 3 + 0) * 32 + col] = a0;
  red[(kg * 3 + 1) * 32 + col] = a1;
  red[(kg * 3 + 2) * 32 + col] = a2;
  __syncthreads();
  if (tid < 96) {
    const int ci = tid >> 5, cc = tid & 31;
    float sum = p.b_mod[l * 6144 + n0 + cc];
#pragma unroll
    for (int g = 0; g < 8; ++g) sum += red[(g * 3 + ci) * 32 + cc];
    ((float*)(p.ws + WS_MOD))[(l * 3 + ci) * 6144 + n0 + cc] = sum;
  }
  __syncthreads();
}

constexpr int WL_IN = 16 * 40, WL_OUT = 16 * 16, WL_GU = 16 * 88, WL_DN = 44 * 16, WL_UP = 2 * 6, WL_G = 2 * 6;
constexpr int WL_TOTAL = WL_IN + WL_OUT + WL_GU + WL_DN + 2 * WL_UP + WL_G;
__device__ __forceinline__ void weight_item(const Params& p, int layer, int r, float* lds) {
  if (r < WL_IN) { transpose_tile(p.w_in, 1024, IN_COLS, (bf16_t*)(p.ws + WS_WT_IN), layer * WL_IN + r, false, lds); return; }
  r -= WL_IN;
  if (r < WL_OUT) { transpose_tile(p.w_out, 1024, 1024, (bf16_t*)(p.ws + WS_WT_OUT), layer * WL_OUT + r, false, lds); return; }
  r -= WL_OUT;
  if (r < WL_GU) { transpose_tile(p.w_gu, 1024, GU, (bf16_t*)(p.ws + WS_WT_GU), layer * WL_GU + r, true, lds); return; }
  r -= WL_GU;
  if (r < WL_DN) { transpose_tile(p.w_down, FF, 1024, (bf16_t*)(p.ws + WS_WT_DN), layer * WL_DN + r, false, lds); return; }
  r -= WL_DN;
  if (r < WL_UP) { transpose_tile(p.c_w_up, 64, 384, (bf16_t*)(p.ws + WS_WUPT), layer * WL_UP + r, false, lds); return; }
  r -= WL_UP;
  if (r < WL_UP) { transpose_tile(p.c_a_up, 64, 384, (bf16_t*)(p.ws + WS_AUPT), layer * WL_UP + r, false, lds); return; }
  r -= WL_UP;
  transpose_tile(p.c_g_up, 128, 384, (bf16_t*)(p.ws + WS_GUPT), layer * WL_G + r, false, lds);
}

constexpr int P0_GEMV = 384;
constexpr int P0_ROPE = 128, P0_CACHE = 256;
constexpr int P0_TOTAL = P0_GEMV + WL_TOTAL + P0_ROPE + P0_CACHE;

__device__ __forceinline__ void phase0(const Params& p, unsigned char* smem) {
  float* lds = (float*)smem;
  const int tid = opq_tid();
  const int bid = opq_bid();
  if (bid == 0 && tid < 64) ((unsigned*)(p.ws + WS_CNT))[tid] = 0u;
  for (int it = bid; it < P0_TOTAL; it += gridDim.x) {
    int r = it;
    if (r < P0_GEMV) { gemv_item(p, r, lds); continue; }
    r -= P0_GEMV;
    if (r < WL_TOTAL) { weight_item(p, 0, r, lds); continue; }
    r -= WL_TOTAL;
    if (r < P0_ROPE) {
      const int idx = r * 256 + tid, t = idx >> 5, i = idx & 31, fi = i & 15;
      const float pos = (i < 16) ? (float)(t >> 6) : (float)(t & 63);
      const float freq = exp2f(-(float)fi * (13.287712379549449f / 16.f));
      float rev = pos * freq * 0.15915494309189535f;
      rev -= floorf(rev);
      float2 cs;
      cs.x = __builtin_amdgcn_cosf(rev);
      cs.y = __builtin_amdgcn_sinf(rev);
      ((float2*)(p.ws + WS_ROPE))[idx] = cs;
      continue;
    }
    r -= P0_ROPE;
    {
#pragma unroll
      for (int j = 0; j < 8; ++j) {
        const int idx = r * 2048 + j * 256 + tid;
        const int tensor = idx >> 17, e = idx & 131071;
        const float* src = tensor == 0 ? p.cache_a_k : tensor == 1 ? p.cache_a_v : tensor == 2 ? p.cache_b_k : p.cache_b_v;
        bf16_t* dst = (bf16_t*)(p.ws + (tensor == 0 ? WS_CKA : tensor == 1 ? WS_CVTA : tensor == 2 ? WS_CKB : WS_CVTB));
        int b, l, h, t, d;
        if ((tensor & 1) == 0) { d = e & 63; t = (e >> 6) & 255; h = (e >> 14) & 1; l = (e >> 15) & 1; b = e >> 16; }
        else { t = e & 255; d = (e >> 8) & 63; h = (e >> 14) & 1; l = (e >> 15) & 1; b = e >> 16; }
        dst[e] = f2bf(src[((((size_t)b * 2 + l) * 256 + t) * 2 + h) * 64 + d]);
      }
    }
  }
}

__device__ __forceinline__ void rpass(const Params& p, int mode, int l) {
  const int tid_ = opq_tid(); const int lane = tid_ & 63, wave = tid_ >> 6;
  const float* MOD = (const float*)(p.ws + WS_MOD);
  const bf16_t* O = (const bf16_t*)(p.ws + WS_DEC);
  float* X = p.out + OUT_X;
  bf16_t* H = (bf16_t*)(p.ws + WS_H);
  const int nwaves = gridDim.x * 4, rpw = (MTOT + nwaves - 1) / nwaves;
  const int gw_ = opq_bid() * 4 + wave;
  const int rbeg = gw_ * rpw, rend = (rbeg + rpw < MTOT) ? rbeg + rpw : MTOT;
  const bool has_next = !(mode == 2 && l == 1);
  const int nl = (mode == 2) ? l + 1 : l;
  float4 vgw[4], vgs[4], vsh[4];
  int ci_cur = -1;
  for (int row = rbeg; row < rend; ++row) {
    const int ci = row < M_CTX ? 0 : 1 + ((row - M_CTX) >> 10);
    if (ci != ci_cur) {
      ci_cur = ci;
      if (mode != 0) {
        const float* gate = MOD + (l * 3 + ci) * 6144 + (mode == 1 ? 2 : 5) * 1024;
        const float* gp = (mode == 1 ? p.norm_mix_post : p.norm_ffn_post) + l * D;
#pragma unroll
        for (int j = 0; j < 4; ++j) {
          const float4 g = *(const float4*)(gate + j * 256 + lane * 4);
          const float4 w = *(const float4*)(gp + j * 256 + lane * 4);
          vgw[j] = make_float4(g.x * w.x, g.y * w.y, g.z * w.z, g.w * w.w);
        }
      }
      if (has_next) {
        const float* gpre = (mode == 1 ? p.norm_ffn_pre : p.norm_mix_pre) + nl * D;
        const float* sc = MOD + (nl * 3 + ci) * 6144 + (mode == 1 ? 4 : 1) * 1024;
        const float* sh = MOD + (nl * 3 + ci) * 6144 + (mode == 1 ? 3 : 0) * 1024;
#pragma unroll
        for (int j = 0; j < 4; ++j) {
          const float4 g = *(const float4*)(gpre + j * 256 + lane * 4);
          const float4 s = *(const float4*)(sc + j * 256 + lane * 4);
          vgs[j] = make_float4(g.x * (1.f + s.x), g.y * (1.f + s.y), g.z * (1.f + s.z), g.w * (1.f + s.w));
          vsh[j] = *(const float4*)(sh + j * 256 + lane * 4);
        }
      }
    }
    const float* xs;
    if (mode == 0 || (mode == 1 && l == 0)) xs = row < M_CTX ? p.x_prompt + (size_t)row * D : p.x_sample + (size_t)(row - M_CTX) * D;
    else xs = X + (size_t)row * D;
    float4 x[4];
#pragma unroll
    for (int j = 0; j < 4; ++j) x[j] = *(const float4*)(xs + j * 256 + lane * 4);
    if (mode != 0) {
      float4 o[4];
      float ss = 0.f;
#pragma unroll
      for (int j = 0; j < 4; ++j) {
        o[j] = cvt4(*(const uint2*)(O + (size_t)row * D + j * 256 + lane * 4));
        ss += o[j].x * o[j].x + o[j].y * o[j].y + o[j].z * o[j].z + o[j].w * o[j].w;
      }
      ss = wave_sum(ss);
      const float rs = __builtin_amdgcn_rsqf(ss * (1.f / D) + 1e-6f);
#pragma unroll
      for (int j = 0; j < 4; ++j) {
        x[j].x += vgw[j].x * (o[j].x * rs);
        x[j].y += vgw[j].y * (o[j].y * rs);
        x[j].z += vgw[j].z * (o[j].z * rs);
        x[j].w += vgw[j].w * (o[j].w * rs);
        *(float4*)(X + (size_t)row * D + j * 256 + lane * 4) = x[j];
      }
    }
    if (!has_next) continue;
    float ss2 = 0.f;
#pragma unroll
    for (int j = 0; j < 4; ++j) ss2 += x[j].x * x[j].x + x[j].y * x[j].y + x[j].z * x[j].z + x[j].w * x[j].w;
    ss2 = wave_sum(ss2);
    const float rs2 = __builtin_amdgcn_rsqf(ss2 * (1.f / D) + 1e-6f);
#pragma unroll
    for (int j = 0; j < 4; ++j) {
      const float h0 = x[j].x * rs2 * vgs[j].x + vsh[j].x;
      const float h1 = x[j].y * rs2 * vgs[j].y + vsh[j].y;
      const float h2 = x[j].z * rs2 * vgs[j].z + vsh[j].z;
      const float h3 = x[j].w * rs2 * vgs[j].w + vsh[j].w;
      uint2 v;
      v.x = pk_bf16(h0, h1);
      v.y = pk_bf16(h2, h3);
      *(uint2*)(H + (size_t)row * D + j * 256 + lane * 4) = v;
    }
  }
}

template <int FN>
__device__ __forceinline__ float xform(float t) {
  if (FN == 1) { const float e = __expf(2.f * t); return 1.f - 2.f * frcp(e + 1.f); }
  if (FN == 2) return sigmoidf_(t);
  return t;
}
__device__ __forceinline__ void epi_f32(const Params& p, f32x4 (&acc)[4][4], int rb, int cb, int lane) {
  const int fr = lane & 15, fq = lane >> 4;
  float* O = (float*)(p.ws + WS_DEC);
#pragma unroll
  for (int m = 0; m < 4; ++m)
#pragma unroll
    for (int n = 0; n < 4; ++n)
#pragma unroll
      for (int j = 0; j < 4; ++j) O[(size_t)(rb + m * 16 + fq * 4 + j) * D + cb + n * 16 + fr] = acc[m][n][j];
}

__device__ __forceinline__ void epi_gu(const Params& p, f32x4 (&acc)[4][4], int rb, int cb, int lane) {
  const int fr = lane & 15, fq = lane >> 4;
  bf16_t* ACT = (bf16_t*)(p.ws + WS_CZ);
  const int chunk = cb >> 6;
#pragma unroll
  for (int m = 0; m < 4; ++m)
#pragma unroll
    for (int n = 0; n < 2; ++n)
#pragma unroll
      for (int j = 0; j < 4; ++j) {
        const float g = acc[m][n][j], u = acc[m][n + 2][j];
        const float a = g * sigmoidf_(g) * u;
        ACT[(size_t)(rb + m * 16 + fq * 4 + j) * FF + chunk * 32 + n * 16 + fr] = f2bf(a);
      }
}

template <int MB>
__device__ __forceinline__ void epi_in(const Params& p, int l, f32x4 (&acc)[MB][4], int rb, int cb, int lane) {
  const int fr = lane & 15, fq = lane >> 4;
  const int cidx = cb >> 6;
  const bool lat = rb >= M_CTX;
  if (cidx >= 36) {
    bf16_t* PA = (bf16_t*)(p.ws + WS_PA);
    const int pc = cb - 2304;
#pragma unroll
    for (int m = 0; m < MB; ++m)
#pragma unroll
      for (int n = 0; n < 4; ++n)
#pragma unroll
        for (int j = 0; j < 4; ++j) {
          float t = acc[m][n][j];
          if (cidx == 36) t = xform<1>(t); else if (cidx >= 38) t = xform<2>(t);
          PA[(size_t)(rb + m * 16 + fq * 4 + j) * 256 + pc + n * 16 + fr] = f2bf(t);
        }
    return;
  }
  if (cidx >= 18) {
    float* CZ = (float*)(p.ws + WS_CZ);
    const int cc = cb - 1152;
#pragma unroll
    for (int m = 0; m < MB; ++m)
#pragma unroll
      for (int n = 0; n < 4; ++n)
#pragma unroll
        for (int j = 0; j < 4; ++j) CZ[(size_t)(rb + m * 16 + fq * 4 + j) * 1408 + cc + n * 16 + fr] = acc[m][n][j];
    return;
  }
  if (cidx >= 8 && cidx < 16) {
    const float* gw = (cidx < 14 ? p.b_q_norm : p.b_k_norm) + l * 64;
    float g[4];
#pragma unroll
    for (int n = 0; n < 4; ++n) g[n] = gw[n * 16 + fr];
#pragma unroll
    for (int m = 0; m < MB; ++m)
#pragma unroll
      for (int j = 0; j < 4; ++j) {
        float ss = 0.f;
#pragma unroll
        for (int n = 0; n < 4; ++n) ss += acc[m][n][j] * acc[m][n][j];
        ss = row16_sum(ss);
        const float rs = __builtin_amdgcn_rsqf(ss * (1.f / 64.f) + 1e-6f);
#pragma unroll
        for (int n = 0; n < 4; ++n) acc[m][n][j] *= rs * g[n];
      }
  }
  const bool isv = (cidx == 6 || cidx == 7 || cidx == 16 || cidx == 17);
  if (lat && !isv) {
    const float2* ROPE = (const float2*)(p.ws + WS_ROPE);
#pragma unroll
    for (int m = 0; m < MB; ++m)
#pragma unroll
      for (int j = 0; j < 4; ++j) {
        const int t = (rb + m * 16 + fq * 4 + j - M_CTX) & 1023;
        const float2 a0 = ROPE[t * 32 + fr], a1 = ROPE[t * 32 + 16 + fr];
        float x1 = acc[m][0][j], x2 = acc[m][2][j];
        acc[m][0][j] = x1 * a0.x - x2 * a0.y;
        acc[m][2][j] = x1 * a0.y + x2 * a0.x;
        x1 = acc[m][1][j]; x2 = acc[m][3][j];
        acc[m][1][j] = x1 * a1.x - x2 * a1.y;
        acc[m][3][j] = x1 * a1.y + x2 * a1.x;
      }
  }
  if (!isv) {
    bf16_t* QK = (bf16_t*)(p.ws + WS_QK);
    const int qc = (cidx < 6) ? cb : cb - 128;
#pragma unroll
    for (int m = 0; m < MB; ++m)
#pragma unroll
      for (int n = 0; n < 4; ++n)
#pragma unroll
        for (int j = 0; j < 4; ++j) QK[(size_t)(rb + m * 16 + fq * 4 + j) * 896 + qc + n * 16 + fr] = f2bf(acc[m][n][j]);
    if (!lat && (cidx == 4 || cidx == 5 || cidx == 14 || cidx == 15)) {
      float* dst = p.out + (cidx < 6 ? OUT_AK : OUT_BK);
      const int h = cidx & 1;
#pragma unroll
      for (int m = 0; m < MB; ++m)
#pragma unroll
        for (int n = 0; n < 4; ++n)
#pragma unroll
          for (int j = 0; j < 4; ++j) {
            const int row = rb + m * 16 + fq * 4 + j, b = row >> 8, t = row & 255;
            dst[((((size_t)b * 2 + l) * 256 + t) * 2 + h) * 64 + n * 16 + fr] = acc[m][n][j];
          }
    }
  } else {
    bf16_t* VT = (bf16_t*)(p.ws + WS_VT);
    const int vh = (cidx < 8) ? cidx - 6 : 2 + cidx - 16;
#pragma unroll
    for (int m = 0; m < MB; ++m)
#pragma unroll
      for (int n = 0; n < 4; ++n) {
        uint2 v;
        v.x = pk_bf16(acc[m][n][0], acc[m][n][1]);
        v.y = pk_bf16(acc[m][n][2], acc[m][n][3]);
        *(uint2*)(VT + ((size_t)(vh * 64 + n * 16 + fr)) * MTOT + rb + m * 16 + fq * 4) = v;
      }
    if (!lat) {
      float* dst = p.out + (cidx < 8 ? OUT_AV : OUT_BV);
      const int h = cidx & 1;
#pragma unroll
      for (int m = 0; m < MB; ++m)
#pragma unroll
        for (int n = 0; n < 4; ++n)
#pragma unroll
          for (int j = 0; j < 4; ++j) {
            const int row = rb + m * 16 + fq * 4 + j, b = row >> 8, t = row & 255;
            dst[((((size_t)b * 2 + l) * 256 + t) * 2 + h) * 64 + n * 16 + fr] = acc[m][n][j];
          }
    }
  }
}

__device__ __forceinline__ void gemm64_tile(const Params& p, int l, const bf16_t* __restrict__ A, int lda,
                                            const bf16_t* __restrict__ Bt, int ldb, int K, int brow, int bcol, unsigned char* smem) {
  const int tid = opq_tid(), lane = tid & 63, wid = tid >> 6, fr = lane & 15, fq = lane >> 4;
  const int sw = (fr >> 1) & 7;
  const int nk = K / 64;
  const int lrow = lane >> 3;
  f32x4 acc[1][4];
#pragma unroll
  for (int n = 0; n < 4; ++n) acc[0][n] = (f32x4){0.f, 0.f, 0.f, 0.f};
  const bf16_t* ga = A + (size_t)(brow + wid * 16 + lrow) * lda;
  const bf16_t* gb = Bt + (size_t)(bcol + wid * 16 + lrow) * ldb;
#define GEMM64_STAGE(bufi, kt_)                                                                                   \
  {                                                                                                               \
    unsigned char* sb_ = smem + (bufi) * 16384 + wid * 2048 + lane * 16;                                          \
    _Pragma("unroll") for (int i_ = 0; i_ < 2; ++i_) {                                                            \
      const int c_ = (lane & 7) ^ (((wid * 16 + i_ * 8 + lrow) >> 1) & 7);                                        \
      __builtin_amdgcn_global_load_lds((const unsigned*)(ga + (size_t)(i_ * 8) * lda + (kt_) * 64 + c_ * 8),      \
                                       (unsigned*)(sb_ + i_ * 1024), 16, 0, 0);                                   \
      __builtin_amdgcn_global_load_lds((const unsigned*)(gb + (size_t)(i_ * 8) * ldb + (kt_) * 64 + c_ * 8),      \
                                       (unsigned*)(sb_ + 8192 + i_ * 1024), 16, 0, 0);                            \
    }                                                                                                             \
  }
  __syncthreads();
  GEMM64_STAGE(0, 0);
  for (int kt = 0; kt < nk; ++kt) {
    asm volatile("s_waitcnt vmcnt(0)" ::: "memory");
    __syncthreads();
    if (kt + 1 < nk) GEMM64_STAGE((kt + 1) & 1, kt + 1);
    const unsigned char* sA = smem + (kt & 1) * 16384;
    const unsigned char* sB = sA + 8192;
#pragma unroll
    for (int s = 0; s < 2; ++s) {
      const int co = ((s * 4 + fq) ^ sw) << 4;
      const bf16x8 a = *(const bf16x8*)(sA + (wid * 16 + fr) * 128 + co);
#pragma unroll
      for (int n = 0; n < 4; ++n) {
        const bf16x8 b = *(const bf16x8*)(sB + (n * 16 + fr) * 128 + co);
        acc[0][n] = mfma16(a, b, acc[0][n]);
      }
    }
  }
  epi_in<1>(p, l, acc, brow + wid * 16, bcol, lane);
}

template <int EPI>
__device__ __forceinline__ void gemm_phase(const Params& p, int l, const bf16_t* __restrict__ A, int lda,
                                           const bf16_t* __restrict__ Bt, int ldb, int N, int K, unsigned char* smem) {
  const int tid = opq_tid(), lane = tid & 63, wid = tid >> 6, wr = wid >> 1, wc = wid & 1, fr = lane & 15, fq = lane >> 4;
  const int bid = opq_bid();
  const int nN = N / 128, ntiles = (MTOT / 128) * nN;
  const int G = gridDim.x, per = G >> 3;
  const int srow = wid * 32 + (lane >> 3);
  const int sw = (fr >> 1) & 7;
  const int nk = K / 64;
  for (int base = 0; base < ntiles; base += G) {
    const int tile = base + (bid & 7) * per + (bid >> 3);
    if (EPI == 0 && base + G > ntiles && (ntiles - base) * 4 <= G) {
      const int sub = tile - base, nsub = (ntiles - base) * 4;
      if (sub < nsub) {
        const int t128 = base + (sub >> 2), q = sub & 3;
        const int patch = t128 >> 5, within = t128 & 31, nPN = nN >> 2;
        const int mt = (patch / nPN) * 8 + (within >> 2), nt = (patch % nPN) * 4 + (within & 3);
        gemm64_tile(p, l, A, lda, Bt, ldb, K, mt * 128 + (q >> 1) * 64, nt * 128 + (q & 1) * 64, smem);
      }
      if (l == 0) {
        const int nidle = G - nsub;
        if (nidle == 0) { for (int it = sub; it < WL_TOTAL; it += G) weight_item(p, 1, it, (float*)smem); }
        else if (sub >= nsub) { for (int it = sub - nsub; it < WL_TOTAL; it += nidle) weight_item(p, 1, it, (float*)smem); }
      }
      continue;
    }
    if (tile >= ntiles) {
      if (EPI == 0 && l == 0) {
        const int nidle = base + G - ntiles;
        for (int it = tile - ntiles; it < WL_TOTAL; it += nidle) weight_item(p, 1, it, (float*)smem);
      }
      continue;
    }
    const int patch = tile >> 5, within = tile & 31, nPN = nN >> 2;
    const int mt = (patch / nPN) * 8 + (within >> 2), nt = (patch % nPN) * 4 + (within & 3);
    const int brow = mt * 128, bcol = nt * 128;
    f32x4 acc[4][4];
#pragma unroll
    for (int m = 0; m < 4; ++m)
#pragma unroll
      for (int n = 0; n < 4; ++n) acc[m][n] = (f32x4){0.f, 0.f, 0.f, 0.f};
    const bf16_t* ga = A + (size_t)(brow + srow) * lda;
    const bf16_t* gb = Bt + (size_t)(bcol + srow) * ldb;
#define GEMM_STAGE(bufi, kt_)                                                                                     \
  {                                                                                                               \
    unsigned char* sa_ = smem + (bufi) * 32768 + wid * 4096 + lane * 16;                                          \
    _Pragma("unroll") for (int i_ = 0; i_ < 4; ++i_) {                                                            \
      const int c_ = (lane & 7) ^ (((srow + i_ * 8) >> 1) & 7);                                                   \
      __builtin_amdgcn_global_load_lds((const unsigned*)(ga + (size_t)(i_ * 8) * lda + (kt_) * 64 + c_ * 8),      \
                                       (unsigned*)(sa_ + i_ * 1024), 16, 0, 0);                                   \
      __builtin_amdgcn_global_load_lds((const unsigned*)(gb + (size_t)(i_ * 8) * ldb + (kt_) * 64 + c_ * 8),      \
                                       (unsigned*)(sa_ + 16384 + i_ * 1024), 16, 0, 0);                           \
    }                                                                                                             \
  }
    __syncthreads();
    GEMM_STAGE(0, 0);
#define GEMM_STAGE1(bufi, kt_, i_)                                                                                \
  {                                                                                                               \
    unsigned char* sa_ = smem + (bufi) * 32768 + wid * 4096 + lane * 16;                                          \
    const int c_ = (lane & 7) ^ (((srow + (i_) * 8) >> 1) & 7);                                                   \
    __builtin_amdgcn_global_load_lds((const unsigned*)(ga + (size_t)((i_) * 8) * lda + (kt_) * 64 + c_ * 8),      \
                                     (unsigned*)(sa_ + (i_) * 1024), 16, 0, 0);                                   \
    __builtin_amdgcn_global_load_lds((const unsigned*)(gb + (size_t)((i_) * 8) * ldb + (kt_) * 64 + c_ * 8),      \
                                     (unsigned*)(sa_ + 16384 + (i_) * 1024), 16, 0, 0);                           \
  }
    for (int kt = 0; kt < nk; ++kt) {
      asm volatile("s_waitcnt vmcnt(0)" ::: "memory");
      __syncthreads();
      const bool more = kt + 1 < nk;
      const unsigned char* sA = smem + (kt & 1) * 32768;
      const unsigned char* sB = sA + 16384;
      bf16x8 a[4], b[4], a2[4], b2[4];
      {
        const int co = (fq ^ sw) << 4, co2 = ((4 + fq) ^ sw) << 4;
#pragma unroll
        for (int m = 0; m < 4; ++m) a[m] = *(const bf16x8*)(sA + (wr * 64 + m * 16 + fr) * 128 + co);
#pragma unroll
        for (int n = 0; n < 4; ++n) b[n] = *(const bf16x8*)(sB + (wc * 64 + n * 16 + fr) * 128 + co);
#pragma unroll
        for (int m = 0; m < 4; ++m) a2[m] = *(const bf16x8*)(sA + (wr * 64 + m * 16 + fr) * 128 + co2);
#pragma unroll
        for (int n = 0; n < 4; ++n) b2[n] = *(const bf16x8*)(sB + (wc * 64 + n * 16 + fr) * 128 + co2);
      }
      __builtin_amdgcn_sched_barrier(0);
#pragma unroll
      for (int m = 0; m < 4; ++m) {
        if (more && m < 2) { GEMM_STAGE1((kt + 1) & 1, kt + 1, 2 * m); GEMM_STAGE1((kt + 1) & 1, kt + 1, 2 * m + 1); }
#pragma unroll
        for (int n = 0; n < 4; ++n) acc[m][n] = mfma16(a[m], b[n], acc[m][n]);
        __builtin_amdgcn_sched_barrier(0);
      }
      __builtin_amdgcn_s_setprio(1);
#pragma unroll
      for (int m = 0; m < 4; ++m)
#pragma unroll
        for (int n = 0; n < 4; ++n) acc[m][n] = mfma16(a2[m], b2[n], acc[m][n]);
      __builtin_amdgcn_s_setprio(0);
    }
    const int rb = brow + wr * 64, cb = bcol + wc * 64;
    if constexpr (EPI == 0) epi_in<4>(p, l, acc, rb, cb, lane);
    else if constexpr (EPI == 1) epi_f32(p, acc, rb, cb, lane);
    else epi_gu(p, acc, rb, cb, lane);
  }
}

constexpr int G160_BUF = 36864;
__device__ __forceinline__ void gemm160_phase(const Params& p, const bf16_t* __restrict__ A, int lda,
                                              const bf16_t* __restrict__ Bt, int ldb, int K, unsigned char* smem) {
  const int tid = opq_tid(), lane = tid & 63, wid = tid >> 6, wr = wid >> 1, wc = wid & 1, fr = lane & 15, fq = lane >> 4;
  const int bid = opq_bid();
  constexpr int nN = 8, ntiles = 64 * nN;
  const int G = gridDim.x, per = G >> 3;
  const int sw = (fr >> 1) & 7;
  const int nk = K / 64;
  const int lrow = lane >> 3;
  bf16_t* O = (bf16_t*)(p.ws + WS_DEC);
  for (int base = 0; base < ntiles; base += G) {
    const int tile = base + (bid & 7) * per + (bid >> 3);
    if (tile >= ntiles) continue;
    const int mt = tile / nN, nt = tile % nN;
    const int brow = mt * 160, bcol = nt * 128;
    f32x4 acc[5][4];
#pragma unroll
    for (int m = 0; m < 5; ++m)
#pragma unroll
      for (int n = 0; n < 4; ++n) acc[m][n] = (f32x4){0.f, 0.f, 0.f, 0.f};
    const bf16_t* ga = A + (size_t)(brow + lrow) * lda;
    const bf16_t* gb = Bt + (size_t)(bcol + wid * 32 + lrow) * ldb;
#define GEMM160_STAGE(bufi, kt_)                                                                                  \
  {                                                                                                               \
    unsigned char* sb_ = smem + (bufi) * G160_BUF;                                                                \
    _Pragma("unroll") for (int i_ = 0; i_ < 5; ++i_) {                                                            \
      const int pc_ = wid + i_ * 4;                                                                               \
      const int c_ = (lane & 7) ^ (((pc_ * 8 + lrow) >> 1) & 7);                                                  \
      __builtin_amdgcn_global_load_lds((const unsigned*)(ga + (size_t)(pc_ * 8) * lda + (kt_) * 64 + c_ * 8),     \
                                       (unsigned*)(sb_ + pc_ * 1024 + lane * 16), 16, 0, 0);                      \
    }                                                                                                             \
    _Pragma("unroll") for (int i_ = 0; i_ < 4; ++i_) {                                                            \
      const int c_ = (lane & 7) ^ (((wid * 32 + i_ * 8 + lrow) >> 1) & 7);                                        \
      __builtin_amdgcn_global_load_lds((const unsigned*)(gb + (size_t)(i_ * 8) * ldb + (kt_) * 64 + c_ * 8),      \
                                       (unsigned*)(sb_ + 20480 + wid * 4096 + i_ * 1024 + lane * 16), 16, 0, 0);  \
    }                                                                                                             \
  }
    __syncthreads();
    GEMM160_STAGE(0, 0);
    for (int kt = 0; kt < nk; ++kt) {
      asm volatile("s_waitcnt vmcnt(0)" ::: "memory");
      __syncthreads();
      if (kt + 1 < nk) GEMM160_STAGE((kt + 1) & 1, kt + 1);
      const unsigned char* sA = smem + (kt & 1) * G160_BUF;
      const unsigned char* sB = sA + 20480;
      bf16x8 a[5], b[4], a2[5], b2[4];
      {
        const int co = (fq ^ sw) << 4, co2 = ((4 + fq) ^ sw) << 4;
#pragma unroll
        for (int m = 0; m < 5; ++m) a[m] = *(const bf16x8*)(sA + (wr * 80 + m * 16 + fr) * 128 + co);
#pragma unroll
        for (int n = 0; n < 4; ++n) b[n] = *(const bf16x8*)(sB + (wc * 64 + n * 16 + fr) * 128 + co);
#pragma unroll
        for (int m = 0; m < 5; ++m) a2[m] = *(const bf16x8*)(sA + (wr * 80 + m * 16 + fr) * 128 + co2);
#pragma unroll
        for (int n = 0; n < 4; ++n) b2[n] = *(const bf16x8*)(sB + (wc * 64 + n * 16 + fr) * 128 + co2);
      }
      __builtin_amdgcn_s_setprio(1);
#pragma unroll
      for (int m = 0; m < 5; ++m)
#pragma unroll
        for (int n = 0; n < 4; ++n) acc[m][n] = mfma16(a[m], b[n], acc[m][n]);
#pragma unroll
      for (int m = 0; m < 5; ++m)
#pragma unroll
        for (int n = 0; n < 4; ++n) acc[m][n] = mfma16(a2[m], b2[n], acc[m][n]);
      __builtin_amdgcn_s_setprio(0);
    }
#pragma unroll
    for (int m = 0; m < 5; ++m)
#pragma unroll
      for (int n = 0; n < 4; ++n)
#pragma unroll
        for (int j = 0; j < 4; ++j)
          O[(size_t)(brow + wr * 80 + m * 16 + fq * 4 + j) * D + bcol + wc * 64 + n * 16 + fr] = f2bf(acc[m][n][j]);
  }
}

template <int FN>
__device__ __forceinline__ bf16x8 ld_frag_f32(const float* src) {
  const float4 u = *(const float4*)src, v = *(const float4*)(src + 4);
  union { uint4 u4; bf16x8 v8; } r;
  r.u4.x = pk_bf16(xform<FN>(u.x), xform<FN>(u.y));
  r.u4.y = pk_bf16(xform<FN>(u.z), xform<FN>(u.w));
  r.u4.z = pk_bf16(xform<FN>(v.x), xform<FN>(v.y));
  r.u4.w = pk_bf16(xform<FN>(v.z), xform<FN>(v.w));
  return r.v8;
}

__device__ __forceinline__ void prep_phase(const Params& p, int l, unsigned char* smem) {
  const int tid = opq_tid(), lane = tid & 63, wid = tid >> 6, fr = lane & 15, fq = lane >> 4;
  const float* CZ = (const float*)(p.ws + WS_CZ);
  float* DEC = (float*)(p.ws + WS_DEC);
  bf16_t* KT = (bf16_t*)(p.ws + WS_KT);
  bf16_t* BB = (bf16_t*)(p.ws + WS_BB);
  bf16_t* KK = (bf16_t*)(p.ws + WS_KK);
  bf16_t* Gb = (bf16_t*)(p.ws + WS_G);
  float* BON = (float*)(p.ws + WS_BON);
  const bf16_t* WUPT = (const bf16_t*)(p.ws + WS_WUPT);
  const bf16_t* AUPT = (const bf16_t*)(p.ws + WS_AUPT);
  const bf16_t* GUPT = (const bf16_t*)(p.ws + WS_GUPT);
  const bf16_t* PA = (const bf16_t*)(p.ws + WS_PA);
  const int swz = (fr >> 1) & 7;
  for (int u = opq_bid(); u < 80 * 6; u += gridDim.x) {
    const int tile = u / 6, h = u % 6;
    __syncthreads();
    {
      uint4 tw_[4], tg_[4];
#pragma unroll
      for (int i = 0; i < 4; ++i) {
        const bf16_t* src = (i < 2 ? WUPT : AUPT) + ((unsigned)(l * 2 + (i & 1)) * 384 + h * 64) * 64;
        const int pc0 = tid, pc1 = tid + 256;
        const uint4 v0 = *(const uint4*)(src + (pc0 >> 3) * 64 + (pc0 & 7) * 8);
        const uint4 v1 = *(const uint4*)(src + (pc1 >> 3) * 64 + (pc1 & 7) * 8);
        tw_[i] = v0; tg_[i] = v1;
      }
#pragma unroll
      for (int i = 0; i < 4; ++i) {
        const int pc0 = tid, pc1 = tid + 256;
        *(uint4*)(smem + i * 8192 + (pc0 >> 3) * 128 + (((pc0 & 7) ^ (((pc0 >> 3) >> 1) & 7)) << 4)) = tw_[i];
        *(uint4*)(smem + i * 8192 + (pc1 >> 3) * 128 + (((pc1 & 7) ^ (((pc1 >> 3) >> 1) & 7)) << 4)) = tg_[i];
      }
#pragma unroll
      for (int i = 0; i < 4; ++i) {
        const int pc = tid + i * 256, col = pc >> 4, chn = pc & 15;
        const uint4 v = *(const uint4*)(GUPT + ((unsigned)l * 384 + h * 64 + col) * 128 + chn * 8);
        *(uint4*)(smem + 32768 + col * 256 + ((chn ^ (col & 15)) << 4)) = v;
      }
    }
    __syncthreads();
#pragma unroll
    for (int mb = 0; mb < 2; ++mb) {
      const int rb = tile * 128 + wid * 32 + mb * 16;
      const int arow = rb + fr;
      bf16x8 ftw[2], fxa[2];
#pragma unroll
      for (int ks = 0; ks < 2; ++ks) {
        ftw[ks] = *(const bf16x8*)(PA + (unsigned)arow * 256 + ks * 32 + fq * 8);
        fxa[ks] = *(const bf16x8*)(PA + (unsigned)arow * 256 + 64 + ks * 32 + fq * 8);
      }
      float kv[4][4], rv[4][4], kkn[4][4], bon[4];
      float kkw[4], kaw[4], rkw[4];
#pragma unroll
      for (int n = 0; n < 4; ++n) {
        kkw[n] = p.c_k_k[l * 384 + h * 64 + n * 16 + fr];
        kaw[n] = p.c_k_a[l * 384 + h * 64 + n * 16 + fr];
        rkw[n] = p.c_r_k[l * 384 + h * 64 + n * 16 + fr];
      }
#pragma unroll
      for (int j = 0; j < 4; ++j) {
        const int row = rb + fq * 4 + j;
        float ss = 0.f;
#pragma unroll
        for (int n = 0; n < 4; ++n) {
          kv[n][j] = CZ[(unsigned)row * 1408 + 384 + h * 64 + n * 16 + fr];
          rv[n][j] = CZ[(unsigned)row * 1408 + h * 64 + n * 16 + fr];
          kkn[n][j] = kv[n][j] * kkw[n];
          ss += kkn[n][j] * kkn[n][j];
        }
        ss = row16_sum(ss);
        const float rs = __builtin_amdgcn_rsqf(ss + 1e-12f);
#pragma unroll
        for (int n = 0; n < 4; ++n) {
          kkn[n][j] *= rs;
          KK[(unsigned)row * 384 + h * 64 + n * 16 + fr] = f2bf(kkn[n][j]);
        }
        bon[j] = 0.f;
      }
#pragma unroll
      for (int d = 0; d < 2; ++d) {
        f32x4 aw[4], aa[4];
#pragma unroll
        for (int n = 0; n < 4; ++n) {
          aw[n] = (f32x4){0.f, 0.f, 0.f, 0.f};
          aa[n] = (f32x4){0.f, 0.f, 0.f, 0.f};
          const int col = h * 64 + n * 16 + fr;
#pragma unroll
          for (int ks = 0; ks < 2; ++ks) {
            const bf16x8 bw = *(const bf16x8*)(smem + d * 8192 + (n * 16 + fr) * 128 + (((ks * 4 + fq) ^ swz) << 4));
            const bf16x8 ba = *(const bf16x8*)(smem + 16384 + d * 8192 + (n * 16 + fr) * 128 + (((ks * 4 + fq) ^ swz) << 4));
            aw[n] = mfma16(ftw[ks], bw, aw[n]);
            aa[n] = mfma16(fxa[ks], ba, aa[n]);
          }
        }
#pragma unroll
        for (int n = 0; n < 4; ++n) {
          const int col = h * 64 + n * 16 + fr;
          const float w0 = p.c_w0[(l * 2 + d) * 384 + col], a0 = p.c_a0[(l * 2 + d) * 384 + col];
#pragma unroll
          for (int j = 0; j < 4; ++j) {
            const int row = rb + fq * 4 + j;
            const float dec = __expf(-0.6065306597126334f * sigmoidf_(aw[n][j] + w0));
            const float a = sigmoidf_(aa[n][j] + a0);
            const float kt = kv[n][j] * (1.f + (a - 1.f) * kaw[n]);
            DEC[((unsigned)d * MTOT + row) * 384 + col] = dec;
            KT[((unsigned)d * MTOT + row) * 384 + col] = f2bf(kt);
            BB[((unsigned)d * MTOT + row) * 384 + col] = f2bf(kkn[n][j] * a);
            bon[j] += rv[n][j] * kt * rkw[n];
          }
        }
      }
#pragma unroll
      for (int j = 0; j < 4; ++j) {
        const float b = row16_sum(bon[j]);
        if (fr == 0) BON[(unsigned)(rb + fq * 4 + j) * 8 + h] = b;
      }
      f32x4 ag[4];
#pragma unroll
      for (int n = 0; n < 4; ++n) ag[n] = (f32x4){0.f, 0.f, 0.f, 0.f};
#pragma unroll
      for (int ks = 0; ks < 4; ++ks) {
        const bf16x8 fa = *(const bf16x8*)(PA + (unsigned)arow * 256 + 128 + ks * 32 + fq * 8);
#pragma unroll
        for (int n = 0; n < 4; ++n) {
          const int col = h * 64 + n * 16 + fr;
          const bf16x8 bg = *(const bf16x8*)(smem + 32768 + (n * 16 + fr) * 256 + (((ks * 4 + fq) ^ fr) << 4));
          ag[n] = mfma16(fa, bg, ag[n]);
        }
      }
#pragma unroll
      for (int n = 0; n < 4; ++n)
#pragma unroll
        for (int j = 0; j < 4; ++j) Gb[(unsigned)(rb + fq * 4 + j) * 384 + h * 64 + n * 16 + fr] = f2bf(ag[n][j]);
    }
  }
}


typedef float f32x2 __attribute__((ext_vector_type(2)));
__device__ __forceinline__ f32x2 fma2(f32x2 a, f32x2 b, f32x2 c) { return __builtin_elementwise_fma(a, b, c); }

struct ScanSrc { const float* DEC; const bf16_t* KT; const bf16_t* BB; const bf16_t* KK; const float* CZ; int row0, T, d, hoff, ls, lc; };
#define SCAN_DECL(P) float4 P##w, P##r, P##v; uint2 P##kt, P##kk, P##b;
#define SCAN_GLOAD(P, chunk)                                                         \
  {                                                                                  \
    int t_ = (chunk) * 16 + sc.ls;                                                   \
    if (sc.d) t_ = sc.T - 1 - t_;                                                    \
    const unsigned row_ = (unsigned)(sc.row0 + t_);                                  \
    P##w = *(const float4*)(sc.DEC + row_ * 384u + sc.hoff + sc.lc);                 \
    P##kt = *(const uint2*)(sc.KT + row_ * 384u + sc.hoff + sc.lc);                  \
    P##kk = *(const uint2*)(sc.KK + row_ * 384u + sc.hoff + sc.lc);                  \
    P##b = *(const uint2*)(sc.BB + row_ * 384u + sc.hoff + sc.lc);                   \
    P##r = *(const float4*)(sc.CZ + row_ * 1408u + sc.hoff + sc.lc);                 \
    P##v = *(const float4*)(sc.CZ + row_ * 1408u + 768 + sc.hoff + sc.lc);           \
  }
#define SCAN_LSTORE(P, b_)                                                           \
  {                                                                                  \
    float* dst_ = buf + (((b_) * 16 + sc.ls) * 6) * 64 + sc.lc;                      \
    const float4 kk_ = cvt4(P##kk);                                                  \
    *(float4*)(dst_) = P##w;                                                         \
    *(float4*)(dst_ + 64) = cvt4(P##kt);                                             \
    *(float4*)(dst_ + 128) = make_float4(-kk_.x, -kk_.y, -kk_.z, -kk_.w);           \
    *(float4*)(dst_ + 192) = cvt4(P##b);                                             \
    *(float4*)(dst_ + 256) = P##r;                                                   \
    *(float4*)(dst_ + 320) = P##v;                                                   \
  }

template <int R>
__device__ __forceinline__ void scan_chunk(f32x2 (&S)[R][2], const float* cbuf, int k0, int v0, int kq,
                                           bf16_t* Yhv, int row0, int T, int d, int ch) {
  const float* sb = cbuf + k0;
  const float* vb = cbuf + 320 + v0;
  float ykeep[R];
#pragma unroll
  for (int j = 0; j < R; ++j) ykeep[j] = 0.f;
  f32x4 cw, ckt, ca, cbv, cr;
  float cvv[R];
  cw = *(const f32x4*)(sb);
  ckt = *(const f32x4*)(sb + 64);
  ca = *(const f32x4*)(sb + 128);
  cbv = *(const f32x4*)(sb + 192);
  cr = *(const f32x4*)(sb + 256);
  if constexpr (R == 4) { const f32x4 t = *(const f32x4*)vb; cvv[0] = t.x; cvv[1] = t.y; cvv[2] = t.z; cvv[3] = t.w; }
  else {
#pragma unroll
    for (int j = 0; j < R; ++j) cvv[j] = vb[j];
  }
#pragma unroll
  for (int s = 0; s < 16; ++s) {
    f32x4 nw, nkt, na, nbv, nr;
    float nvv[R];
    if (s < 15) {
      nw = *(const f32x4*)(sb + (s + 1) * 384);
      nkt = *(const f32x4*)(sb + (s + 1) * 384 + 64);
      na = *(const f32x4*)(sb + (s + 1) * 384 + 128);
      nbv = *(const f32x4*)(sb + (s + 1) * 384 + 192);
      nr = *(const f32x4*)(sb + (s + 1) * 384 + 256);
      if constexpr (R == 4) { const f32x4 t = *(const f32x4*)(vb + (s + 1) * 384); nvv[0] = t.x; nvv[1] = t.y; nvv[2] = t.z; nvv[3] = t.w; }
      else {
#pragma unroll
        for (int j = 0; j < R; ++j) nvv[j] = vb[(s + 1) * 384 + j];
      }
    }
#pragma unroll
    for (int j = 0; j < R; ++j) {
      f32x2 acc = S[j][0] * ca.xy;
      acc = fma2(S[j][1], ca.zw, acc);
      float sa = acc.x + acc.y;
      sa += dppf<DPP_XOR1>(sa);
      sa += dppf<DPP_XOR2>(sa);
      sa += dppf<DPP_ROR4>(sa);
      sa += dppf<DPP_ROR8>(sa);
      const f32x2 sa2 = {sa, sa}, vv2 = {cvv[j], cvv[j]};
      S[j][0] = fma2(S[j][0], cw.xy, fma2(sa2, cbv.xy, vv2 * ckt.xy));
      S[j][1] = fma2(S[j][1], cw.zw, fma2(sa2, cbv.zw, vv2 * ckt.zw));
      f32x2 yacc = S[j][0] * cr.xy;
      yacc = fma2(S[j][1], cr.zw, yacc);
      float y = yacc.x + yacc.y;
      y += dppf<DPP_XOR1>(y);
      y += dppf<DPP_XOR2>(y);
      y += dppf<DPP_ROR4>(y);
      y += dppf<DPP_ROR8>(y);
      ykeep[j] = (kq == s) ? y : ykeep[j];
    }
    if (s < 15) {
      cw = nw; ckt = nkt; ca = na; cbv = nbv; cr = nr;
#pragma unroll
      for (int j = 0; j < R; ++j) cvv[j] = nvv[j];
    }
  }
  int t = ch * 16 + kq;
  if (d) t = T - 1 - t;
#pragma unroll
  for (int j = 0; j < R; ++j) Yhv[(unsigned)(row0 + t) * 384u + j] = f2bf(ykeep[j]);
}

constexpr int DPP_HMIRROR = 0x141;
__device__ __forceinline__ void scan_chunk8(f32x2 (&S)[2][4], const float* cbuf, int k0, int v0, int kq,
                                            bf16_t* Yhv, int row0, int T, int d, int ch) {
  const float* sb = cbuf + k0;
  const float* vb = cbuf + 320 + v0;
  float ykeep[2][2];
#pragma unroll
  for (int j = 0; j < 2; ++j) { ykeep[j][0] = 0.f; ykeep[j][1] = 0.f; }
  f32x4 cw[2], ckt[2], ca[2], cbv[2], cr[2];
  f32x2 cvv;
#pragma unroll
  for (int q = 0; q < 2; ++q) {
    cw[q] = *(const f32x4*)(sb + q * 4);
    ckt[q] = *(const f32x4*)(sb + 64 + q * 4);
    ca[q] = *(const f32x4*)(sb + 128 + q * 4);
    cbv[q] = *(const f32x4*)(sb + 192 + q * 4);
    cr[q] = *(const f32x4*)(sb + 256 + q * 4);
  }
  cvv = *(const f32x2*)vb;
#pragma unroll
  for (int s = 0; s < 16; ++s) {
    f32x4 nw[2], nkt[2], na[2], nbv[2], nr[2];
    f32x2 nvv = {0.f, 0.f};
    if (s < 15) {
#pragma unroll
      for (int q = 0; q < 2; ++q) {
        nw[q] = *(const f32x4*)(sb + (s + 1) * 384 + q * 4);
        nkt[q] = *(const f32x4*)(sb + (s + 1) * 384 + 64 + q * 4);
        na[q] = *(const f32x4*)(sb + (s + 1) * 384 + 128 + q * 4);
        nbv[q] = *(const f32x4*)(sb + (s + 1) * 384 + 192 + q * 4);
        nr[q] = *(const f32x4*)(sb + (s + 1) * 384 + 256 + q * 4);
      }
      nvv = *(const f32x2*)(vb + (s + 1) * 384);
    }
#pragma unroll
    for (int j = 0; j < 2; ++j) {
      f32x2 acc = S[j][0] * ca[0].xy;
      acc = fma2(S[j][1], ca[0].zw, acc);
      acc = fma2(S[j][2], ca[1].xy, acc);
      acc = fma2(S[j][3], ca[1].zw, acc);
      float sa = acc.x + acc.y;
      sa += dppf<DPP_XOR1>(sa);
      sa += dppf<DPP_XOR2>(sa);
      sa += dppf<DPP_HMIRROR>(sa);
      const float vj = j ? cvv.y : cvv.x;
      const f32x2 sa2 = {sa, sa}, vv2 = {vj, vj};
      S[j][0] = fma2(S[j][0], cw[0].xy, fma2(sa2, cbv[0].xy, vv2 * ckt[0].xy));
      S[j][1] = fma2(S[j][1], cw[0].zw, fma2(sa2, cbv[0].zw, vv2 * ckt[0].zw));
      S[j][2] = fma2(S[j][2], cw[1].xy, fma2(sa2, cbv[1].xy, vv2 * ckt[1].xy));
      S[j][3] = fma2(S[j][3], cw[1].zw, fma2(sa2, cbv[1].zw, vv2 * ckt[1].zw));
      f32x2 yacc = S[j][0] * cr[0].xy;
      yacc = fma2(S[j][1], cr[0].zw, yacc);
      yacc = fma2(S[j][2], cr[1].xy, yacc);
      yacc = fma2(S[j][3], cr[1].zw, yacc);
      float y = yacc.x + yacc.y;
      y += dppf<DPP_XOR1>(y);
      y += dppf<DPP_XOR2>(y);
      y += dppf<DPP_HMIRROR>(y);
      ykeep[j][s >> 3] = (kq == (s & 7)) ? y : ykeep[j][s >> 3];
    }
    if (s < 15) {
#pragma unroll
      for (int q = 0; q < 2; ++q) { cw[q] = nw[q]; ckt[q] = nkt[q]; ca[q] = na[q]; cbv[q] = nbv[q]; cr[q] = nr[q]; }
      cvv = nvv;
    }
  }
#pragma unroll
  for (int hs = 0; hs < 2; ++hs) {
    int t = ch * 16 + hs * 8 + kq;
    if (d) t = T - 1 - t;
#pragma unroll
    for (int j = 0; j < 2; ++j) Yhv[(unsigned)(row0 + t) * 384u + j] = f2bf(ykeep[j][hs]);
  }
}

__device__ __forceinline__ void scan_unit8(const Params& p, int l, int row0, int T, int h, int d, float* fin, unsigned char* smem) {
  const int tid = opq_tid();
  const int v0 = (tid >> 3) * 2, kq = tid & 7, k0 = kq * 8;
  f32x2 S[2][4];
#pragma unroll
  for (int j = 0; j < 2; ++j)
#pragma unroll
    for (int i = 0; i < 4; ++i) S[j][i] = (f32x2){0.f, 0.f};
  float* buf = (float*)smem;
  ScanSrc sc;
  sc.DEC = (const float*)(p.ws + WS_DEC) + (size_t)d * MTOT * 384;
  sc.KT = (const bf16_t*)(p.ws + WS_KT) + (size_t)d * MTOT * 384;
  sc.BB = (const bf16_t*)(p.ws + WS_BB) + (size_t)d * MTOT * 384;
  sc.KK = (const bf16_t*)(p.ws + WS_KK);
  sc.CZ = (const float*)(p.ws + WS_CZ);
  sc.row0 = row0; sc.T = T; sc.d = d; sc.hoff = h * 64; sc.ls = tid >> 4; sc.lc = (tid & 15) * 4;
  bf16_t* Yhv = (bf16_t*)(p.ws + WS_Y) + (size_t)d * MTOT * 384 + h * 64 + v0;
  const int nch = T / 16;
  float* buf0 = buf;
  float* buf1 = buf + 16 * 384;
  __syncthreads();
  SCAN_DECL(A)
  SCAN_GLOAD(A, 0);
  SCAN_LSTORE(A, 0);
  __syncthreads();
  for (int ch = 0; ch < nch; ++ch) {
    if (ch + 1 < nch) SCAN_GLOAD(A, ch + 1);
    scan_chunk8(S, (ch & 1) ? buf1 : buf0, k0, v0, kq, Yhv, row0, T, d, ch);
    if (ch + 1 < nch) SCAN_LSTORE(A, (ch + 1) & 1);
    __syncthreads();
  }
#pragma unroll
  for (int j = 0; j < 2; ++j) {
    float4 t0, t1;
    t0.x = S[j][0].x; t0.y = S[j][0].y; t0.z = S[j][1].x; t0.w = S[j][1].y;
    t1.x = S[j][2].x; t1.y = S[j][2].y; t1.z = S[j][3].x; t1.w = S[j][3].y;
    *(float4*)(fin + (v0 + j) * 64 + k0) = t0;
    *(float4*)(fin + (v0 + j) * 64 + k0 + 4) = t1;
  }
}

template <int R>
__device__ __forceinline__ void scan_unit(const Params& p, int l, int row0, int T, int h, int d, int vbase,
                                          const float* init, float* fin, unsigned char* smem) {
  const int tid = opq_tid();
  const int v0 = vbase + (tid >> 4) * R, kq = tid & 15, k0 = kq * 4;
  f32x2 S[R][2];
#pragma unroll
  for (int j = 0; j < R; ++j) {
    if (init) {
      const float4 t = *(const float4*)(init + (v0 + j) * 64 + k0);
      S[j][0].x = t.x; S[j][0].y = t.y; S[j][1].x = t.z; S[j][1].y = t.w;
    } else {
      S[j][0] = (f32x2){0.f, 0.f}; S[j][1] = (f32x2){0.f, 0.f};
    }
  }
  float* buf = (float*)smem;
  ScanSrc sc;
  sc.DEC = (const float*)(p.ws + WS_DEC) + (size_t)d * MTOT * 384;
  sc.KT = (const bf16_t*)(p.ws + WS_KT) + (size_t)d * MTOT * 384;
  sc.BB = (const bf16_t*)(p.ws + WS_BB) + (size_t)d * MTOT * 384;
  sc.KK = (const bf16_t*)(p.ws + WS_KK);
  sc.CZ = (const float*)(p.ws + WS_CZ);
  sc.row0 = row0; sc.T = T; sc.d = d; sc.hoff = h * 64; sc.ls = tid >> 4; sc.lc = (tid & 15) * 4;
  bf16_t* Yhv = (bf16_t*)(p.ws + WS_Y) + (size_t)d * MTOT * 384 + h * 64 + v0;
  const int nch = T / 16;
  float* buf0 = buf;
  float* buf1 = buf + 16 * 384;
  __syncthreads();
  if constexpr (R == 1) {
    __builtin_amdgcn_s_setprio(3);
    SCAN_DECL(A) SCAN_DECL(B) SCAN_DECL(C) SCAN_DECL(Dd)
    SCAN_GLOAD(A, 0);
    SCAN_LSTORE(A, 0);
    SCAN_GLOAD(A, 1);
    SCAN_GLOAD(B, 2);
    SCAN_GLOAD(C, 3);
    __syncthreads();
    for (int ch = 0; ch < nch; ch += 4) {
      if (ch + 4 < nch) SCAN_GLOAD(Dd, ch + 4);
      scan_chunk<R>(S, buf0, k0, v0, kq, Yhv, row0, T, d, ch);
      SCAN_LSTORE(A, 1);
      __syncthreads();
      if (ch + 5 < nch) SCAN_GLOAD(A, ch + 5);
      scan_chunk<R>(S, buf1, k0, v0, kq, Yhv, row0, T, d, ch + 1);
      SCAN_LSTORE(B, 0);
      __syncthreads();
      if (ch + 6 < nch) SCAN_GLOAD(B, ch + 6);
      scan_chunk<R>(S, buf0, k0, v0, kq, Yhv, row0, T, d, ch + 2);
      SCAN_LSTORE(C, 1);
      __syncthreads();
      if (ch + 7 < nch) SCAN_GLOAD(C, ch + 7);
      scan_chunk<R>(S, buf1, k0, v0, kq, Yhv, row0, T, d, ch + 3);
      if (ch + 4 < nch) SCAN_LSTORE(Dd, 0);
      __syncthreads();
    }
    __builtin_amdgcn_s_setprio(0);
  } else {
    SCAN_DECL(A)
    SCAN_GLOAD(A, 0);
    SCAN_LSTORE(A, 0);
    __syncthreads();
    for (int ch = 0; ch < nch; ++ch) {
      if (ch + 1 < nch) SCAN_GLOAD(A, ch + 1);
      scan_chunk<R>(S, (ch & 1) ? buf1 : buf0, k0, v0, kq, Yhv, row0, T, d, ch);
      if (ch + 1 < nch) SCAN_LSTORE(A, (ch + 1) & 1);
      __syncthreads();
    }
  }
  if (fin) {
#pragma unroll
    for (int j = 0; j < R; ++j) {
      float4 t;
      t.x = S[j][0].x; t.y = S[j][0].y; t.z = S[j][1].x; t.w = S[j][1].y;
      *(float4*)(fin + (v0 + j) * 64 + k0) = t;
    }
  }
}

struct AttnDesc {
  const bf16_t* q;
  const bf16_t* kloc;
  const bf16_t* vloc;
  const bf16_t* kctx;
  const bf16_t* vctx;
  bf16_t* o;
  int qpos0;
  int lo, hi;
  int window;
  float sink; int has_sink;
};

__device__ __forceinline__ void attn_unit(const AttnDesc& a, unsigned char* smem) {
  const int tid = opq_tid(), lane = tid & 63, wid = tid >> 6, fr = lane & 15, fq = lane >> 4;
  unsigned char* sK = smem;
  unsigned char* sV = smem + 8192;
  bf16x8 qf[2];
  {
    const bf16_t* qp = a.q + (size_t)(wid * 16 + fr) * 896 + fq * 8;
    qf[0] = *(const bf16x8*)(qp);
    qf[1] = *(const bf16x8*)(qp + 32);
  }
  f32x4 o[4];
#pragma unroll
  for (int i = 0; i < 4; ++i) o[i] = (f32x4){0.f, 0.f, 0.f, 0.f};
  float mrun = -1e30f, lsum = 0.f;
  const int nctx = a.kctx ? 4 : 0;
  const int ntl = nctx + (a.hi - a.lo + 1);
  const int sw = (fr >> 1) & 7;
  const int qpos = a.qpos0 + wid * 16 + fr;
  const int r0_ = tid >> 3, chn = tid & 7, r1_ = r0_ + 32;
  const int rho0 = (r0_ & 32) | (((r0_ >> 2) & 1) << 4) | (((r0_ >> 3) & 3) << 2) | (r0_ & 3);
  const int rho1 = rho0 + 32;
  uint4 rk0, rk1, rv0, rv1;
#define ATTN_TLOAD(it_)                                                                          \
  {                                                                                              \
    const bool ic_ = (it_) < nctx;                                                               \
    const int kt_ = ic_ ? (it_) : a.lo + ((it_) - nctx);                                         \
    const bf16_t* kb_ = ic_ ? a.kctx + (size_t)kt_ * 64 * 64 : a.kloc + (size_t)kt_ * 64 * 896;  \
    const int kstr_ = ic_ ? 64 : 896;                                                            \
    const bf16_t* vb_ = ic_ ? a.vctx + kt_ * 64 : a.vloc + kt_ * 64;                             \
    const int vstr_ = ic_ ? 256 : MTOT;                                                          \
    rk0 = *(const uint4*)(kb_ + (size_t)r0_ * kstr_ + chn * 8);                                  \
    rk1 = *(const uint4*)(kb_ + (size_t)r1_ * kstr_ + chn * 8);                                  \
    rv0 = *(const uint4*)(vb_ + (size_t)r0_ * vstr_ + chn * 8);                                  \
    rv1 = *(const uint4*)(vb_ + (size_t)r1_ * vstr_ + chn * 8);                                  \
  }
  ATTN_TLOAD(0);
  for (int it = 0; it < ntl; ++it) {
    const bool isctx = it < nctx;
    const int kt = isctx ? it : a.lo + (it - nctx);
    __syncthreads();
    *(uint4*)(sK + rho0 * 128 + ((chn ^ ((rho0 >> 1) & 7)) << 4)) = rk0;
    *(uint4*)(sK + rho1 * 128 + ((chn ^ ((rho1 >> 1) & 7)) << 4)) = rk1;
    *(uint4*)(sV + r0_ * 128 + ((chn ^ ((r0_ >> 1) & 7)) << 4)) = rv0;
    *(uint4*)(sV + r1_ * 128 + ((chn ^ ((r1_ >> 1) & 7)) << 4)) = rv1;
    __syncthreads();
    if (it + 1 < ntl) ATTN_TLOAD(it + 1);
    f32x4 st[4];
#pragma unroll
    for (int kb4 = 0; kb4 < 4; ++kb4) {
      st[kb4] = (f32x4){0.f, 0.f, 0.f, 0.f};
#pragma unroll
      for (int ks = 0; ks < 2; ++ks) {
        const bf16x8 af = *(const bf16x8*)(sK + (kb4 * 16 + fr) * 128 + (((ks * 4 + fq) ^ sw) << 4));
        st[kb4] = mfma16(af, qf[ks], st[kb4]);
      }
    }
    float mt = -1e30f;
#pragma unroll
    for (int kb4 = 0; kb4 < 4; ++kb4)
#pragma unroll
      for (int jj = 0; jj < 4; ++jj) {
        float s = st[kb4][jj] * 0.125f;
        if (a.window && !isctx) {
          const int key = (kb4 >> 1) * 32 + fq * 8 + (kb4 & 1) * 4 + jj;
          const int dlt = kt * 64 + key - qpos;
          if (dlt > 128 || dlt < -128) s = -1e30f;
        }
        st[kb4][jj] = s;
        mt = fmaxf(mt, s);
      }
    mt = fmaxf(mt, __shfl_xor(mt, 16));
    mt = fmaxf(mt, __shfl_xor(mt, 32));
    const float mnew = fmaxf(mrun, mt);
    const float alpha = __expf(mrun - mnew);
    mrun = mnew;
    float ps = 0.f;
#pragma unroll
    for (int kb4 = 0; kb4 < 4; ++kb4)
#pragma unroll
      for (int jj = 0; jj < 4; ++jj) {
        const float pv = __expf(st[kb4][jj] - mnew);
        st[kb4][jj] = pv;
        ps += pv;
      }
    lsum = lsum * alpha + ps;
#pragma unroll
    for (int i = 0; i < 4; ++i) o[i] *= alpha;
    bf16x8 pb[2];
#pragma unroll
    for (int kg = 0; kg < 2; ++kg) {
      union { uint4 u4; bf16x8 v8; } r;
      r.u4.x = pk_bf16(st[2 * kg][0], st[2 * kg][1]);
      r.u4.y = pk_bf16(st[2 * kg][2], st[2 * kg][3]);
      r.u4.z = pk_bf16(st[2 * kg + 1][0], st[2 * kg + 1][1]);
      r.u4.w = pk_bf16(st[2 * kg + 1][2], st[2 * kg + 1][3]);
      pb[kg] = r.v8;
    }
#pragma unroll
    for (int db = 0; db < 4; ++db)
#pragma unroll
      for (int kg = 0; kg < 2; ++kg) {
        const bf16x8 vf = *(const bf16x8*)(sV + (db * 16 + fr) * 128 + (((kg * 4 + fq) ^ sw) << 4));
        o[db] = mfma16(vf, pb[kg], o[db]);
      }
  }
  lsum += __shfl_xor(lsum, 16);
  lsum += __shfl_xor(lsum, 32);
  if (a.has_sink) lsum += __expf(a.sink - mrun);
  const float inv = frcp(lsum);
  bf16_t* op = a.o + (size_t)(wid * 16 + fr) * 1024 + fq * 4;
#pragma unroll
  for (int db = 0; db < 4; ++db) {
    uint2 v;
    v.x = pk_bf16(o[db][0] * inv, o[db][1] * inv);
    v.y = pk_bf16(o[db][2] * inv, o[db][3] * inv);
    *(uint2*)(op + db * 16) = v;
  }
}

constexpr int U_LSCAN = 96, U_CSCAN = 384, U_LATB = 192, U_LATA = 128, U_CTX = 1280;
constexpr int U_TOTAL = U_LSCAN + U_CSCAN + U_LATB + U_LATA + U_CTX;

__device__ __forceinline__ void mix_phase(const Params& p, int slot, int l, unsigned char* smem, int ulo = 0, int uhi = U_TOTAL) {
  unsigned* cnt = (unsigned*)(p.ws + WS_CNT) + slot * 8;
  int* s_u = (int*)(smem + SMEM_CTL);
  const bf16_t* QK = (const bf16_t*)(p.ws + WS_QK);
  const bf16_t* VT = (const bf16_t*)(p.ws + WS_VT);
  bf16_t* MIX = (bf16_t*)(p.ws + WS_H);
  for (;;) {
    __syncthreads();
    if (opq_tid() == 0) *s_u = (int)atomicAdd(cnt, 1u);
    __syncthreads();
    int u = *s_u + ulo;
    if (u >= uhi) break;
    if (u < U_LSCAN) {
      const int chain = u >> 2, part = u & 3;
      const int b = chain / 12, h = (chain % 12) >> 1, d = chain & 1;
      const float* init = p.state_c + ((((size_t)b * 2 + l) * 2 + d) * 6 + h) * 4096;
      scan_unit<1>(p, l, M_CTX + b * 1024, 1024, h, d, part * 16, init, nullptr, smem);
      continue;
    }
    u -= U_LSCAN;
    if (u < U_CSCAN) {
      const int b = u / 12, h = (u % 12) >> 1, d = u & 1;
      float* fin = p.out + OUT_ST + ((((size_t)b * 2 + l) * 2 + d) * 6 + h) * 4096;
      scan_unit8(p, l, b * 256, 256, h, d, fin, smem);
      continue;
    }
    u -= U_CSCAN;
    AttnDesc a;
    if (u < U_LATB) {
      const int b = u / 96, h = (u % 96) >> 4, qb = u & 15, kvh = h / 3;
      const int r0 = M_CTX + b * 1024;
      a.q = QK + (size_t)(r0 + qb * 64) * 896 + 384 + h * 64;
      a.kloc = QK + (size_t)r0 * 896 + 768 + kvh * 64;
      a.vloc = VT + (size_t)((2 + kvh) * 64) * MTOT + r0;
      a.kctx = (const bf16_t*)(p.ws + WS_CKB) + (size_t)((b * 2 + l) * 2 + kvh) * 16384;
      a.vctx = (const bf16_t*)(p.ws + WS_CVTB) + (size_t)((b * 2 + l) * 2 + kvh) * 16384;
      a.o = MIX + (size_t)(r0 + qb * 64) * 1024 + 256 + h * 64;
      a.qpos0 = qb * 64; a.lo = 0; a.hi = 15; a.window = 0; a.sink = 0.f; a.has_sink = 0;
    } else if (u < U_LATB + U_LATA) {
      u -= U_LATB;
      const int b = u >> 6, h = (u & 63) >> 4, qb = u & 15, kvh = h >> 1;
      const int r0 = M_CTX + b * 1024;
      a.q = QK + (size_t)(r0 + qb * 64) * 896 + h * 64;
      a.kloc = QK + (size_t)r0 * 896 + 256 + kvh * 64;
      a.vloc = VT + (size_t)(kvh * 64) * MTOT + r0;
      a.kctx = (const bf16_t*)(p.ws + WS_CKA) + (size_t)((b * 2 + l) * 2 + kvh) * 16384;
      a.vctx = (const bf16_t*)(p.ws + WS_CVTA) + (size_t)((b * 2 + l) * 2 + kvh) * 16384;
      a.o = MIX + (size_t)(r0 + qb * 64) * 1024 + h * 64;
      a.qpos0 = qb * 64; a.lo = qb - 2 < 0 ? 0 : qb - 2; a.hi = qb + 2 > 15 ? 15 : qb + 2; a.window = 1;
      a.sink = p.a_sink[l * 4 + h]; a.has_sink = 1;
    } else {
      u -= U_LATB + U_LATA;
      const int b = u / 40, rem = u % 40, hh = rem >> 2, qb = rem & 3;
      const int r0 = b * 256;
      a.kctx = nullptr; a.vctx = nullptr;
      a.qpos0 = qb * 64; a.lo = 0; a.hi = 3; a.window = 0;
      if (hh < 4) {
        const int h = hh, kvh = h >> 1;
        a.q = QK + (size_t)(r0 + qb * 64) * 896 + h * 64;
        a.kloc = QK + (size_t)r0 * 896 + 256 + kvh * 64;
        a.vloc = VT + (size_t)(kvh * 64) * MTOT + r0;
        a.o = MIX + (size_t)(r0 + qb * 64) * 1024 + h * 64;
        a.sink = p.a_sink[l * 4 + h]; a.has_sink = 1;
      } else {
        const int h = hh - 4, kvh = h / 3;
        a.q = QK + (size_t)(r0 + qb * 64) * 896 + 384 + h * 64;
        a.kloc = QK + (size_t)r0 * 896 + 768 + kvh * 64;
        a.vloc = VT + (size_t)((2 + kvh) * 64) * MTOT + r0;
        a.o = MIX + (size_t)(r0 + qb * 64) * 1024 + 256 + h * 64;
        a.sink = 0.f; a.has_sink = 0;
      }
    }
    attn_unit(a, smem);
  }
}

__device__ __forceinline__ void post_phase(const Params& p, int l) {
  const int tid_ = opq_tid(); const int lane = tid_ & 63, wave = tid_ >> 6;
  const bf16_t* Y = (const bf16_t*)(p.ws + WS_Y);
  const bf16_t* Gb = (const bf16_t*)(p.ws + WS_G);
  const float* BON = (const float*)(p.ws + WS_BON);
  const float* CZ = (const float*)(p.ws + WS_CZ);
  bf16_t* MIX = (bf16_t*)(p.ws + WS_H);
  for (int row = opq_bid() * 4 + wave; row < MTOT; row += gridDim.x * 4) {
#pragma unroll
    for (int h = 0; h < 6; ++h) {
      const int col = h * 64 + lane;
      const float y = bf2f(Y[(size_t)row * 384 + col]) + bf2f(Y[((size_t)MTOT + row) * 384 + col]);
      const float mu = wave_sum(y) * (1.f / 64.f);
      const float dv = y - mu;
      const float var = wave_sum(dv * dv) * (1.f / 64.f);
      const float yn = dv * __builtin_amdgcn_rsqf(var + 64e-5f);
      const float vv = CZ[(size_t)row * 1408 + 768 + col];
      const float o = (yn * p.c_ln_w[l * 384 + col] + p.c_ln_b[l * 384 + col] + BON[(size_t)row * 8 + h] * vv) *
                      bf2f(Gb[(size_t)row * 384 + col]);
      MIX[(size_t)row * 1024 + 640 + col] = f2bf(o);
    }
  }
}


#define XB_TMO      128
#define XB_XCNT(j)  (256  + 64 * (j))
#define XB_XSUB(j)  (1280 + 64 * (j))
#define XB_XGEN(j)  (2304 + 64 * (j))
#define XB_TOP      3328
#define XB_TOPGEN   3392
#define XCD_BAR_WORDS 3456
#define XB_SPIN_CAP (1u << 22)
#define LAS __attribute__((address_space(3)))
__device__ __forceinline__ unsigned xb_ld(unsigned* p)              { return __hip_atomic_load(p, __ATOMIC_RELAXED, __HIP_MEMORY_SCOPE_AGENT); }
__device__ __forceinline__ unsigned xb_add(unsigned* p, unsigned v) { return __hip_atomic_fetch_add(p, v, __ATOMIC_RELAXED, __HIP_MEMORY_SCOPE_AGENT); }
__device__ __forceinline__ unsigned xb_xcc_id() { return (unsigned)__builtin_amdgcn_s_getreg((3 << 11) | 20) & 0xFu; }
#define XB_SPIN(cond, bar) do { unsigned _sp = 0; while (cond) { __builtin_amdgcn_s_sleep(1); \
    if ((++_sp & 255u) == 0u) { if (xb_ld(&(bar)[XB_TMO])) break; if (_sp > XB_SPIN_CAP) { atomicAdd(&(bar)[XB_TMO], 1u); break; } } } } while (0)
struct XcdBarrier { unsigned* bar; unsigned x; volatile LAS unsigned* st; };
__device__ __forceinline__ XcdBarrier xcd_barrier_post(unsigned* bar, volatile LAS unsigned* st) {
  XcdBarrier b; b.bar = bar; b.x = xb_xcc_id(); b.st = st;
  if (threadIdx.x == 0) (void)xb_add(&bar[XB_XCNT(b.x)], 1u);
  return b;
}
__device__ __forceinline__ void xcd_barrier_complete(unsigned* bar, unsigned x, unsigned& nloc, unsigned& nx) {
  const unsigned G = gridDim.x * gridDim.y * gridDim.z;
  unsigned sum, cnt, mine, sp = 0u;
  for (;;) {
    sum = 0u; cnt = 0u; mine = 0u;
#pragma unroll
    for (unsigned j = 0; j < 16; ++j) { const unsigned c = xb_ld(&bar[XB_XCNT(j)]); sum += c; cnt += (c > 0u) ? 1u : 0u; mine = (j == x) ? c : mine; }
    if (sum == G) break;
    __builtin_amdgcn_s_sleep(1);
    if ((++sp & 255u) == 0u) { if (xb_ld(&bar[XB_TMO])) break; if (sp > XB_SPIN_CAP) { atomicAdd(&bar[XB_TMO], 1u); break; } }
  }
  nloc = mine > 0u ? mine : 1u; nx = cnt > 0u ? cnt : 1u;
}
__device__ __forceinline__ void xcd_barrier(const XcdBarrier& b) {
  asm volatile("s_waitcnt vmcnt(0)" ::: "memory");
  __syncthreads();
  if (threadIdx.x == 0) {
    unsigned* bar = b.bar;
    __builtin_amdgcn_s_waitcnt(0);
    unsigned nloc = b.st[0], nx = b.st[1];
    if (nloc == 0u) { xcd_barrier_complete(bar, b.x, nloc, nx); b.st[0] = nloc; b.st[1] = nx; }
    const unsigned old = xb_add(&bar[XB_XSUB(b.x)], 1u);
    const unsigned gen = old / nloc;
    if (old + 1u == (gen + 1u) * nloc) {
      __builtin_amdgcn_fence(__ATOMIC_RELEASE, "agent");
      asm volatile("s_waitcnt vmcnt(0)" ::: "memory");
      const unsigned og = xb_add(&bar[XB_TOP], 1u);
      const unsigned tg = og / nx;
      if (og + 1u == (tg + 1u) * nx) xb_add(&bar[XB_TOPGEN], 1u);
      else XB_SPIN(xb_ld(&bar[XB_TOPGEN]) == tg, bar);
      __builtin_amdgcn_fence(__ATOMIC_ACQUIRE, "agent");
      xb_add(&bar[XB_XGEN(b.x)], 1u);
      asm volatile("s_waitcnt vmcnt(0)" ::: "memory");
    } else {
      XB_SPIN(xb_ld(&bar[XB_XGEN(b.x)]) == gen, bar);
      __builtin_amdgcn_fence(__ATOMIC_ACQUIRE, "agent");
      asm volatile("s_waitcnt vmcnt(0)" ::: "memory");
    }
  }
  __syncthreads();
}

__device__ __forceinline__ void run_phase(const Params& p, int ph, unsigned char* smem) {
  if (ph == 0) { phase0(p, smem); return; }
  if (ph == NPHASE - 1) { rpass(p, 2, 1); return; }
  const int l = (ph - 1) / 9, s = (ph - 1) % 9;
  const bf16_t* H = (const bf16_t*)(p.ws + WS_H);
  switch (s) {
    case 0: if (l == 0) rpass(p, 0, 0); else rpass(p, 2, 0); break;
    case 1: gemm_phase<0>(p, l, H, D, (const bf16_t*)(p.ws + WS_WT_IN) + (size_t)l * IN_COLS * D, D, IN_COLS, D, smem); break;
    case 2: prep_phase(p, l, smem); break;
    case 3: mix_phase(p, l * 2, l, smem); break;
    case 4: post_phase(p, l); break;
    case 5: gemm_phase<1>(p, l, H, D, (const bf16_t*)(p.ws + WS_WT_OUT) + (size_t)l * D * D, D, D, D, smem); break;
    case 6: rpass(p, 1, l); break;
    case 7: gemm_phase<2>(p, l, H, D, (const bf16_t*)(p.ws + WS_WT_GU) + (size_t)l * GU * D, D, GU, D, smem); break;
    case 8: gemm_phase<1>(p, l, (const bf16_t*)(p.ws + WS_CZ), FF, (const bf16_t*)(p.ws + WS_WT_DN) + (size_t)l * D * FF, FF, D, FF, smem); break;
  }
}

#if N_LAUNCH_MODE == 0
__global__ void __launch_bounds__(256, 2) fwd_phases(Params p) {
  extern __shared__ __attribute__((aligned(16))) unsigned char smem[];
  run_phase(p, p.ph_lo, smem);
}
#define FWD_KERNEL fwd_phases
#else
template <int L>
__device__ __forceinline__ void layer_phases(const Params& p, unsigned char* smem, const XcdBarrier& xb) {
  const bf16_t* H = (const bf16_t*)(p.ws + WS_H);
  if (L == 0) {
#pragma unroll
    for (int rep = 0; rep < REP_R0; ++rep) rpass(p, 0, 0);
  } else rpass(p, 2, 0);
  xcd_barrier(xb);
#pragma unroll
  for (int rep = 0; rep < REP_GEMM; ++rep) {
    gemm_phase<0>(p, L, H, D, (const bf16_t*)(p.ws + WS_WT_IN) + (size_t)L * IN_COLS * D, D, IN_COLS, D, smem);
    xcd_barrier(xb);
  }
#pragma unroll
  for (int rep = 0; rep < REP_OTHER * REP_PREP; ++rep) {
    prep_phase(p, L, smem);
    xcd_barrier(xb);
  }
#if MIX_SPLIT
#pragma unroll
  for (int rep = 0; rep < REP_MA; ++rep) { mix_phase(p, L * 4 + 0 + 0 * rep, L, smem, 0, U_LSCAN); xcd_barrier(xb); if (rep + 1 < REP_MA) { if (threadIdx.x == 0 && blockIdx.x == 0) ((unsigned*)(p.ws + WS_CNT))[(L * 4 + 0) * 8] = 0u; xcd_barrier(xb); } }
#pragma unroll
  for (int rep = 0; rep < REP_MB; ++rep) { mix_phase(p, L * 4 + 1, L, smem, U_LSCAN, U_LSCAN + U_CSCAN); xcd_barrier(xb); if (rep + 1 < REP_MB) { if (threadIdx.x == 0 && blockIdx.x == 0) ((unsigned*)(p.ws + WS_CNT))[(L * 4 + 1) * 8] = 0u; xcd_barrier(xb); } }
#pragma unroll
  for (int rep = 0; rep < REP_MC; ++rep) { mix_phase(p, L * 4 + 2, L, smem, U_LSCAN + U_CSCAN, U_TOTAL); xcd_barrier(xb); if (rep + 1 < REP_MC) { if (threadIdx.x == 0 && blockIdx.x == 0) ((unsigned*)(p.ws + WS_CNT))[(L * 4 + 2) * 8] = 0u; xcd_barrier(xb); } }
#else
#pragma unroll
  for (int rep = 0; rep < REP_MIX; ++rep) {
    mix_phase(p, L * 2 + rep, L, smem);
    xcd_barrier(xb);
  }
#endif
#pragma unroll
  for (int rep = 0; rep < REP_OTHER; ++rep) {
    post_phase(p, L);
    xcd_barrier(xb);
  }
#pragma unroll
  for (int rep = 0; rep < REP_GEMM; ++rep) {
    gemm160_phase(p, H, D, (const bf16_t*)(p.ws + WS_WT_OUT) + (size_t)L * D * D, D, D, smem);
    xcd_barrier(xb);
  }
  rpass(p, 1, L);
  xcd_barrier(xb);
#pragma unroll
  for (int rep = 0; rep < REP_GEMM; ++rep) {
    gemm_phase<2>(p, L, H, D, (const bf16_t*)(p.ws + WS_WT_GU) + (size_t)L * GU * D, D, GU, D, smem);
    xcd_barrier(xb);
  }
#pragma unroll
  for (int rep = 0; rep < REP_GEMM; ++rep) {
    gemm160_phase(p, (const bf16_t*)(p.ws + WS_CZ), FF, (const bf16_t*)(p.ws + WS_WT_DN) + (size_t)L * D * FF, FF, FF, smem);
    xcd_barrier(xb);
  }
}
__global__ void __launch_bounds__(256, 2) fwd_mega(Params p) {
  extern __shared__ __attribute__((aligned(16))) unsigned char smem[];
  if (threadIdx.x == 0) { *(unsigned*)(smem + SMEM_CTL + 8) = 0u; *(unsigned*)(smem + SMEM_CTL + 12) = 0u; }
  __syncthreads();
  XcdBarrier xb = xcd_barrier_post((unsigned*)(p.ws + WS_BAR), (volatile LAS unsigned*)(smem + SMEM_CTL + 8));
#pragma unroll
  for (int rep = 0; rep < REP_P0; ++rep) phase0(p, smem);
#pragma unroll
  for (int rep = 0; rep < REP_BAR; ++rep) xcd_barrier(xb);
#if USE_CG_SYNC
  cg::this_grid().sync();
#else
  if (p.ph_hi < 0) cg::this_grid().sync();
  xcd_barrier(xb);
#endif
  layer_phases<0>(p, smem, xb);
  layer_phases<1>(p, smem, xb);
  rpass(p, 2, 1);
}
#define FWD_KERNEL fwd_mega
#endif

extern "C" void kernel_launch(void* const* d_in, const int* in_sizes, int n_in, void* d_out, int out_size, void* d_ws,
                              size_t ws_size, hipStream_t stream) {
  static int grid_blocks = 0;
  if (!grid_blocks) {
    int dev = 0, cus = 0, per_cu = 0;
    (void)hipGetDevice(&dev);
    (void)hipDeviceGetAttribute(&cus, hipDeviceAttributeMultiprocessorCount, dev);
    (void)hipFuncSetAttribute((const void*)FWD_KERNEL, hipFuncAttributeMaxDynamicSharedMemorySize, SMEM_BYTES);
    (void)hipOccupancyMaxActiveBlocksPerMultiprocessor(&per_cu, (const void*)FWD_KERNEL, 256, SMEM_BYTES);
    if (per_cu > 2) per_cu = 2;
    if (per_cu < 1) per_cu = 1;
    grid_blocks = cus * per_cu;
    if (n_in != 32 || ws_size < WS_END) {
      fprintf(stderr, "kernel_launch: unexpected n_in %d or ws_size %zu (< %zu)\n", n_in, ws_size, (size_t)WS_END);
      grid_blocks = -1;
    }
  }
  if (grid_blocks < 0) return;
  Params p{};
  const float** pp = (const float**)&p;
  for (int i = 0; i < 32; ++i) pp[i] = (const float*)d_in[i];
  p.out = (float*)d_out;
  p.ws = (unsigned char*)d_ws;
#if N_LAUNCH_MODE
  p.ph_lo = 0; p.ph_hi = NPHASE;
  (void)hipMemsetAsync((unsigned char*)d_ws + WS_BAR, 0, 16384, stream);
  void* args[] = {&p};
  hipError_t e = hipLaunchCooperativeKernel((const void*)fwd_mega, dim3(grid_blocks), dim3(256), args, SMEM_BYTES, stream);
  if (e != hipSuccess) fprintf(stderr, "cooperative launch failed: %s (grid %d)\n", hipGetErrorString(e), grid_blocks);
#else
  for (int ph = 0; ph < NPHASE; ++ph) {
    p.ph_lo = ph; p.ph_hi = ph + 1;
    hipLaunchKernelGGL(fwd_phases, dim3(grid_blocks), dim3(256), SMEM_BYTES, stream, p);
  }
#endif
}
```

```cpp
#include <hip/hip_runtime.h>
#include <hip/hip_bf16.h>
#include <hip/hip_cooperative_groups.h>
#include <cstdio>
#include <cstdint>
namespace cg = cooperative_groups;

typedef unsigned short bf16_t;
using bf16x8 = __attribute__((ext_vector_type(8))) short;
using f32x4 = __attribute__((ext_vector_type(4))) float;

#ifndef REP_GEMM
#define REP_GEMM 1
#endif
#ifndef REP_MIX
#define REP_MIX 1
#endif
#ifndef REP_P0
#define REP_P0 1
#endif
#ifndef REP_R0
#define REP_R0 1
#endif
#ifndef REP_BAR
#define REP_BAR 0
#endif
#ifndef REP_PREP
#define REP_PREP 1
#endif
#ifndef MIX_SPLIT
#define MIX_SPLIT 0
#endif
#ifndef REP_MA
#define REP_MA 1
#endif
#ifndef REP_MB
#define REP_MB 1
#endif
#ifndef REP_MC
#define REP_MC 1
#endif
#ifndef REP_OTHER
#define REP_OTHER 1
#endif
#ifndef USE_CG_SYNC
#define USE_CG_SYNC 0
#endif
#ifndef N_LAUNCH_MODE
#define N_LAUNCH_MODE 1
#endif

constexpr int D = 1024, M_CTX = 8192, M_LAT = 2048, MTOT = 10240;
constexpr int IN_COLS = 2560, FF = 2816, GU = 5632;
constexpr int NPHASE = 20;
constexpr int SMEM_CTL = 73728;
constexpr int SMEM_BYTES = SMEM_CTL + 64;

constexpr size_t al256(size_t x) { return (x + 255) & ~(size_t)255; }
constexpr size_t WS_WT_IN = 0;
constexpr size_t WS_WT_OUT = WS_WT_IN + (size_t)2 * IN_COLS * D * 2;
constexpr size_t WS_WT_GU = WS_WT_OUT + (size_t)2 * D * D * 2;
constexpr size_t WS_WT_DN = WS_WT_GU + (size_t)2 * GU * D * 2;
constexpr size_t WS_WUPT = WS_WT_DN + (size_t)2 * D * FF * 2;
constexpr size_t WS_AUPT = WS_WUPT + (size_t)4 * 384 * 64 * 2;
constexpr size_t WS_GUPT = WS_AUPT + (size_t)4 * 384 * 64 * 2;
constexpr size_t WS_MOD = WS_GUPT + (size_t)2 * 384 * 128 * 2;
constexpr size_t WS_ROPE = WS_MOD + (size_t)2 * 3 * 6144 * 4;
constexpr size_t WS_CKA = WS_ROPE + (size_t)1024 * 32 * 2 * 4;
constexpr size_t WS_CVTA = WS_CKA + (size_t)131072 * 2;
constexpr size_t WS_CKB = WS_CVTA + (size_t)131072 * 2;
constexpr size_t WS_CVTB = WS_CKB + (size_t)131072 * 2;
constexpr size_t WS_CNT = WS_CVTB + (size_t)131072 * 2;
constexpr size_t WS_BAR = WS_CNT + 256;
constexpr size_t WS_H = WS_BAR + 16384;
constexpr size_t WS_QK = WS_H + (size_t)MTOT * D * 2;
constexpr size_t WS_VT = WS_QK + (size_t)MTOT * 896 * 2;
constexpr size_t WS_CZ = WS_VT + (size_t)4 * 64 * MTOT * 2;
constexpr size_t WS_DEC = WS_CZ + (size_t)MTOT * 1408 * 4;
constexpr size_t WS_KT = WS_DEC + (size_t)2 * MTOT * 384 * 4;
constexpr size_t WS_BB = WS_KT + (size_t)2 * MTOT * 384 * 2;
constexpr size_t WS_KK = WS_BB + (size_t)2 * MTOT * 384 * 2;
constexpr size_t WS_G = WS_KK + (size_t)MTOT * 384 * 2;
constexpr size_t WS_BON = WS_G + (size_t)MTOT * 384 * 2;
constexpr size_t WS_Y = WS_BON + (size_t)MTOT * 8 * 4;
constexpr size_t WS_PA = WS_Y + (size_t)2 * MTOT * 384 * 2;
constexpr size_t WS_END = WS_PA + (size_t)MTOT * 256 * 2;
static_assert((size_t)MTOT * D * 4 <= (WS_BB - WS_DEC), "O alias");
static_assert(WS_END <= (size_t)256 * 1024 * 1024, "workspace too big");

constexpr size_t OUT_X = 0;
constexpr size_t OUT_AK = (size_t)MTOT * D;
constexpr size_t OUT_AV = OUT_AK + 2097152;
constexpr size_t OUT_BK = OUT_AV + 2097152;
constexpr size_t OUT_BV = OUT_BK + 2097152;
constexpr size_t OUT_ST = OUT_BV + 2097152;

struct Params {
  const float *x_prompt, *x_sample, *cache_a_k, *cache_a_v, *cache_b_k, *cache_b_v, *state_c, *c, *c_ctx,
      *w_mod, *b_mod, *norm_mix_pre, *norm_mix_post, *norm_ffn_pre, *norm_ffn_post, *w_in, *w_out, *a_sink,
      *b_q_norm, *b_k_norm, *c_w0, *c_w_up, *c_a0, *c_a_up, *c_g_up, *c_k_k, *c_k_a, *c_r_k, *c_ln_w, *c_ln_b,
      *w_gu, *w_down;
  float* out;
  unsigned char* ws;
  int ph_lo, ph_hi;
};

typedef __bf16 bf16x2_t __attribute__((ext_vector_type(2)));
typedef float f32x2_t __attribute__((ext_vector_type(2)));
__device__ __forceinline__ unsigned pk_bf16(float lo, float hi) {
  f32x2_t f = {lo, hi};
  bf16x2_t b = __builtin_convertvector(f, bf16x2_t);
  return __builtin_bit_cast(unsigned, b);
}
__device__ __forceinline__ bf16_t f2bf(float f) { return (bf16_t)(pk_bf16(f, 0.f) & 0xffffu); }
__device__ __forceinline__ float bf2f(bf16_t b) { return __uint_as_float(((unsigned)b) << 16); }
__device__ __forceinline__ float bflo(unsigned u) { return __uint_as_float(u << 16); }
__device__ __forceinline__ float bfhi(unsigned u) { return __uint_as_float(u & 0xffff0000u); }
__device__ __forceinline__ int opq_tid() { int x = threadIdx.x; asm volatile("" : "+v"(x)); return x; }
__device__ __forceinline__ int opq_bid() { int x = blockIdx.x; asm volatile("" : "+s"(x)); return x; }
__device__ __forceinline__ float4 cvt4(uint2 u) { return make_float4(bflo(u.x), bfhi(u.x), bflo(u.y), bfhi(u.y)); }
__device__ __forceinline__ float frcp(float x) { return __builtin_amdgcn_rcpf(x); }
__device__ __forceinline__ float sigmoidf_(float x) { return frcp(1.f + __expf(-x)); }
template <int CTRL>
__device__ __forceinline__ float dppf(float x) {
  return __builtin_bit_cast(float, __builtin_amdgcn_mov_dpp(__builtin_bit_cast(int, x), CTRL, 0xf, 0xf, true));
}
constexpr int DPP_XOR1 = 0xB1, DPP_XOR2 = 0x4E, DPP_ROR4 = 0x124, DPP_ROR8 = 0x128;
__device__ __forceinline__ float row16_sum(float v) {
  v += dppf<DPP_XOR1>(v);
  v += dppf<DPP_XOR2>(v);
  v += dppf<DPP_ROR4>(v);
  v += dppf<DPP_ROR8>(v);
  return v;
}
__device__ __forceinline__ float wave_sum(float v) {
  v = row16_sum(v);
  const float r0 = __builtin_bit_cast(float, __builtin_amdgcn_readlane(__builtin_bit_cast(int, v), 0));
  const float r1 = __builtin_bit_cast(float, __builtin_amdgcn_readlane(__builtin_bit_cast(int, v), 16));
  const float r2 = __builtin_bit_cast(float, __builtin_amdgcn_readlane(__builtin_bit_cast(int, v), 32));
  const float r3 = __builtin_bit_cast(float, __builtin_amdgcn_readlane(__builtin_bit_cast(int, v), 48));
  return (r0 + r1) + (r2 + r3);
}
__device__ __forceinline__ f32x4 mfma16(bf16x8 a, bf16x8 b, f32x4 c) {
  return __builtin_amdgcn_mfma_f32_16x16x32_bf16(a, b, c, 0, 0, 0);
}

__device__ __forceinline__ void transpose_tile(const float* __restrict__ src, int K, int N, bf16_t* __restrict__ dst,
                                               int tile, bool perm, float* lds) {
  const int nkt = K / 64, nnt = N / 64, per = nkt * nnt;
  const int lyr = tile / per, r = tile % per, kt = r / nnt, nt = r % nnt;
  src += (size_t)lyr * K * N;
  dst += (size_t)lyr * K * N;
  const int tid = opq_tid();
#pragma unroll
  for (int i = 0; i < 16; ++i) {
    const int row = (tid >> 6) + 4 * i;
    lds[row * 65 + (tid & 63)] = src[(size_t)(kt * 64 + row) * N + nt * 64 + (tid & 63)];
  }
  __syncthreads();
#pragma unroll
  for (int it = 0; it < 2; ++it) {
    const int idx = tid + it * 256, n = idx >> 3, kc = idx & 7;
    uint4 v;
    v.x = pk_bf16(lds[(kc * 8 + 0) * 65 + n], lds[(kc * 8 + 1) * 65 + n]);
    v.y = pk_bf16(lds[(kc * 8 + 2) * 65 + n], lds[(kc * 8 + 3) * 65 + n]);
    v.z = pk_bf16(lds[(kc * 8 + 4) * 65 + n], lds[(kc * 8 + 5) * 65 + n]);
    v.w = pk_bf16(lds[(kc * 8 + 6) * 65 + n], lds[(kc * 8 + 7) * 65 + n]);
    const int col = nt * 64 + n;
    int prow = col;
    if (perm) {
      if (col < FF) prow = (col >> 5) * 64 + (col & 31);
      else { const int c2 = col - FF; prow = (c2 >> 5) * 64 + 32 + (c2 & 31); }
    }
    *(uint4*)(dst + (size_t)prow * K + kt * 64 + kc * 8) = v;
  }
  __syncthreads();
}

__device__ __forceinline__ void gemv_item(const Params& p, int item, float* lds) {
  const int l = item / 192, n0 = (item % 192) * 32;
  const int tid = opq_tid();
  float* s_c = lds;
  float* red = lds + 3072;
  for (int i = tid; i < 3072; i += 256) {
    const int ci = i >> 10, k = i & 1023;
    const float x = (ci == 0) ? p.c_ctx[k] : p.c[(ci - 1) * 1024 + k];
    s_c[i] = x * sigmoidf_(x);
  }
  __syncthreads();
  const int kg = tid >> 5, col = tid & 31;
  const float* w = p.w_mod + (size_t)l * 1024 * 6144 + (size_t)(kg * 128) * 6144 + n0 + col;
  float a0 = 0.f, a1 = 0.f, a2 = 0.f;
#pragma unroll 32
  for (int k = 0; k < 128; ++k) {
    const float wv = __builtin_nontemporal_load(w + (size_t)k * 6144);
    a0 += s_c[kg * 128 + k] * wv;
    a1 += s_c[1024 + kg * 128 + k] * wv;
    a2 += s_c[2048 + kg * 128 + k] * wv;
  }
  red[(kg * 3 + 0) * 32 + col] = a0;
  red[(kg * 3 + 1) * 32 + col] = a1;
  red[(kg * 3 + 2) * 32 + col] = a2;
  __syncthreads();
  if (tid < 96) {
    const int ci = tid >> 5, cc = tid & 31;
    float sum = p.b_mod[l * 6144 + n0 + cc];
#pragma unroll
    for (int g = 0; g < 8; ++g) sum += red[(g * 3 + ci) * 32 + cc];
    ((float*)(p.ws + WS_MOD))[(l * 3 + ci) * 6144 + n0 + cc] = sum;
  }
  __syncthreads();
}

constexpr int WL_IN = 16 * 40, WL_OUT = 16 * 16, WL_GU = 16 * 88, WL_DN = 44 * 16, WL_UP = 2 * 6, WL_G = 2 * 6;
constexpr int WL_TOTAL = WL_IN + WL_OUT + WL_GU + WL_DN + 2 * WL_UP + WL_G;
__device__ __forceinline__ void weight_item(const Params& p, int layer, int r, float* lds) {
  if (r < WL_IN) { transpose_tile(p.w_in, 1024, IN_COLS, (bf16_t*)(p.ws + WS_WT_IN), layer * WL_IN + r, false, lds); return; }
  r -= WL_IN;
  if (r < WL_OUT) { transpose_tile(p.w_out, 1024, 1024, (bf16_t*)(p.ws + WS_WT_OUT), layer * WL_OUT + r, false, lds); return; }
  r -= WL_OUT;
  if (r < WL_GU) { transpose_tile(p.w_gu, 1024, GU, (bf16_t*)(p.ws + WS_WT_GU), layer * WL_GU + r, true, lds); return; }
  r -= WL_GU;
  if (r < WL_DN) { transpose_tile(p.w_down, FF, 1024, (bf16_t*)(p.ws + WS_WT_DN), layer * WL_DN + r, false, lds); return; }
  r -= WL_DN;
  if (r < WL_UP) { transpose_tile(p.c_w_up, 64, 384, (bf16_t*)(p.ws + WS_WUPT), layer * WL_UP + r, false, lds); return; }
  r -= WL_UP;
  if (r < WL_UP) { transpose_tile(p.c_a_up, 64, 384, (bf16_t*)(p.ws + WS_AUPT), layer * WL_UP + r, false, lds); return; }
  r -= WL_UP;
  transpose_tile(p.c_g_up, 128, 384, (bf16_t*)(p.ws + WS_GUPT), layer * WL_G + r, false, lds);
}

constexpr int P0_GEMV = 384;
constexpr int P0_ROPE = 128, P0_CACHE = 256;
constexpr int P0_TOTAL = P0_GEMV + WL_TOTAL + P0_ROPE + P0_CACHE;

__device__ __forceinline__ void phase0(const Params& p, unsigned char* smem) {
  float* lds = (float*)smem;
  const int tid = opq_tid();
  const int bid = opq_bid();
  if (bid == 0 && tid < 64) ((unsigned*)(p.ws + WS_CNT))[tid] = 0u;
  for (int it = bid; it < P0_TOTAL; it += gridDim.x) {
    int r = it;
    if (r < P0_GEMV) { gemv_item(p, r, lds); continue; }
    r -= P0_GEMV;
    if (r < WL_TOTAL) { weight_item(p, 0, r, lds); continue; }
    r -= WL_TOTAL;
    if (r < P0_ROPE) {
      const int idx = r * 256 + tid, t = idx >> 5, i = idx & 31, fi = i & 15;
      const float pos = (i < 16) ? (float)(t >> 6) : (float)(t & 63);
      const float freq = exp2f(-(float)fi * (13.287712379549449f / 16.f));
      float rev = pos * freq * 0.15915494309189535f;
      rev -= floorf(rev);
      float2 cs;
      cs.x = __builtin_amdgcn_cosf(rev);
      cs.y = __builtin_amdgcn_sinf(rev);
      ((float2*)(p.ws + WS_ROPE))[idx] = cs;
      continue;
    }
    r -= P0_ROPE;
    {
#pragma unroll
      for (int j = 0; j < 8; ++j) {
        const int idx = r * 2048 + j * 256 + tid;
        const int tensor = idx >> 17, e = idx & 131071;
        const float* src = tensor == 0 ? p.cache_a_k : tensor == 1 ? p.cache_a_v : tensor == 2 ? p.cache_b_k : p.cache_b_v;
        bf16_t* dst = (bf16_t*)(p.ws + (tensor == 0 ? WS_CKA : tensor == 1 ? WS_CVTA : tensor == 2 ? WS_CKB : WS_CVTB));
        int b, l, h, t, d;
        if ((tensor & 1) == 0) { d = e & 63; t = (e >> 6) & 255; h = (e >> 14) & 1; l = (e >> 15) & 1; b = e >> 16; }
        else { t = e & 255; d = (e >> 8) & 63; h = (e >> 14) & 1; l = (e >> 15) & 1; b = e >> 16; }
        dst[e] = f2bf(src[((((size_t)b * 2 + l) * 256 + t) * 2 + h) * 64 + d]);
      }
    }
  }
}

__device__ __forceinline__ void rpass(const Params& p, int mode, int l) {
  const int tid_ = opq_tid(); const int lane = tid_ & 63, wave = tid_ >> 6;
  const float* MOD = (const float*)(p.ws + WS_MOD);
  const bf16_t* O = (const bf16_t*)(p.ws + WS_DEC);
  float* X = p.out + OUT_X;
  bf16_t* H = (bf16_t*)(p.ws + WS_H);
  const int nwaves = gridDim.x * 4, rpw = (MTOT + nwaves - 1) / nwaves;
  const int gw_ = opq_bid() * 4 + wave;
  const int rbeg = gw_ * rpw, rend = (rbeg + rpw < MTOT) ? rbeg + rpw : MTOT;
  const bool has_next = !(mode == 2 && l == 1);
  const int nl = (mode == 2) ? l + 1 : l;
  float4 vgw[4], vgs[4], vsh[4];
  int ci_cur = -1;
  for (int row = rbeg; row < rend; ++row) {
    const int ci = row < M_CTX ? 0 : 1 + ((row - M_CTX) >> 10);
    if (ci != ci_cur) {
      ci_cur = ci;
      if (mode != 0) {
        const float* gate = MOD + (l * 3 + ci) * 6144 + (mode == 1 ? 2 : 5) * 1024;
        const float* gp = (mode == 1 ? p.norm_mix_post : p.norm_ffn_post) + l * D;
#pragma unroll
        for (int j = 0; j < 4; ++j) {
          const float4 g = *(const float4*)(gate + j * 256 + lane * 4);
          const float4 w = *(const float4*)(gp + j * 256 + lane * 4);
          vgw[j] = make_float4(g.x * w.x, g.y * w.y, g.z * w.z, g.w * w.w);
        }
      }
      if (has_next) {
        const float* gpre = (mode == 1 ? p.norm_ffn_pre : p.norm_mix_pre) + nl * D;
        const float* sc = MOD + (nl * 3 + ci) * 6144 + (mode == 1 ? 4 : 1) * 1024;
        const float* sh = MOD + (nl * 3 + ci) * 6144 + (mode == 1 ? 3 : 0) * 1024;
#pragma unroll
        for (int j = 0; j < 4; ++j) {
          const float4 g = *(const float4*)(gpre + j * 256 + lane * 4);
          const float4 s = *(const float4*)(sc + j * 256 + lane * 4);
          vgs[j] = make_float4(g.x * (1.f + s.x), g.y * (1.f + s.y), g.z * (1.f + s.z), g.w * (1.f + s.w));
          vsh[j] = *(const float4*)(sh + j * 256 + lane * 4);
        }
      }
    }
    const float* xs;
    if (mode == 0 || (mode == 1 && l == 0)) xs = row < M_CTX ? p.x_prompt + (size_t)row * D : p.x_sample + (size_t)(row - M_CTX) * D;
    else xs = X + (size_t)row * D;
    float4 x[4];
#pragma unroll
    for (int j = 0; j < 4; ++j) x[j] = *(const float4*)(xs + j * 256 + lane * 4);
    if (mode != 0) {
      float4 o[4];
      float ss = 0.f;
#pragma unroll
      for (int j = 0; j < 4; ++j) {
        o[j] = cvt4(*(const uint2*)(O + (size_t)row * D + j * 256 + lane * 4));
        ss += o[j].x * o[j].x + o[j].y * o[j].y + o[j].z * o[j].z + o[j].w * o[j].w;
      }
      ss = wave_sum(ss);
      const float rs = __builtin_amdgcn_rsqf(ss * (1.f / D) + 1e-6f);
#pragma unroll
      for (int j = 0; j < 4; ++j) {
        x[j].x += vgw[j].x * (o[j].x * rs);
        x[j].y += vgw[j].y * (o[j].y * rs);
        x[j].z += vgw[j].z * (o[j].z * rs);
        x[j].w += vgw[j].w * (o[j].w * rs);
        *(float4*)(X + (size_t)row * D + j * 256 + lane * 4) = x[j];
      }
    }
    if (!has_next) continue;
    float ss2 = 0.f;
#pragma unroll
    for (int j = 0; j < 4; ++j) ss2 += x[j].x * x[j].x + x[j].y * x[j].y + x[j].z * x[j].z + x[j].w * x[j].w;
    ss2 = wave_sum(ss2);
    const float rs2 = __builtin_amdgcn_rsqf(ss2 * (1.f / D) + 1e-6f);
#pragma unroll
    for (int j = 0; j < 4; ++j) {
      const float h0 = x[j].x * rs2 * vgs[j].x + vsh[j].x;
      const float h1 = x[j].y * rs2 * vgs[j].y + vsh[j].y;
      const float h2 = x[j].z * rs2 * vgs[j].z + vsh[j].z;
      const float h3 = x[j].w * rs2 * vgs[j].w + vsh[j].w;
      uint2 v;
      v.x = pk_bf16(h0, h1);
      v.y = pk_bf16(h2, h3);
      *(uint2*)(H + (size_t)row * D + j * 256 + lane * 4) = v;
    }
  }
}

template <int FN>
__device__ __forceinline__ float xform(float t) {
  if (FN == 1) { const float e = __expf(2.f * t); return 1.f - 2.f * frcp(e + 1.f); }
  if (FN == 2) return sigmoidf_(t);
  return t;
}
__device__ __forceinline__ void epi_f32(const Params& p, f32x4 (&acc)[4][4], int rb, int cb, int lane) {
  const int fr = lane & 15, fq = lane >> 4;
  float* O = (float*)(p.ws + WS_DEC);
#pragma unroll
  for (int m = 0; m < 4; ++m)
#pragma unroll
    for (int n = 0; n < 4; ++n)
#pragma unroll
      for (int j = 0; j < 4; ++j) O[(size_t)(rb + m * 16 + fq * 4 + j) * D + cb + n * 16 + fr] = acc[m][n][j];
}

__device__ __forceinline__ void epi_gu(const Params& p, f32x4 (&acc)[4][4], int rb, int cb, int lane) {
  const int fr = lane & 15, fq = lane >> 4;
  bf16_t* ACT = (bf16_t*)(p.ws + WS_CZ);
  const int chunk = cb >> 6;
#pragma unroll
  for (int m = 0; m < 4; ++m)
#pragma unroll
    for (int n = 0; n < 2; ++n)
#pragma unroll
      for (int j = 0; j < 4; ++j) {
        const float g = acc[m][n][j], u = acc[m][n + 2][j];
        const float a = g * sigmoidf_(g) * u;
        ACT[(size_t)(rb + m * 16 + fq * 4 + j) * FF + chunk * 32 + n * 16 + fr] = f2bf(a);
      }
}

template <int MB>
__device__ __forceinline__ void epi_in(const Params& p, int l, f32x4 (&acc)[MB][4], int rb, int cb, int lane) {
  const int fr = lane & 15, fq = lane >> 4;
  const int cidx = cb >> 6;
  const bool lat = rb >= M_CTX;
  if (cidx >= 36) {
    bf16_t* PA = (bf16_t*)(p.ws + WS_PA);
    const int pc = cb - 2304;
#pragma unroll
    for (int m = 0; m < MB; ++m)
#pragma unroll
      for (int n = 0; n < 4; ++n)
#pragma unroll
        for (int j = 0; j < 4; ++j) {
          float t = acc[m][n][j];
          if (cidx == 36) t = xform<1>(t); else if (cidx >= 38) t = xform<2>(t);
          PA[(size_t)(rb + m * 16 + fq * 4 + j) * 256 + pc + n * 16 + fr] = f2bf(t);
        }
    return;
  }
  if (cidx >= 18) {
    float* CZ = (float*)(p.ws + WS_CZ);
    const int cc = cb - 1152;
#pragma unroll
    for (int m = 0; m < MB; ++m)
#pragma unroll
      for (int n = 0; n < 4; ++n)
#pragma unroll
        for (int j = 0; j < 4; ++j) CZ[(size_t)(rb + m * 16 + fq * 4 + j) * 1408 + cc + n * 16 + fr] = acc[m][n][j];
    return;
  }
  if (cidx >= 8 && cidx < 16) {
    const float* gw = (cidx < 14 ? p.b_q_norm : p.b_k_norm) + l * 64;
    float g[4];
#pragma unroll
    for (int n = 0; n < 4; ++n) g[n] = gw[n * 16 + fr];
#pragma unroll
    for (int m = 0; m < MB; ++m)
#pragma unroll
      for (int j = 0; j < 4; ++j) {
        float ss = 0.f;
#pragma unroll
        for (int n = 0; n < 4; ++n) ss += acc[m][n][j] * acc[m][n][j];
        ss = row16_sum(ss);
        const float rs = __builtin_amdgcn_rsqf(ss * (1.f / 64.f) + 1e-6f);
#pragma unroll
        for (int n = 0; n < 4; ++n) acc[m][n][j] *= rs * g[n];
      }
  }
  const bool isv = (cidx == 6 || cidx == 7 || cidx == 16 || cidx == 17);
  if (lat && !isv) {
    const float2* ROPE = (const float2*)(p.ws + WS_ROPE);
#pragma unroll
    for (int m = 0; m < MB; ++m)
#pragma unroll
      for (int j = 0; j < 4; ++j) {
        const int t = (rb + m * 16 + fq * 4 + j - M_CTX) & 1023;
        const float2 a0 = ROPE[t * 32 + fr], a1 = ROPE[t * 32 + 16 + fr];
        float x1 = acc[m][0][j], x2 = acc[m][2][j];
        acc[m][0][j] = x1 * a0.x - x2 * a0.y;
        acc[m][2][j] = x1 * a0.y + x2 * a0.x;
        x1 = acc[m][1][j]; x2 = acc[m][3][j];
        acc[m][1][j] = x1 * a1.x - x2 * a1.y;
        acc[m][3][j] = x1 * a1.y + x2 * a1.x;
      }
  }
  if (!isv) {
    bf16_t* QK = (bf16_t*)(p.ws + WS_QK);
    const int qc = (cidx < 6) ? cb : cb - 128;
#pragma unroll
    for (int m = 0; m < MB; ++m)
#pragma unroll
      for (int n = 0; n < 4; ++n)
#pragma unroll
        for (int j = 0; j < 4; ++j) QK[(size_t)(rb + m * 16 + fq * 4 + j) * 896 + qc + n * 16 + fr] = f2bf(acc[m][n][j]);
    if (!lat && (cidx == 4 || cidx == 5 || cidx == 14 || cidx == 15)) {
      float* dst = p.out + (cidx < 6 ? OUT_AK : OUT_BK);
      const int h = cidx & 1;
#pragma unroll
      for (int m = 0; m < MB; ++m)
#pragma unroll
        for (int n = 0; n < 4; ++n)
#pragma unroll
          for (int j = 0; j < 4; ++j) {
            const int row = rb + m * 16 + fq * 4 + j, b = row >> 8, t = row & 255;
            dst[((((size_t)b * 2 + l) * 256 + t) * 2 + h) * 64 + n * 16 + fr] = acc[m][n][j];
          }
    }
  } else {
    bf16_t* VT = (bf16_t*)(p.ws + WS_VT);
    const int vh = (cidx < 8) ? cidx - 6 : 2 + cidx - 16;
#pragma unroll
    for (int m = 0; m < MB; ++m)
#pragma unroll
      for (int n = 0; n < 4; ++n) {
        uint2 v;
        v.x = pk_bf16(acc[m][n][0], acc[m][n][1]);
        v.y = pk_bf16(acc[m][n][2], acc[m][n][3]);
        *(uint2*)(VT + ((size_t)(vh * 64 + n * 16 + fr)) * MTOT + rb + m * 16 + fq * 4) = v;
      }
    if (!lat) {
      float* dst = p.out + (cidx < 8 ? OUT_AV : OUT_BV);
      const int h = cidx & 1;
#pragma unroll
      for (int m = 0; m < MB; ++m)
#pragma unroll
        for (int n = 0; n < 4; ++n)
#pragma unroll
          for (int j = 0; j < 4; ++j) {
            const int row = rb + m * 16 + fq * 4 + j, b = row >> 8, t = row & 255;
            dst[((((size_t)b * 2 + l) * 256 + t) * 2 + h) * 64 + n * 16 + fr] = acc[m][n][j];
          }
    }
  }
}

__device__ __forceinline__ void gemm64_tile(const Params& p, int l, const bf16_t* __restrict__ A, int lda,
                                            const bf16_t* __restrict__ Bt, int ldb, int K, int brow, int bcol, unsigned char* smem) {
  const int tid = opq_tid(), lane = tid & 63, wid = tid >> 6, fr = lane & 15, fq = lane >> 4;
  const int sw = (fr >> 1) & 7;
  const int nk = K / 64;
  const int lrow = lane >> 3;
  f32x4 acc[1][4];
#pragma unroll
  for (int n = 0; n < 4; ++n) acc[0][n] = (f32x4){0.f, 0.f, 0.f, 0.f};
  const bf16_t* ga = A + (size_t)(brow + wid * 16 + lrow) * lda;
  const bf16_t* gb = Bt + (size_t)(bcol + wid * 16 + lrow) * ldb;
#define GEMM64_STAGE(bufi, kt_)                                                                                   \
  {                                                                                                               \
    unsigned char* sb_ = smem + (bufi) * 16384 + wid * 2048 + lane * 16;                                          \
    _Pragma("unroll") for (int i_ = 0; i_ < 2; ++i_) {                                                            \
      const int c_ = (lane & 7) ^ (((wid * 16 + i_ * 8 + lrow) >> 1) & 7);                                        \
      __builtin_amdgcn_global_load_lds((const unsigned*)(ga + (size_t)(i_ * 8) * lda + (kt_) * 64 + c_ * 8),      \
                                       (unsigned*)(sb_ + i_ * 1024), 16, 0, 0);                                   \
      __builtin_amdgcn_global_load_lds((const unsigned*)(gb + (size_t)(i_ * 8) * ldb + (kt_) * 64 + c_ * 8),      \
                                       (unsigned*)(sb_ + 8192 + i_ * 1024), 16, 0, 0);                            \
    }                                                                                                             \
  }
  __syncthreads();
  GEMM64_STAGE(0, 0);
  for (int kt = 0; kt < nk; ++kt) {
    asm volatile("s_waitcnt vmcnt(0)" ::: "memory");
    __syncthreads();
    if (kt + 1 < nk) GEMM64_STAGE((kt + 1) & 1, kt + 1);
    const unsigned char* sA = smem + (kt & 1) * 16384;
    const unsigned char* sB = sA + 8192;
#pragma unroll
    for (int s = 0; s < 2; ++s) {
      const int co = ((s * 4 + fq) ^ sw) << 4;
      const bf16x8 a = *(const bf16x8*)(sA + (wid * 16 + fr) * 128 + co);
#pragma unroll
      for (int n = 0; n < 4; ++n) {
        const bf16x8 b = *(const bf16x8*)(sB + (n * 16 + fr) * 128 + co);
        acc[0][n] = mfma16(a, b, acc[0][n]);
      }
    }
  }
  epi_in<1>(p, l, acc, brow + wid * 16, bcol, lane);
}

template <int EPI>
__device__ __forceinline__ void gemm_phase(const Params& p, int l, const bf16_t* __restrict__ A, int lda,
                                           const bf16_t* __restrict__ Bt, int ldb, int N, int K, unsigned char* smem) {
  const int tid = opq_tid(), lane = tid & 63, wid = tid >> 6, wr = wid >> 1, wc = wid & 1, fr = lane & 15, fq = lane >> 4;
  const int bid = opq_bid();
  const int nN = N / 128, ntiles = (MTOT / 128) * nN;
  const int G = gridDim.x, per = G >> 3;
  const int srow = wid * 32 + (lane >> 3);
  const int sw = (fr >> 1) & 7;
  const int nk = K / 64;
  for (int base = 0; base < ntiles; base += G) {
    const int tile = base + (bid & 7) * per + (bid >> 3);
    if (EPI == 0 && base + G > ntiles && (ntiles - base) * 4 <= G) {
      const int sub = tile - base, nsub = (ntiles - base) * 4;
      if (sub < nsub) {
        const int t128 = base + (sub >> 2), q = sub & 3;
        const int patch = t128 >> 5, within = t128 & 31, nPN = nN >> 2;
        const int mt = (patch / nPN) * 8 + (within >> 2), nt = (patch % nPN) * 4 + (within & 3);
        gemm64_tile(p, l, A, lda, Bt, ldb, K, mt * 128 + (q >> 1) * 64, nt * 128 + (q & 1) * 64, smem);
      }
      if (l == 0) {
        const int nidle = G - nsub;
        if (nidle == 0) { for (int it = sub; it < WL_TOTAL; it += G) weight_item(p, 1, it, (float*)smem); }
        else if (sub >= nsub) { for (int it = sub - nsub; it < WL_TOTAL; it += nidle) weight_item(p, 1, it, (float*)smem); }
      }
      continue;
    }
    if (tile >= ntiles) {
      if (EPI == 0 && l == 0) {
        const int nidle = base + G - ntiles;
        for (int it = tile - ntiles; it < WL_TOTAL; it += nidle) weight_item(p, 1, it, (float*)smem);
      }
      continue;
    }
    const int patch = tile >> 5, within = tile & 31, nPN = nN >> 2;
    const int mt = (patch / nPN) * 8 + (within >> 2), nt = (patch % nPN) * 4 + (within & 3);
    const int brow = mt * 128, bcol = nt * 128;
    f32x4 acc[4][4];
#pragma unroll
    for (int m = 0; m < 4; ++m)
#pragma unroll
      for (int n = 0; n < 4; ++n) acc[m][n] = (f32x4){0.f, 0.f, 0.f, 0.f};
    const bf16_t* ga = A + (size_t)(brow + srow) * lda;
    const bf16_t* gb = Bt + (size_t)(bcol + srow) * ldb;
#define GEMM_STAGE(bufi, kt_)                                                                                     \
  {                                                                                                               \
    unsigned char* sa_ = smem + (bufi) * 32768 + wid * 4096 + lane * 16;                                          \
    _Pragma("unroll") for (int i_ = 0; i_ < 4; ++i_) {                                                            \
      const int c_ = (lane & 7) ^ (((srow + i_ * 8) >> 1) & 7);                                                   \
      __builtin_amdgcn_global_load_lds((const unsigned*)(ga + (size_t)(i_ * 8) * lda + (kt_) * 64 + c_ * 8),      \
                                       (unsigned*)(sa_ + i_ * 1024), 16, 0, 0);                                   \
      __builtin_amdgcn_global_load_lds((const unsigned*)(gb + (size_t)(i_ * 8) * ldb + (kt_) * 64 + c_ * 8),      \
                                       (unsigned*)(sa_ + 16384 + i_ * 1024), 16, 0, 0);                           \
    }                                                                                                             \
  }
    __syncthreads();
    GEMM_STAGE(0, 0);
#define GEMM_STAGE1(bufi, kt_, i_)                                                                                \
  {                                                                                                               \
    unsigned char* sa_ = smem + (bufi) * 32768 + wid * 4096 + lane * 16;                                          \
    const int c_ = (lane & 7) ^ (((srow + (i_) * 8) >> 1) & 7);                                                   \
    __builtin_amdgcn_global_load_lds((const unsigned*)(ga + (size_t)((i_) * 8) * lda + (kt_) * 64 + c_ * 8),      \
                                     (unsigned*)(sa_ + (i_) * 1024), 16, 0, 0);                                   \
    __builtin_amdgcn_global_load_lds((const unsigned*)(gb + (size_t)((i_) * 8) * ldb + (kt_) * 64 + c_ * 8),      \
                                     (unsigned*)(sa_ + 16384 + (i_) * 1024), 16, 0, 0);                           \
  }
    for (int kt = 0; kt < nk; ++kt) {
      asm volatile("s_waitcnt vmcnt(0)" ::: "memory");
      __syncthreads();
      const bool more = kt + 1 < nk;
      const unsigned char* sA = smem + (kt & 1) * 32768;
      const unsigned char* sB = sA + 16384;
      bf16x8 a[4], b[4], a2[4], b2[4];
      {
        const int co = (fq ^ sw) << 4, co2 = ((4 + fq) ^ sw) << 4;
#pragma unroll
        for (int m = 0; m < 4; ++m) a[m] = *(const bf16x8*)(sA + (wr * 64 + m * 16 + fr) * 128 + co);
#pragma unroll
        for (int n = 0; n < 4; ++n) b[n] = *(const bf16x8*)(sB + (wc * 64 + n * 16 + fr) * 128 + co);
#pragma unroll
        for (int m = 0; m < 4; ++m) a2[m] = *(const bf16x8*)(sA + (wr * 64 + m * 16 + fr) * 128 + co2);
#pragma unroll
        for (int n = 0; n < 4; ++n) b2[n] = *(const bf16x8*)(sB + (wc * 64 + n * 16 + fr) * 128 + co2);
      }
      __builtin_amdgcn_sched_barrier(0);
#pragma unroll
      for (int m = 0; m < 4; ++m) {
        if (more && m < 2) { GEMM_STAGE1((kt + 1) & 1, kt + 1, 2 * m); GEMM_STAGE1((kt + 1) & 1, kt + 1, 2 * m + 1); }
#pragma unroll
        for (int n = 0; n < 4; ++n) acc[m][n] = mfma16(a[m], b[n], acc[m][n]);
        __builtin_amdgcn_sched_barrier(0);
      }
      __builtin_amdgcn_s_setprio(1);
#pragma unroll
      for (int m = 0; m < 4; ++m)
#pragma unroll
        for (int n = 0; n < 4; ++n) acc[m][n] = mfma16(a2[m], b2[n], acc[m][n]);
      __builtin_amdgcn_s_setprio(0);
    }
    const int rb = brow + wr * 64, cb = bcol + wc * 64;
    if constexpr (EPI == 0) epi_in<4>(p, l, acc, rb, cb, lane);
    else if constexpr (EPI == 1) epi_f32(p, acc, rb, cb, lane);
    else epi_gu(p, acc, rb, cb, lane);
  }
}

constexpr int G160_BUF = 36864;
__device__ __forceinline__ void gemm160_phase(const Params& p, const bf16_t* __restrict__ A, int lda,
                                              const bf16_t* __restrict__ Bt, int ldb, int K, unsigned char* smem) {
  const int tid = opq_tid(), lane = tid & 63, wid = tid >> 6, wr = wid >> 1, wc = wid & 1, fr = lane & 15, fq = lane >> 4;
  const int bid = opq_bid();
  constexpr int nN = 8, ntiles = 64 * nN;
  const int G = gridDim.x, per = G >> 3;
  const int sw = (fr >> 1) & 7;
  const int nk = K / 64;
  const int lrow = lane >> 3;
  bf16_t* O = (bf16_t*)(p.ws + WS_DEC);
  for (int base = 0; base < ntiles; base += G) {
    const int tile = base + (bid & 7) * per + (bid >> 3);
    if (tile >= ntiles) continue;
    const int mt = tile / nN, nt = tile % nN;
    const int brow = mt * 160, bcol = nt * 128;
    f32x4 acc[5][4];
#pragma unroll
    for (int m = 0; m < 5; ++m)
#pragma unroll
      for (int n = 0; n < 4; ++n) acc[m][n] = (f32x4){0.f, 0.f, 0.f, 0.f};
    const bf16_t* ga = A + (size_t)(brow + lrow) * lda;
    const bf16_t* gb = Bt + (size_t)(bcol + wid * 32 + lrow) * ldb;
#define GEMM160_STAGE(bufi, kt_)                                                                                  \
  {                                                                                                               \
    unsigned char* sb_ = smem + (bufi) * G160_BUF;                                                                \
    _Pragma("unroll") for (int i_ = 0; i_ < 5; ++i_) {                                                            \
      const int pc_ = wid + i_ * 4;                                                                               \
      const int c_ = (lane & 7) ^ (((pc_ * 8 + lrow) >> 1) & 7);                                                  \
      __builtin_amdgcn_global_load_lds((const unsigned*)(ga + (size_t)(pc_ * 8) * lda + (kt_) * 64 + c_ * 8),     \
                                       (unsigned*)(sb_ + pc_ * 1024 + lane * 16), 16, 0, 0);                      \
    }                                                                                                             \
    _Pragma("unroll") for (int i_ = 0; i_ < 4; ++i_) {                                                            \
      const int c_ = (lane & 7) ^ (((wid * 32 + i_ * 8 + lrow) >> 1) & 7);                                        \
      __builtin_amdgcn_global_load_lds((const unsigned*)(gb + (size_t)(i_ * 8) * ldb + (kt_) * 64 + c_ * 8),      \
                                       (unsigned*)(sb_ + 20480 + wid * 4096 + i_ * 1024 + lane * 16), 16, 0, 0);  \
    }                                                                                                             \
  }
    __syncthreads();
    GEMM160_STAGE(0, 0);
    for (int kt = 0; kt < nk; ++kt) {
      asm volatile("s_waitcnt vmcnt(0)" ::: "memory");
      __syncthreads();
      if (kt + 1 < nk) GEMM160_STAGE((kt + 1) & 1, kt + 1);
      const unsigned char* sA = smem + (kt & 1) * G160_BUF;
      const unsigned char* sB = sA + 20480;
      bf16x8 a[5], b[4], a2[5], b2[4];
      {
        const int co = (fq ^ sw) << 4, co2 = ((4 + fq) ^ sw) << 4;
#pragma unroll
        for (int m = 0; m < 5; ++m) a[m] = *(const bf16x8*)(sA + (wr * 80 + m * 16 + fr) * 128 + co);
#pragma unroll
        for (int n = 0; n < 4; ++n) b[n] = *(const bf16x8*)(sB + (wc * 64 + n * 16 + fr) * 128 + co);
#pragma unroll
        for (int m = 0; m < 5; ++m) a2[m] = *(const bf16x8*)(sA + (wr * 80 + m * 16 + fr) * 128 + co2);
#pragma unroll
        for (int n = 0; n < 4; ++n) b2[n] = *(const bf16x8*)(sB + (wc * 64 + n * 16 + fr) * 128 + co2);
      }
      __builtin_amdgcn_s_setprio(1);
#pragma unroll
      for (int m = 0; m < 5; ++m)
#pragma unroll
        for (int n = 0; n < 4; ++n) acc[m][n] = mfma16(a[m], b[n], acc[m][n]);
#pragma unroll
      for (int m = 0; m < 5; ++m)
#pragma unroll
        for (int n = 0; n < 4; ++n) acc[m][n] = mfma16(a2[m], b2[n], acc[m][n]);
      __builtin_amdgcn_s_setprio(0);
    }
#pragma unroll
    for (int m = 0; m < 5; ++m)
#pragma unroll
      for (int n = 0; n < 4; ++n)
#pragma unroll
        for (int j = 0; j < 4; ++j)
          O[(size_t)(brow + wr * 80 + m * 16 + fq * 4 + j) * D + bcol + wc * 64 + n * 16 + fr] = f2bf(acc[m][n][j]);
  }
}

template <int FN>
__device__ __forceinline__ bf16x8 ld_frag_f32(const float* src) {
  const float4 u = *(const float4*)src, v = *(const float4*)(src + 4);
  union { uint4 u4; bf16x8 v8; } r;
  r.u4.x = pk_bf16(xform<FN>(u.x), xform<FN>(u.y));
  r.u4.y = pk_bf16(xform<FN>(u.z), xform<FN>(u.w));
  r.u4.z = pk_bf16(xform<FN>(v.x), xform<FN>(v.y));
  r.u4.w = pk_bf16(xform<FN>(v.z), xform<FN>(v.w));
  return r.v8;
}

__device__ __forceinline__ void prep_phase(const Params& p, int l, unsigned char* smem) {
  const int tid = opq_tid(), lane = tid & 63, wid = tid >> 6, fr = lane & 15, fq = lane >> 4;
  const float* CZ = (const float*)(p.ws + WS_CZ);
  float* DEC = (float*)(p.ws + WS_DEC);
  bf16_t* KT = (bf16_t*)(p.ws + WS_KT);
  bf16_t* BB = (bf16_t*)(p.ws + WS_BB);
  bf16_t* KK = (bf16_t*)(p.ws + WS_KK);
  bf16_t* Gb = (bf16_t*)(p.ws + WS_G);
  float* BON = (float*)(p.ws + WS_BON);
  const bf16_t* WUPT = (const bf16_t*)(p.ws + WS_WUPT);
  const bf16_t* AUPT = (const bf16_t*)(p.ws + WS_AUPT);
  const bf16_t* GUPT = (const bf16_t*)(p.ws + WS_GUPT);
  const bf16_t* PA = (const bf16_t*)(p.ws + WS_PA);
  const int swz = (fr >> 1) & 7;
  for (int u = opq_bid(); u < 80 * 6; u += gridDim.x) {
    const int tile = u / 6, h = u % 6;
    __syncthreads();
    {
      uint4 tw_[4], tg_[4];
#pragma unroll
      for (int i = 0; i < 4; ++i) {
        const bf16_t* src = (i < 2 ? WUPT : AUPT) + ((unsigned)(l * 2 + (i & 1)) * 384 + h * 64) * 64;
        const int pc0 = tid, pc1 = tid + 256;
        const uint4 v0 = *(const uint4*)(src + (pc0 >> 3) * 64 + (pc0 & 7) * 8);
        const uint4 v1 = *(const uint4*)(src + (pc1 >> 3) * 64 + (pc1 & 7) * 8);
        tw_[i] = v0; tg_[i] = v1;
      }
#pragma unroll
      for (int i = 0; i < 4; ++i) {
        const int pc0 = tid, pc1 = tid + 256;
        *(uint4*)(smem + i * 8192 + (pc0 >> 3) * 128 + (((pc0 & 7) ^ (((pc0 >> 3) >> 1) & 7)) << 4)) = tw_[i];
        *(uint4*)(smem + i * 8192 + (pc1 >> 3) * 128 + (((pc1 & 7) ^ (((pc1 >> 3) >> 1) & 7)) << 4)) = tg_[i];
      }
#pragma unroll
      for (int i = 0; i < 4; ++i) {
        const int pc = tid + i * 256, col = pc >> 4, chn = pc & 15;
        const uint4 v = *(const uint4*)(GUPT + ((unsigned)l * 384 + h * 64 + col) * 128 + chn * 8);
        *(uint4*)(smem + 32768 + col * 256 + ((chn ^ (col & 15)) << 4)) = v;
      }
    }
    __syncthreads();
#pragma unroll
    for (int mb = 0; mb < 2; ++mb) {
      const int rb = tile * 128 + wid * 32 + mb * 16;
      const int arow = rb + fr;
      bf16x8 ftw[2], fxa[2];
#pragma unroll
      for (int ks = 0; ks < 2; ++ks) {
        ftw[ks] = *(const bf16x8*)(PA + (unsigned)arow * 256 + ks * 32 + fq * 8);
        fxa[ks] = *(const bf16x8*)(PA + (unsigned)arow * 256 + 64 + ks * 32 + fq * 8);
      }
      float kv[4][4], rv[4][4], kkn[4][4], bon[4];
      float kkw[4], kaw[4], rkw[4];
#pragma unroll
      for (int n = 0; n < 4; ++n) {
        kkw[n] = p.c_k_k[l * 384 + h * 64 + n * 16 + fr];
        kaw[n] = p.c_k_a[l * 384 + h * 64 + n * 16 + fr];
        rkw[n] = p.c_r_k[l * 384 + h * 64 + n * 16 + fr];
      }
#pragma unroll
      for (int j = 0; j < 4; ++j) {
        const int row = rb + fq * 4 + j;
        float ss = 0.f;
#pragma unroll
        for (int n = 0; n < 4; ++n) {
          kv[n][j] = CZ[(unsigned)row * 1408 + 384 + h * 64 + n * 16 + fr];
          rv[n][j] = CZ[(unsigned)row * 1408 + h * 64 + n * 16 + fr];
          kkn[n][j] = kv[n][j] * kkw[n];
          ss += kkn[n][j] * kkn[n][j];
        }
        ss = row16_sum(ss);
        const float rs = __builtin_amdgcn_rsqf(ss + 1e-12f);
#pragma unroll
        for (int n = 0; n < 4; ++n) {
          kkn[n][j] *= rs;
          KK[(unsigned)row * 384 + h * 64 + n * 16 + fr] = f2bf(kkn[n][j]);
        }
        bon[j] = 0.f;
      }
#pragma unroll
      for (int d = 0; d < 2; ++d) {
        f32x4 aw[4], aa[4];
#pragma unroll
        for (int n = 0; n < 4; ++n) {
          aw[n] = (f32x4){0.f, 0.f, 0.f, 0.f};
          aa[n] = (f32x4){0.f, 0.f, 0.f, 0.f};
          const int col = h * 64 + n * 16 + fr;
#pragma unroll
          for (int ks = 0; ks < 2; ++ks) {
            const bf16x8 bw = *(const bf16x8*)(smem + d * 8192 + (n * 16 + fr) * 128 + (((ks * 4 + fq) ^ swz) << 4));
            const bf16x8 ba = *(const bf16x8*)(smem + 16384 + d * 8192 + (n * 16 + fr) * 128 + (((ks * 4 + fq) ^ swz) << 4));
            aw[n] = mfma16(ftw[ks], bw, aw[n]);
            aa[n] = mfma16(fxa[ks], ba, aa[n]);
          }
        }
#pragma unroll
        for (int n = 0; n < 4; ++n) {
          const int col = h * 64 + n * 16 + fr;
          const float w0 = p.c_w0[(l * 2 + d) * 384 + col], a0 = p.c_a0[(l * 2 + d) * 384 + col];
#pragma unroll
          for (int j = 0; j < 4; ++j) {
            const int row = rb + fq * 4 + j;
            const float dec = __expf(-0.6065306597126334f * sigmoidf_(aw[n][j] + w0));
            const float a = sigmoidf_(aa[n][j] + a0);
            const float kt = kv[n][j] * (1.f + (a - 1.f) * kaw[n]);
            DEC[((unsigned)d * MTOT + row) * 384 + col] = dec;
            KT[((unsigned)d * MTOT + row) * 384 + col] = f2bf(kt);
            BB[((unsigned)d * MTOT + row) * 384 + col] = f2bf(kkn[n][j] * a);
            bon[j] += rv[n][j] * kt * rkw[n];
          }
        }
      }
#pragma unroll
      for (int j = 0; j < 4; ++j) {
        const float b = row16_sum(bon[j]);
        if (fr == 0) BON[(unsigned)(rb + fq * 4 + j) * 8 + h] = b;
      }
      f32x4 ag[4];
#pragma unroll
      for (int n = 0; n < 4; ++n) ag[n] = (f32x4){0.f, 0.f, 0.f, 0.f};
#pragma unroll
      for (int ks = 0; ks < 4; ++ks) {
        const bf16x8 fa = *(const bf16x8*)(PA + (unsigned)arow * 256 + 128 + ks * 32 + fq * 8);
#pragma unroll
        for (int n = 0; n < 4; ++n) {
          const int col = h * 64 + n * 16 + fr;
          const bf16x8 bg = *(const bf16x8*)(smem + 32768 + (n * 16 + fr) * 256 + (((ks * 4 + fq) ^ fr) << 4));
          ag[n] = mfma16(fa, bg, ag[n]);
        }
      }
#pragma unroll
      for (int n = 0; n < 4; ++n)
#pragma unroll
        for (int j = 0; j < 4; ++j) Gb[(unsigned)(rb + fq * 4 + j) * 384 + h * 64 + n * 16 + fr] = f2bf(ag[n][j]);
    }
  }
}


typedef float f32x2 __attribute__((ext_vector_type(2)));
__device__ __forceinline__ f32x2 fma2(f32x2 a, f32x2 b, f32x2 c) { return __builtin_elementwise_fma(a, b, c); }

struct ScanSrc { const float* DEC; const bf16_t* KT; const bf16_t* BB; const bf16_t* KK; const float* CZ; int row0, T, d, hoff, ls, lc; };
#define SCAN_DECL(P) float4 P##w, P##r, P##v; uint2 P##kt, P##kk, P##b;
#define SCAN_GLOAD(P, chunk)                                                         \
  {                                                                                  \
    int t_ = (chunk) * 16 + sc.ls;                                                   \
    if (sc.d) t_ = sc.T - 1 - t_;                                                    \
    const unsigned row_ = (unsigned)(sc.row0 + t_);                                  \
    P##w = *(const float4*)(sc.DEC + row_ * 384u + sc.hoff + sc.lc);                 \
    P##kt = *(const uint2*)(sc.KT + row_ * 384u + sc.hoff + sc.lc);                  \
    P##kk = *(const uint2*)(sc.KK + row_ * 384u + sc.hoff + sc.lc);                  \
    P##b = *(const uint2*)(sc.BB + row_ * 384u + sc.hoff + sc.lc);                   \
    P##r = *(const float4*)(sc.CZ + row_ * 1408u + sc.hoff + sc.lc);                 \
    P##v = *(const float4*)(sc.CZ + row_ * 1408u + 768 + sc.hoff + sc.lc);           \
  }
#define SCAN_LSTORE(P, b_)                                                           \
  {                                                                                  \
    float* dst_ = buf + (((b_) * 16 + sc.ls) * 6) * 64 + sc.lc;                      \
    const float4 kk_ = cvt4(P##kk);                                                  \
    *(float4*)(dst_) = P##w;                                                         \
    *(float4*)(dst_ + 64) = cvt4(P##kt);                                             \
    *(float4*)(dst_ + 128) = make_float4(-kk_.x, -kk_.y, -kk_.z, -kk_.w);           \
    *(float4*)(dst_ + 192) = cvt4(P##b);                                             \
    *(float4*)(dst_ + 256) = P##r;                                                   \
    *(float4*)(dst_ + 320) = P##v;                                                   \
  }

template <int R>
__device__ __forceinline__ void scan_chunk(f32x2 (&S)[R][2], const float* cbuf, int k0, int v0, int kq,
                                           bf16_t* Yhv, int row0, int T, int d, int ch) {
  const float* sb = cbuf + k0;
  const float* vb = cbuf + 320 + v0;
  float ykeep[R];
#pragma unroll
  for (int j = 0; j < R; ++j) ykeep[j] = 0.f;
  f32x4 cw, ckt, ca, cbv, cr;
  float cvv[R];
  cw = *(const f32x4*)(sb);
  ckt = *(const f32x4*)(sb + 64);
  ca = *(const f32x4*)(sb + 128);
  cbv = *(const f32x4*)(sb + 192);
  cr = *(const f32x4*)(sb + 256);
  if constexpr (R == 4) { const f32x4 t = *(const f32x4*)vb; cvv[0] = t.x; cvv[1] = t.y; cvv[2] = t.z; cvv[3] = t.w; }
  else {
#pragma unroll
    for (int j = 0; j < R; ++j) cvv[j] = vb[j];
  }
#pragma unroll
  for (int s = 0; s < 16; ++s) {
    f32x4 nw, nkt, na, nbv, nr;
    float nvv[R];
    if (s < 15) {
      nw = *(const f32x4*)(sb + (s + 1) * 384);
      nkt = *(const f32x4*)(sb + (s + 1) * 384 + 64);
      na = *(const f32x4*)(sb + (s + 1) * 384 + 128);
      nbv = *(const f32x4*)(sb + (s + 1) * 384 + 192);
      nr = *(const f32x4*)(sb + (s + 1) * 384 + 256);
      if constexpr (R == 4) { const f32x4 t = *(const f32x4*)(vb + (s + 1) * 384); nvv[0] = t.x; nvv[1] = t.y; nvv[2] = t.z; nvv[3] = t.w; }
      else {
#pragma unroll
        for (int j = 0; j < R; ++j) nvv[j] = vb[(s + 1) * 384 + j];
      }
    }
#pragma unroll
    for (int j = 0; j < R; ++j) {
      f32x2 acc = S[j][0] * ca.xy;
      acc = fma2(S[j][1], ca.zw, acc);
      float sa = acc.x + acc.y;
      sa += dppf<DPP_XOR1>(sa);
      sa += dppf<DPP_XOR2>(sa);
      sa += dppf<DPP_ROR4>(sa);
      sa += dppf<DPP_ROR8>(sa);
      const f32x2 sa2 = {sa, sa}, vv2 = {cvv[j], cvv[j]};
      S[j][0] = fma2(S[j][0], cw.xy, fma2(sa2, cbv.xy, vv2 * ckt.xy));
      S[j][1] = fma2(S[j][1], cw.zw, fma2(sa2, cbv.zw, vv2 * ckt.zw));
      f32x2 yacc = S[j][0] * cr.xy;
      yacc = fma2(S[j][1], cr.zw, yacc);
      float y = yacc.x + yacc.y;
      y += dppf<DPP_XOR1>(y);
      y += dppf<DPP_XOR2>(y);
      y += dppf<DPP_ROR4>(y);
      y += dppf<DPP_ROR8>(y);
      ykeep[j] = (kq == s) ? y : ykeep[j];
    }
    if (s < 15) {
      cw = nw; ckt = nkt; ca = na; cbv = nbv; cr = nr;
#pragma unroll
      for (int j = 0; j < R; ++j) cvv[j] = nvv[j];
    }
  }
  int t = ch * 16 + kq;
  if (d) t = T - 1 - t;
#pragma unroll
  for (int j = 0; j < R; ++j) Yhv[(unsigned)(row0 + t) * 384u + j] = f2bf(ykeep[j]);
}

constexpr int DPP_HMIRROR = 0x141;
__device__ __forceinline__ void scan_chunk8(f32x2 (&S)[2][4], const float* cbuf, int k0, int v0, int kq,
                                            bf16_t* Yhv, int row0, int T, int d, int ch) {
  const float* sb = cbuf + k0;
  const float* vb = cbuf + 320 + v0;
  float ykeep[2][2];
#pragma unroll
  for (int j = 0; j < 2; ++j) { ykeep[j][0] = 0.f; ykeep[j][1] = 0.f; }
  f32x4 cw[2], ckt[2], ca[2], cbv[2], cr[2];
  f32x2 cvv;
#pragma unroll
  for (int q = 0; q < 2; ++q) {
    cw[q] = *(const f32x4*)(sb + q * 4);
    ckt[q] = *(const f32x4*)(sb + 64 + q * 4);
    ca[q] = *(const f32x4*)(sb + 128 + q * 4);
    cbv[q] = *(const f32x4*)(sb + 192 + q * 4);
    cr[q] = *(const f32x4*)(sb + 256 + q * 4);
  }
  cvv = *(const f32x2*)vb;
#pragma unroll
  for (int s = 0; s < 16; ++s) {
    f32x4 nw[2], nkt[2], na[2], nbv[2], nr[2];
    f32x2 nvv = {0.f, 0.f};
    if (s < 15) {
#pragma unroll
      for (int q = 0; q < 2; ++q) {
        nw[q] = *(const f32x4*)(sb + (s + 1) * 384 + q * 4);
        nkt[q] = *(const f32x4*)(sb + (s + 1) * 384 + 64 + q * 4);
        na[q] = *(const f32x4*)(sb + (s + 1) * 384 + 128 + q * 4);
        nbv[q] = *(const f32x4*)(sb + (s + 1) * 384 + 192 + q * 4);
        nr[q] = *(const f32x4*)(sb + (s + 1) * 384 + 256 + q * 4);
      }
      nvv = *(const f32x2*)(vb + (s + 1) * 384);
    }
#pragma unroll
    for (int j = 0; j < 2; ++j) {
      f32x2 acc = S[j][0] * ca[0].xy;
      acc = fma2(S[j][1], ca[0].zw, acc);
      acc = fma2(S[j][2], ca[1].xy, acc);
      acc = fma2(S[j][3], ca[1].zw, acc);
      float sa = acc.x + acc.y;
      sa += dppf<DPP_XOR1>(sa);
      sa += dppf<DPP_XOR2>(sa);
      sa += dppf<DPP_HMIRROR>(sa);
      const float vj = j ? cvv.y : cvv.x;
      const f32x2 sa2 = {sa, sa}, vv2 = {vj, vj};
      S[j][0] = fma2(S[j][0], cw[0].xy, fma2(sa2, cbv[0].xy, vv2 * ckt[0].xy));
      S[j][1] = fma2(S[j][1], cw[0].zw, fma2(sa2, cbv[0].zw, vv2 * ckt[0].zw));
      S[j][2] = fma2(S[j][2], cw[1].xy, fma2(sa2, cbv[1].xy, vv2 * ckt[1].xy));
      S[j][3] = fma2(S[j][3], cw[1].zw, fma2(sa2, cbv[1].zw, vv2 * ckt[1].zw));
      f32x2 yacc = S[j][0] * cr[0].xy;
      yacc = fma2(S[j][1], cr[0].zw, yacc);
      yacc = fma2(S[j][2], cr[1].xy, yacc);
      yacc = fma2(S[j][3], cr[1].zw, yacc);
      float y = yacc.x + yacc.y;
      y += dppf<DPP_XOR1>(y);
      y += dppf<DPP_XOR2>(y);
      y += dppf<DPP_HMIRROR>(y);
      ykeep[j][s >> 3] = (kq == (s & 7)) ? y : ykeep[j][s >> 3];
    }
    if (s < 15) {
#pragma unroll
      for (int q = 0; q < 2; ++q) { cw[q] = nw[q]; ckt[q] = nkt[q]; ca[q] = na[q]; cbv[q] = nbv[q]; cr[q] = nr[q]; }
      cvv = nvv;
    }
  }
#pragma unroll
  for (int hs = 0; hs < 2; ++hs) {
    int t = ch * 16 + hs * 8 + kq;
    if (d) t = T - 1 - t;
#pragma unroll
    for (int j = 0; j < 2; ++j) Yhv[(unsigned)(row0 + t) * 384u + j] = f2bf(ykeep[j][hs]);
  }
}

__device__ __forceinline__ void scan_unit8(const Params& p, int l, int row0, int T, int h, int d, float* fin, unsigned char* smem) {
  const int tid = opq_tid();
  const int v0 = (tid >> 3) * 2, kq = tid & 7, k0 = kq * 8;
  f32x2 S[2][4];
#pragma unroll
  for (int j = 0; j < 2; ++j)
#pragma unroll
    for (int i = 0; i < 4; ++i) S[j][i] = (f32x2){0.f, 0.f};
  float* buf = (float*)smem;
  ScanSrc sc;
  sc.DEC = (const float*)(p.ws + WS_DEC) + (size_t)d * MTOT * 384;
  sc.KT = (const bf16_t*)(p.ws + WS_KT) + (size_t)d * MTOT * 384;
  sc.BB = (const bf16_t*)(p.ws + WS_BB) + (size_t)d * MTOT * 384;
  sc.KK = (const bf16_t*)(p.ws + WS_KK);
  sc.CZ = (const float*)(p.ws + WS_CZ);
  sc.row0 = row0; sc.T = T; sc.d = d; sc.hoff = h * 64; sc.ls = tid >> 4; sc.lc = (tid & 15) * 4;
  bf16_t* Yhv = (bf16_t*)(p.ws + WS_Y) + (size_t)d * MTOT * 384 + h * 64 + v0;
  const int nch = T / 16;
  float* buf0 = buf;
  float* buf1 = buf + 16 * 384;
  __syncthreads();
  SCAN_DECL(A)
  SCAN_GLOAD(A, 0);
  SCAN_LSTORE(A, 0);
  __syncthreads();
  for (int ch = 0; ch < nch; ++ch) {
    if (ch + 1 < nch) SCAN_GLOAD(A, ch + 1);
    scan_chunk8(S, (ch & 1) ? buf1 : buf0, k0, v0, kq, Yhv, row0, T, d, ch);
    if (ch + 1 < nch) SCAN_LSTORE(A, (ch + 1) & 1);
    __syncthreads();
  }
#pragma unroll
  for (int j = 0; j < 2; ++j) {
    float4 t0, t1;
    t0.x = S[j][0].x; t0.y = S[j][0].y; t0.z = S[j][1].x; t0.w = S[j][1].y;
    t1.x = S[j][2].x; t1.y = S[j][2].y; t1.z = S[j][3].x; t1.w = S[j][3].y;
    *(float4*)(fin + (v0 + j) * 64 + k0) = t0;
    *(float4*)(fin + (v0 + j) * 64 + k0 + 4) = t1;
  }
}

template <int R>
__device__ __forceinline__ void scan_unit(const Params& p, int l, int row0, int T, int h, int d, int vbase,
                                          const float* init, float* fin, unsigned char* smem) {
  const int tid = opq_tid();
  const int v0 = vbase + (tid >> 4) * R, kq = tid & 15, k0 = kq * 4;
  f32x2 S[R][2];
#pragma unroll
  for (int j = 0; j < R; ++j) {
    if (init) {
      const float4 t = *(const float4*)(init + (v0 + j) * 64 + k0);
      S[j][0].x = t.x; S[j][0].y = t.y; S[j][1].x = t.z; S[j][1].y = t.w;
    } else {
      S[j][0] = (f32x2){0.f, 0.f}; S[j][1] = (f32x2){0.f, 0.f};
    }
  }
  float* buf = (float*)smem;
  ScanSrc sc;
  sc.DEC = (const float*)(p.ws + WS_DEC) + (size_t)d * MTOT * 384;
  sc.KT = (const bf16_t*)(p.ws + WS_KT) + (size_t)d * MTOT * 384;
  sc.BB = (const bf16_t*)(p.ws + WS_BB) + (size_t)d * MTOT * 384;
  sc.KK = (const bf16_t*)(p.ws + WS_KK);
  sc.CZ = (const float*)(p.ws + WS_CZ);
  sc.row0 = row0; sc.T = T; sc.d = d; sc.hoff = h * 64; sc.ls = tid >> 4; sc.lc = (tid & 15) * 4;
  bf16_t* Yhv = (bf16_t*)(p.ws + WS_Y) + (size_t)d * MTOT * 384 + h * 64 + v0;
  const int nch = T / 16;
  float* buf0 = buf;
  float* buf1 = buf + 16 * 384;
  __syncthreads();
  if constexpr (R == 1) {
    __builtin_amdgcn_s_setprio(3);
    SCAN_DECL(A) SCAN_DECL(B) SCAN_DECL(C) SCAN_DECL(Dd)
    SCAN_GLOAD(A, 0);
    SCAN_LSTORE(A, 0);
    SCAN_GLOAD(A, 1);
    SCAN_GLOAD(B, 2);
    SCAN_GLOAD(C, 3);
    __syncthreads();
    for (int ch = 0; ch < nch; ch += 4) {
      if (ch + 4 < nch) SCAN_GLOAD(Dd, ch + 4);
      scan_chunk<R>(S, buf0, k0, v0, kq, Yhv, row0, T, d, ch);
      SCAN_LSTORE(A, 1);
      __syncthreads();
      if (ch + 5 < nch) SCAN_GLOAD(A, ch + 5);
      scan_chunk<R>(S, buf1, k0, v0, kq, Yhv, row0, T, d, ch + 1);
      SCAN_LSTORE(B, 0);
      __syncthreads();
      if (ch + 6 < nch) SCAN_GLOAD(B, ch + 6);
      scan_chunk<R>(S, buf0, k0, v0, kq, Yhv, row0, T, d, ch + 2);
      SCAN_LSTORE(C, 1);
      __syncthreads();
      if (ch + 7 < nch) SCAN_GLOAD(C, ch + 7);
      scan_chunk<R>(S, buf1, k0, v0, kq, Yhv, row0, T, d, ch + 3);
      if (ch + 4 < nch) SCAN_LSTORE(Dd, 0);
      __syncthreads();
    }
    __builtin_amdgcn_s_setprio(0);
  } else {
    SCAN_DECL(A)
    SCAN_GLOAD(A, 0);
    SCAN_LSTORE(A, 0);
    __syncthreads();
    for (int ch = 0; ch < nch; ++ch) {
      if (ch + 1 < nch) SCAN_GLOAD(A, ch + 1);
      scan_chunk<R>(S, (ch & 1) ? buf1 : buf0, k0, v0, kq, Yhv, row0, T, d, ch);
      if (ch + 1 < nch) SCAN_LSTORE(A, (ch + 1) & 1);
      __syncthreads();
    }
  }
  if (fin) {
#pragma unroll
    for (int j = 0; j < R; ++j) {
      float4 t;
      t.x = S[j][0].x; t.y = S[j][0].y; t.z = S[j][1].x; t.w = S[j][1].y;
      *(float4*)(fin + (v0 + j) * 64 + k0) = t;
    }
  }
}

struct AttnDesc {
  const bf16_t* q;
  const bf16_t* kloc;
  const bf16_t* vloc;
  const bf16_t* kctx;
  const bf16_t* vctx;
  bf16_t* o;
  int qpos0;
  int lo, hi;
  int window;
  float sink; int has_sink;
};

__device__ __forceinline__ void attn_unit(const AttnDesc& a, unsigned char* smem) {
  const int tid = opq_tid(), lane = tid & 63, wid = tid >> 6, fr = lane & 15, fq = lane >> 4;
  unsigned char* sK = smem;
  unsigned char* sV = smem + 8192;
  bf16x8 qf[2];
  {
    const bf16_t* qp = a.q + (size_t)(wid * 16 + fr) * 896 + fq * 8;
    qf[0] = *(const bf16x8*)(qp);
    qf[1] = *(const bf16x8*)(qp + 32);
  }
  f32x4 o[4];
#pragma unroll
  for (int i = 0; i < 4; ++i) o[i] = (f32x4){0.f, 0.f, 0.f, 0.f};
  float mrun = -1e30f, lsum = 0.f;
  const int nctx = a.kctx ? 4 : 0;
  const int ntl = nctx + (a.hi - a.lo + 1);
  const int sw = (fr >> 1) & 7;
  const int qpos = a.qpos0 + wid * 16 + fr;
  const int r0_ = tid >> 3, chn = tid & 7, r1_ = r0_ + 32;
  const int rho0 = (r0_ & 32) | (((r0_ >> 2) & 1) << 4) | (((r0_ >> 3) & 3) << 2) | (r0_ & 3);
  const int rho1 = rho0 + 32;
  uint4 rk0, rk1, rv0, rv1;
#define ATTN_TLOAD(it_)                                                                          \
  {                                                                                              \
    const bool ic_ = (it_) < nctx;                                                               \
    const int kt_ = ic_ ? (it_) : a.lo + ((it_) - nctx);                                         \
    const bf16_t* kb_ = ic_ ? a.kctx + (size_t)kt_ * 64 * 64 : a.kloc + (size_t)kt_ * 64 * 896;  \
    const int kstr_ = ic_ ? 64 : 896;                                                            \
    const bf16_t* vb_ = ic_ ? a.vctx + kt_ * 64 : a.vloc + kt_ * 64;                             \
    const int vstr_ = ic_ ? 256 : MTOT;                                                          \
    rk0 = *(const uint4*)(kb_ + (size_t)r0_ * kstr_ + chn * 8);                                  \
    rk1 = *(const uint4*)(kb_ + (size_t)r1_ * kstr_ + chn * 8);                                  \
    rv0 = *(const uint4*)(vb_ + (size_t)r0_ * vstr_ + chn * 8);                                  \
    rv1 = *(const uint4*)(vb_ + (size_t)r1_ * vstr_ + chn * 8);                                  \
  }
  ATTN_TLOAD(0);
  for (int it = 0; it < ntl; ++it) {
    const bool isctx = it < nctx;
    const int kt = isctx ? it : a.lo + (it - nctx);
    __syncthreads();
    *(uint4*)(sK + rho0 * 128 + ((chn ^ ((rho0 >> 1) & 7)) << 4)) = rk0;
    *(uint4*)(sK + rho1 * 128 + ((chn ^ ((rho1 >> 1) & 7)) << 4)) = rk1;
    *(uint4*)(sV + r0_ * 128 + ((chn ^ ((r0_ >> 1) & 7)) << 4)) = rv0;
    *(uint4*)(sV + r1_ * 128 + ((chn ^ ((r1_ >> 1) & 7)) << 4)) = rv1;
    __syncthreads();
    if (it + 1 < ntl) ATTN_TLOAD(it + 1);
    f32x4 st[4];
#pragma unroll
    for (int kb4 = 0; kb4 < 4; ++kb4) {
      st[kb4] = (f32x4){0.f, 0.f, 0.f, 0.f};
#pragma unroll
      for (int ks = 0; ks < 2; ++ks) {
        const bf16x8 af = *(const bf16x8*)(sK + (kb4 * 16 + fr) * 128 + (((ks * 4 + fq) ^ sw) << 4));
        st[kb4] = mfma16(af, qf[ks], st[kb4]);
      }
    }
    float mt = -1e30f;
#pragma unroll
    for (int kb4 = 0; kb4 < 4; ++kb4)
#pragma unroll
      for (int jj = 0; jj < 4; ++jj) {
        float s = st[kb4][jj] * 0.125f;
        if (a.window && !isctx) {
          const int key = (kb4 >> 1) * 32 + fq * 8 + (kb4 & 1) * 4 + jj;
          const int dlt = kt * 64 + key - qpos;
          if (dlt > 128 || dlt < -128) s = -1e30f;
        }
        st[kb4][jj] = s;
        mt = fmaxf(mt, s);
      }
    mt = fmaxf(mt, __shfl_xor(mt, 16));
    mt = fmaxf(mt, __shfl_xor(mt, 32));
    const float mnew = fmaxf(mrun, mt);
    const float alpha = __expf(mrun - mnew);
    mrun = mnew;
    float ps = 0.f;
#pragma unroll
    for (int kb4 = 0; kb4 < 4; ++kb4)
#pragma unroll
      for (int jj = 0; jj < 4; ++jj) {
        const float pv = __expf(st[kb4][jj] - mnew);
        st[kb4][jj] = pv;
        ps += pv;
      }
    lsum = lsum * alpha + ps;
#pragma unroll
    for (int i = 0; i < 4; ++i) o[i] *= alpha;
    bf16x8 pb[2];
#pragma unroll
    for (int kg = 0; kg < 2; ++kg) {
      union { uint4 u4; bf16x8 v8; } r;
      r.u4.x = pk_bf16(st[2 * kg][0], st[2 * kg][1]);
      r.u4.y = pk_bf16(st[2 * kg][2], st[2 * kg][3]);
      r.u4.z = pk_bf16(st[2 * kg + 1][0], st[2 * kg + 1][1]);
      r.u4.w = pk_bf16(st[2 * kg + 1][2], st[2 * kg + 1][3]);
      pb[kg] = r.v8;
    }
#pragma unroll
    for (int db = 0; db < 4; ++db)
#pragma unroll
      for (int kg = 0; kg < 2; ++kg) {
        const bf16x8 vf = *(const bf16x8*)(sV + (db * 16 + fr) * 128 + (((kg * 4 + fq) ^ sw) << 4));
        o[db] = mfma16(vf, pb[kg], o[db]);
      }
  }
  lsum += __shfl_xor(lsum, 16);
  lsum += __shfl_xor(lsum, 32);
  if (a.has_sink) lsum += __expf(a.sink - mrun);
  const float inv = frcp(lsum);
  bf16_t* op = a.o + (size_t)(wid * 16 + fr) * 1024 + fq * 4;
#pragma unroll
  for (int db = 0; db < 4; ++db) {
    uint2 v;
    v.x = pk_bf16(o[db][0] * inv, o[db][1] * inv);
    v.y = pk_bf16(o[db][2] * inv, o[db][3] * inv);
    *(uint2*)(op + db * 16) = v;
  }
}

constexpr int U_LSCAN = 96, U_CSCAN = 384, U_LATB = 192, U_LATA = 128, U_CTX = 1280;
constexpr int U_TOTAL = U_LSCAN + U_CSCAN + U_LATB + U_LATA + U_CTX;

__device__ __forceinline__ void mix_phase(const Params& p, int slot, int l, unsigned char* smem, int ulo = 0, int uhi = U_TOTAL) {
  unsigned* cnt = (unsigned*)(p.ws + WS_CNT) + slot * 8;
  int* s_u = (int*)(smem + SMEM_CTL);
  const bf16_t* QK = (const bf16_t*)(p.ws + WS_QK);
  const bf16_t* VT = (const bf16_t*)(p.ws + WS_VT);
  bf16_t* MIX = (bf16_t*)(p.ws + WS_H);
  for (;;) {
    __syncthreads();
    if (opq_tid() == 0) *s_u = (int)atomicAdd(cnt, 1u);
    __syncthreads();
    int u = *s_u + ulo;
    if (u >= uhi) break;
    if (u < U_LSCAN) {
      const int chain = u >> 2, part = u & 3;
      const int b = chain / 12, h = (chain % 12) >> 1, d = chain & 1;
      const float* init = p.state_c + ((((size_t)b * 2 + l) * 2 + d) * 6 + h) * 4096;
      scan_unit<1>(p, l, M_CTX + b * 1024, 1024, h, d, part * 16, init, nullptr, smem);
      continue;
    }
    u -= U_LSCAN;
    if (u < U_CSCAN) {
      const int b = u / 12, h = (u % 12) >> 1, d = u & 1;
      float* fin = p.out + OUT_ST + ((((size_t)b * 2 + l) * 2 + d) * 6 + h) * 4096;
      scan_unit8(p, l, b * 256, 256, h, d, fin, smem);
      continue;
    }
    u -= U_CSCAN;
    AttnDesc a;
    if (u < U_LATB) {
      const int b = u / 96, h = (u % 96) >> 4, qb = u & 15, kvh = h / 3;
      const int r0 = M_CTX + b * 1024;
      a.q = QK + (size_t)(r0 + qb * 64) * 896 + 384 + h * 64;
      a.kloc = QK + (size_t)r0 * 896 + 768 + kvh * 64;
      a.vloc = VT + (size_t)((2 + kvh) * 64) * MTOT + r0;
      a.kctx = (const bf16_t*)(p.ws + WS_CKB) + (size_t)((b * 2 + l) * 2 + kvh) * 16384;
      a.vctx = (const bf16_t*)(p.ws + WS_CVTB) + (size_t)((b * 2 + l) * 2 + kvh) * 16384;
      a.o = MIX + (size_t)(r0 + qb * 64) * 1024 + 256 + h * 64;
      a.qpos0 = qb * 64; a.lo = 0; a.hi = 15; a.window = 0; a.sink = 0.f; a.has_sink = 0;
    } else if (u < U_LATB + U_LATA) {
      u -= U_LATB;
      const int b = u >> 6, h = (u & 63) >> 4, qb = u & 15, kvh = h >> 1;
      const int r0 = M_CTX + b * 1024;
      a.q = QK + (size_t)(r0 + qb * 64) * 896 + h * 64;
      a.kloc = QK + (size_t)r0 * 896 + 256 + kvh * 64;
      a.vloc = VT + (size_t)(kvh * 64) * MTOT + r0;
      a.kctx = (const bf16_t*)(p.ws + WS_CKA) + (size_t)((b * 2 + l) * 2 + kvh) * 16384;
      a.vctx = (const bf16_t*)(p.ws + WS_CVTA) + (size_t)((b * 2 + l) * 2 + kvh) * 16384;
      a.o = MIX + (size_t)(r0 + qb * 64) * 1024 + h * 64;
      a.qpos0 = qb * 64; a.lo = qb - 2 < 0 ? 0 : qb - 2; a.hi = qb + 2 > 15 ? 15 : qb + 2; a.window = 1;
      a.sink = p.a_sink[l * 4 + h]; a.has_sink = 1;
    } else {
      u -= U_LATB + U_LATA;
      const int b = u / 40, rem = u % 40, hh = rem >> 2, qb = rem & 3;
      const int r0 = b * 256;
      a.kctx = nullptr; a.vctx = nullptr;
      a.qpos0 = qb * 64; a.lo = 0; a.hi = 3; a.window = 0;
      if (hh < 4) {
        const int h = hh, kvh = h >> 1;
        a.q = QK + (size_t)(r0 + qb * 64) * 896 + h * 64;
        a.kloc = QK + (size_t)r0 * 896 + 256 + kvh * 64;
        a.vloc = VT + (size_t)(kvh * 64) * MTOT + r0;
        a.o = MIX + (size_t)(r0 + qb * 64) * 1024 + h * 64;
        a.sink = p.a_sink[l * 4 + h]; a.has_sink = 1;
      } else {
        const int h = hh - 4, kvh = h / 3;
        a.q = QK + (size_t)(r0 + qb * 64) * 896 + 384 + h * 64;
        a.kloc = QK + (size_t)r0 * 896 + 768 + kvh * 64;
        a.vloc = VT + (size_t)((2 + kvh) * 64) * MTOT + r0;
        a.o = MIX + (size_t)(r0 + qb * 64) * 1024 + 256 + h * 64;
        a.sink = 0.f; a.has_sink = 0;
      }
    }
    attn_unit(a, smem);
  }
}

__device__ __forceinline__ void post_phase(const Params& p, int l) {
  const int tid_ = opq_tid(); const int lane = tid_ & 63, wave = tid_ >> 6;
  const bf16_t* Y = (const bf16_t*)(p.ws + WS_Y);
  const bf16_t* Gb = (const bf16_t*)(p.ws + WS_G);
  const float* BON = (const float*)(p.ws + WS_BON);
  const float* CZ = (const float*)(p.ws + WS_CZ);
  bf16_t* MIX = (bf16_t*)(p.ws + WS_H);
  for (int row = opq_bid() * 4 + wave; row < MTOT; row += gridDim.x * 4) {
#pragma unroll
    for (int h = 0; h < 6; ++h) {
      const int col = h * 64 + lane;
      const float y = bf2f(Y[(size_t)row * 384 + col]) + bf2f(Y[((size_t)MTOT + row) * 384 + col]);
      const float mu = wave_sum(y) * (1.f / 64.f);
      const float dv = y - mu;
      const float var = wave_sum(dv * dv) * (1.f / 64.f);
      const float yn = dv * __builtin_amdgcn_rsqf(var + 64e-5f);
      const float vv = CZ[(size_t)row * 1408 + 768 + col];
      const float o = (yn * p.c_ln_w[l * 384 + col] + p.c_ln_b[l * 384 + col] + BON[(size_t)row * 8 + h] * vv) *
                      bf2f(Gb[(size_t)row * 384 + col]);
      MIX[(size_t)row * 1024 + 640 + col] = f2bf(o);
    }
  }
}


#define XB_TMO      128
#define XB_XCNT(j)  (256  + 64 * (j))
#define XB_XSUB(j)  (1280 + 64 * (j))
#define XB_XGEN(j)  (2304 + 64 * (j))
#define XB_TOP      3328
#define XB_TOPGEN   3392
#define XCD_BAR_WORDS 3456
#define XB_SPIN_CAP (1u << 22)
#define LAS __attribute__((address_space(3)))
__device__ __forceinline__ unsigned xb_ld(unsigned* p)              { return __hip_atomic_load(p, __ATOMIC_RELAXED, __HIP_MEMORY_SCOPE_AGENT); }
__device__ __forceinline__ unsigned xb_add(unsigned* p, unsigned v) { return __hip_atomic_fetch_add(p, v, __ATOMIC_RELAXED, __HIP_MEMORY_SCOPE_AGENT); }
__device__ __forceinline__ unsigned xb_xcc_id() { return (unsigned)__builtin_amdgcn_s_getreg((3 << 11) | 20) & 0xFu; }
#define XB_SPIN(cond, bar) do { unsigned _sp = 0; while (cond) { __builtin_amdgcn_s_sleep(1); \
    if ((++_sp & 255u) == 0u) { if (xb_ld(&(bar)[XB_TMO])) break; if (_sp > XB_SPIN_CAP) { atomicAdd(&(bar)[XB_TMO], 1u); break; } } } } while (0)
struct XcdBarrier { unsigned* bar; unsigned x; volatile LAS unsigned* st; };
__device__ __forceinline__ XcdBarrier xcd_barrier_post(unsigned* bar, volatile LAS unsigned* st) {
  XcdBarrier b; b.bar = bar; b.x = xb_xcc_id(); b.st = st;
  if (threadIdx.x == 0) (void)xb_add(&bar[XB_XCNT(b.x)], 1u);
  return b;
}
__device__ __forceinline__ void xcd_barrier_complete(unsigned* bar, unsigned x, unsigned& nloc, unsigned& nx) {
  const unsigned G = gridDim.x * gridDim.y * gridDim.z;
  unsigned sum, cnt, mine, sp = 0u;
  for (;;) {
    sum = 0u; cnt = 0u; mine = 0u;
#pragma unroll
    for (unsigned j = 0; j < 16; ++j) { const unsigned c = xb_ld(&bar[XB_XCNT(j)]); sum += c; cnt += (c > 0u) ? 1u : 0u; mine = (j == x) ? c : mine; }
    if (sum == G) break;
    __builtin_amdgcn_s_sleep(1);
    if ((++sp & 255u) == 0u) { if (xb_ld(&bar[XB_TMO])) break; if (sp > XB_SPIN_CAP) { atomicAdd(&bar[XB_TMO], 1u); break; } }
  }
  nloc = mine > 0u ? mine : 1u; nx = cnt > 0u ? cnt : 1u;
}
__device__ __forceinline__ void xcd_barrier(const XcdBarrier& b) {
  asm volatile("s_waitcnt vmcnt(0)" ::: "memory");
  __syncthreads();
  if (threadIdx.x == 0) {
    unsigned* bar = b.bar;
    __builtin_amdgcn_s_waitcnt(0);
    unsigned nloc = b.st[0], nx = b.st[1];
    if (nloc == 0u) { xcd_barrier_complete(bar, b.x, nloc, nx); b.st[0] = nloc; b.st[1] = nx; }
    const unsigned old = xb_add(&bar[XB_XSUB(b.x)], 1u);
    const unsigned gen = old / nloc;
    if (old + 1u == (gen + 1u) * nloc) {
      __builtin_amdgcn_fence(__ATOMIC_RELEASE, "agent");
      asm volatile("s_waitcnt vmcnt(0)" ::: "memory");
      const unsigned og = xb_add(&bar[XB_TOP], 1u);
      const unsigned tg = og / nx;
      if (og + 1u == (tg + 1u) * nx) xb_add(&bar[XB_TOPGEN], 1u);
      else XB_SPIN(xb_ld(&bar[XB_TOPGEN]) == tg, bar);
      __builtin_amdgcn_fence(__ATOMIC_ACQUIRE, "agent");
      xb_add(&bar[XB_XGEN(b.x)], 1u);
      asm volatile("s_waitcnt vmcnt(0)" ::: "memory");
    } else {
      XB_SPIN(xb_ld(&bar[XB_XGEN(b.x)]) == gen, bar);
      __builtin_amdgcn_fence(__ATOMIC_ACQUIRE, "agent");
      asm volatile("s_waitcnt vmcnt(0)" ::: "memory");
    }
  }
  __syncthreads();
}

__device__ __forceinline__ void run_phase(const Params& p, int ph, unsigned char* smem) {
  if (ph == 0) { phase0(p, smem); return; }
  if (ph == NPHASE - 1) { rpass(p, 2, 1); return; }
  const int l = (ph - 1) / 9, s = (ph - 1) % 9;
  const bf16_t* H = (const bf16_t*)(p.ws + WS_H);
  switch (s) {
    case 0: if (l == 0) rpass(p, 0, 0); else rpass(p, 2, 0); break;
    case 1: gemm_phase<0>(p, l, H, D, (const bf16_t*)(p.ws + WS_WT_IN) + (size_t)l * IN_COLS * D, D, IN_COLS, D, smem); break;
    case 2: prep_phase(p, l, smem); break;
    case 3: mix_phase(p, l * 2, l, smem); break;
    case 4: post_phase(p, l); break;
    case 5: gemm_phase<1>(p, l, H, D, (const bf16_t*)(p.ws + WS_WT_OUT) + (size_t)l * D * D, D, D, D, smem); break;
    case 6: rpass(p, 1, l); break;
    case 7: gemm_phase<2>(p, l, H, D, (const bf16_t*)(p.ws + WS_WT_GU) + (size_t)l * GU * D, D, GU, D, smem); break;
    case 8: gemm_phase<1>(p, l, (const bf16_t*)(p.ws + WS_CZ), FF, (const bf16_t*)(p.ws + WS_WT_DN) + (size_t)l * D * FF, FF, D, FF, smem); break;
  }
}

#if N_LAUNCH_MODE == 0
__global__ void __launch_bounds__(256, 2) fwd_phases(Params p) {
  extern __shared__ __attribute__((aligned(16))) unsigned char smem[];
  run_phase(p, p.ph_lo, smem);
}
#define FWD_KERNEL fwd_phases
#else
template <int L>
__device__ __forceinline__ void layer_phases(const Params& p, unsigned char* smem, const XcdBarrier& xb) {
  const bf16_t* H = (const bf16_t*)(p.ws + WS_H);
  if (L == 0) {
#pragma unroll
    for (int rep = 0; rep < REP_R0; ++rep) rpass(p, 0, 0);
  } else rpass(p, 2, 0);
  xcd_barrier(xb);
#pragma unroll
  for (int rep = 0; rep < REP_GEMM; ++rep) {
    gemm_phase<0>(p, L, H, D, (const bf16_t*)(p.ws + WS_WT_IN) + (size_t)L * IN_COLS * D, D, IN_COLS, D, smem);
    xcd_barrier(xb);
  }
#pragma unroll
  for (int rep = 0; rep < REP_OTHER * REP_PREP; ++rep) {
    prep_phase(p, L, smem);
    xcd_barrier(xb);
  }
#if MIX_SPLIT
#pragma unroll
  for (int rep = 0; rep < REP_MA; ++rep) { mix_phase(p, L * 4 + 0 + 0 * rep, L, smem, 0, U_LSCAN); xcd_barrier(xb); if (rep + 1 < REP_MA) { if (threadIdx.x == 0 && blockIdx.x == 0) ((unsigned*)(p.ws + WS_CNT))[(L * 4 + 0) * 8] = 0u; xcd_barrier(xb); } }
#pragma unroll
  for (int rep = 0; rep < REP_MB; ++rep) { mix_phase(p, L * 4 + 1, L, smem, U_LSCAN, U_LSCAN + U_CSCAN); xcd_barrier(xb); if (rep + 1 < REP_MB) { if (threadIdx.x == 0 && blockIdx.x == 0) ((unsigned*)(p.ws + WS_CNT))[(L * 4 + 1) * 8] = 0u; xcd_barrier(xb); } }
#pragma unroll
  for (int rep = 0; rep < REP_MC; ++rep) { mix_phase(p, L * 4 + 2, L, smem, U_LSCAN + U_CSCAN, U_TOTAL); xcd_barrier(xb); if (rep + 1 < REP_MC) { if (threadIdx.x == 0 && blockIdx.x == 0) ((unsigned*)(p.ws + WS_CNT))[(L * 4 + 2) * 8] = 0u; xcd_barrier(xb); } }
#else
#pragma unroll
  for (int rep = 0; rep < REP_MIX; ++rep) {
    mix_phase(p, L * 2 + rep, L, smem);
    xcd_barrier(xb);
  }
#endif
#pragma unroll
  for (int rep = 0; rep < REP_OTHER; ++rep) {
    post_phase(p, L);
    xcd_barrier(xb);
  }
#pragma unroll
  for (int rep = 0; rep < REP_GEMM; ++rep) {
    gemm160_phase(p, H, D, (const bf16_t*)(p.ws + WS_WT_OUT) + (size_t)L * D * D, D, D, smem);
    xcd_barrier(xb);
  }
  rpass(p, 1, L);
  xcd_barrier(xb);
#pragma unroll
  for (int rep = 0; rep < REP_GEMM; ++rep) {
    gemm_phase<2>(p, L, H, D, (const bf16_t*)(p.ws + WS_WT_GU) + (size_t)L * GU * D, D, GU, D, smem);
    xcd_barrier(xb);
  }
#pragma unroll
  for (int rep = 0; rep < REP_GEMM; ++rep) {
    gemm160_phase(p, (const bf16_t*)(p.ws + WS_CZ), FF, (const bf16_t*)(p.ws + WS_WT_DN) + (size_t)L * D * FF, FF, FF, smem);
    xcd_barrier(xb);
  }
}
__global__ void __launch_bounds__(256, 2) fwd_mega(Params p) {
  extern __shared__ __attribute__((aligned(16))) unsigned char smem[];
  if (threadIdx.x == 0) { *(unsigned*)(smem + SMEM_CTL + 8) = 0u; *(unsigned*)(smem + SMEM_CTL + 12) = 0u; }
  __syncthreads();
  XcdBarrier xb = xcd_barrier_post((unsigned*)(p.ws + WS_BAR), (volatile LAS unsigned*)(smem + SMEM_CTL + 8));
#pragma unroll
  for (int rep = 0; rep < REP_P0; ++rep) phase0(p, smem);
#pragma unroll
  for (int rep = 0; rep < REP_BAR; ++rep) xcd_barrier(xb);
#if USE_CG_SYNC
  cg::this_grid().sync();
#else
  if (p.ph_hi < 0) cg::this_grid().sync();
  xcd_barrier(xb);
#endif
  layer_phases<0>(p, smem, xb);
  layer_phases<1>(p, smem, xb);
  rpass(p, 2, 1);
}
#define FWD_KERNEL fwd_mega
#endif

extern "C" void kernel_launch(void* const* d_in, const int* in_sizes, int n_in, void* d_out, int out_size, void* d_ws,
                              size_t ws_size, hipStream_t stream) {
  static int grid_blocks = 0;
  if (!grid_blocks) {
    int dev = 0, cus = 0, per_cu = 0;
    (void)hipGetDevice(&dev);
    (void)hipDeviceGetAttribute(&cus, hipDeviceAttributeMultiprocessorCount, dev);
    (void)hipFuncSetAttribute((const void*)FWD_KERNEL, hipFuncAttributeMaxDynamicSharedMemorySize, SMEM_BYTES);
    (void)hipOccupancyMaxActiveBlocksPerMultiprocessor(&per_cu, (const void*)FWD_KERNEL, 256, SMEM_BYTES);
    if (per_cu > 2) per_cu = 2;
    if (per_cu < 1) per_cu = 1;
    grid_blocks = cus * per_cu;
    if (n_in != 32 || ws_size < WS_END) {
      fprintf(stderr, "kernel_launch: unexpected n_in %d or ws_size %zu (< %zu)\n", n_in, ws_size, (size_t)WS_END);
      grid_blocks = -1;
    }
  }
  if (grid_blocks < 0) return;
  Params p{};
  const float** pp = (const float**)&p;
  for (int i = 0; i < 32; ++i) pp[i] = (const float*)d_in[i];
  p.out = (float*)d_out;
  p.ws = (unsigned char*)d_ws;
#if N_LAUNCH_MODE
  p.ph_lo = 0; p.ph_hi = NPHASE;
  (void)hipMemsetAsync((unsigned char*)d_ws + WS_BAR, 0, 16384, stream);
  void* args[] = {&p};
  hipError_t e = hipLaunchCooperativeKernel((const void*)fwd_mega, dim3(grid_blocks), dim3(256), args, SMEM_BYTES, stream);
  if (e != hipSuccess) fprintf(stderr, "cooperative launch failed: %s (grid %d)\n", hipGetErrorString(e), grid_blocks);
#else
  for (int ph = 0; ph < NPHASE; ++ph) {
    p.ph_lo = ph; p.ph_hi = ph + 1;
    hipLaunchKernelGGL(fwd_phases, dim3(grid_blocks), dim3(256), SMEM_BYTES, stream, p);
  }
#endif
}
```
